# Optimizing an MI355X kernel written in HIP

```python
import math
import jax
import jax.numpy as jnp
from jax import lax
import numpy as np

D_MODEL = 1024
BATCH = 8
SEQ = 8192
DEPTH = 2

GRID_W = 64
CTX_LEN = 256
N_MOD = 6
RMS_EPS = 1e-6

ML_HEADS = 4
ML_DQK = D_MODEL // 8
ML_DV = D_MODEL // 4
ML_CHUNK = 128

SS_INNER = D_MODEL
SS_HEADDIM = 64
SS_HEADS = SS_INNER // SS_HEADDIM
SS_GROUPS = 2
SS_RPG = SS_HEADS // SS_GROUPS
SS_STATE = 128
SS_CHUNK = 64
SS_CONV_CH = SS_INNER + 2 * SS_GROUPS * SS_STATE

MIX_W = ML_HEADS * ML_DV + SS_INNER
AB_SIZES = (ML_HEADS * ML_DQK, ML_HEADS * ML_DQK, ML_HEADS * ML_DV, ML_HEADS * ML_DV, 4 * ML_HEADS,
            SS_INNER, SS_CONV_CH, 2 * SS_HEADS)
AB_COLS = sum(AB_SIZES)

RW_HEADSZ = 64
RW_HEADS = D_MODEL // RW_HEADSZ
RW_DECAY_LORA = 64
RW_ICLR_LORA = 64
RW_GATE_LORA = 160
RW_GN_EPS = 64e-5

N_EXPERTS = 16
EC_CAPACITY_FACTOR = 2
EXPERT_FF = 11 * D_MODEL // 8

kernel_name = 'hybrid_mlstm_ssd_rwkv7_ec_moe_dit'


def rmsnorm(x, g, eps=RMS_EPS):
    xf = x.astype(jnp.float32)
    y = xf * lax.rsqrt(jnp.mean(xf * xf, axis=-1, keepdims=True) + eps)
    return (y * g.astype(jnp.float32)).astype(x.dtype)


def modulate(h, shift, scale):
    return h * (1.0 + scale) + shift


def mlstm_scan(q, k, v, ig, fg, state):
    bsz, nh, t, dk = q.shape
    dv = v.shape[-1]
    L = ML_CHUNK
    nc = t // L
    q = q.reshape(bsz, nh, nc, L, dk)
    k = k.reshape(bsz, nh, nc, L, dk)
    v = v.reshape(bsz, nh, nc, L, dv)
    ig = ig.reshape(bsz, nh, nc, L)
    b = jnp.cumsum(jax.nn.log_sigmoid(fg).reshape(bsz, nh, nc, L), axis=-1)
    b_end = b[..., -1]
    lw = b_end[..., None] - b + ig
    m_loc = jnp.max(lw, axis=-1)
    wgt = jnp.exp(lw - m_loc[..., None])
    c_loc = jnp.einsum('bhcsv,bhcsk->bhcvk', v * wgt[..., None], k)
    n_loc = jnp.einsum('bhcs,bhcsk->bhck', wgt, k)

    def step(carry, inp):
        c_st, n_st, m_st = carry
        cl, nl, ml, be = inp
        m_new = jnp.maximum(be + m_st, ml)
        a = jnp.exp(be + m_st - m_new)
        g = jnp.exp(ml - m_new)
        c_new = a[..., None, None] * c_st + g[..., None, None] * cl
        n_new = a[..., None] * n_st + g[..., None] * nl
        return (c_new, n_new, m_new), (c_st, n_st, m_st)

    xs = tuple(jnp.moveaxis(u, 2, 0) for u in (c_loc, n_loc, m_loc, b_end))
    final, (c_prev, n_prev, m_prev) = lax.scan(step, state, xs)
    c_prev = jnp.moveaxis(c_prev, 0, 2)
    n_prev = jnp.moveaxis(n_prev, 0, 2)
    m_prev = jnp.moveaxis(m_prev, 0, 2)
    causal = jnp.tril(jnp.ones((L, L), dtype=bool))
    log_d = jnp.where(causal, b[..., :, None] - b[..., None, :] + ig[..., None, :], -jnp.inf)
    log_inter = b + m_prev[..., None]
    m_row = jnp.maximum(jnp.max(log_d, axis=-1), log_inter)
    s = jnp.einsum('bhcjk,bhcsk->bhcjs', q, k) * jnp.exp(log_d - m_row[..., None])
    w_inter = jnp.exp(log_inter - m_row)
    num = jnp.einsum('bhcjs,bhcsv->bhcjv', s, v) + w_inter[..., None] * jnp.einsum('bhcvk,bhcjk->bhcjv', c_prev, q)
    den = jnp.sum(s, axis=-1) + w_inter * jnp.einsum('bhck,bhcjk->bhcj', n_prev, q)
    h = num / jnp.maximum(jnp.abs(den), jnp.exp(-m_row))[..., None]
    return h.reshape(bsz, nh, t, dv), final


def mlstm_branch(parts_c, parts_l, gate_b, norm_g, ctx_out):
    def heads(parts):
        q, k, v, o, gates = parts
        bsz, t, _ = q.shape
        split = lambda u, dh: u.reshape(bsz, t, ML_HEADS, dh).transpose(0, 2, 1, 3)
        gates = (gates.reshape(bsz, t, 2, 2, ML_HEADS) + gate_b).transpose(2, 3, 0, 4, 1)
        return split(q, ML_DQK), split(k, ML_DQK) * (ML_DQK ** -0.5), split(v, ML_DV), gates, o

    def bidir(hp, init):
        q, k, v, g, _ = hp
        fl = lambda u: jnp.flip(u, axis=2)
        h_f, s_f = mlstm_scan(q, k, v, g[0, 0], g[0, 1], init[0])
        h_b, s_b = mlstm_scan(fl(q), fl(k), fl(v), fl(g[1, 0]), fl(g[1, 1]), init[1])
        return h_f + fl(h_b), (s_f, s_b)

    def post(h, o):
        bsz, _, t, _ = h.shape
        h = rmsnorm(jnp.swapaxes(h, 1, 2), norm_g.reshape(ML_HEADS, ML_DV))
        return h.reshape(bsz, t, ML_HEADS * ML_DV) * jax.nn.sigmoid(o)

    hc, hl = heads(parts_c), heads(parts_l)
    bsz = hc[0].shape[0]
    zero = (jnp.zeros((bsz, ML_HEADS, ML_DV, ML_DQK), jnp.float32),
            jnp.zeros((bsz, ML_HEADS, ML_DQK), jnp.float32),
            jnp.zeros((bsz, ML_HEADS), jnp.float32))
    y_c, ctx_states = bidir(hc, (zero, zero))
    y_l, _ = bidir(hl, ctx_states)
    return (post(y_c, hc[4]) if ctx_out else None), post(y_l, hl[4])


def depthwise_conv2d(u, w, bias, width):
    bsz, t, ch = u.shape
    img = u.reshape(bsz, t // width, width, ch)
    out = lax.conv_general_dilated(img, w.astype(u.dtype)[:, :, None, :], (1, 1), 'SAME',
                                   dimension_numbers=('NHWC', 'HWIO', 'NHWC'), feature_group_count=ch)
    return out.reshape(bsz, t, ch) + bias


def ssd_scan(xs, dt, a, bm, cm, h0):
    bsz, t, ng, nr, hp = xs.shape
    ns = bm.shape[-1]
    L = SS_CHUNK
    nc = t // L
    x = (xs * dt[..., None]).reshape(bsz, nc, L, ng, nr, hp)
    bc = bm.reshape(bsz, nc, L, ng, ns)
    cc = cm.reshape(bsz, nc, L, ng, ns)
    acum = jnp.cumsum((dt * a).reshape(bsz, nc, L, ng, nr), axis=2)
    a_end = acum[:, :, -1]
    s_loc = jnp.einsum('bclgrp,bclgn->bcgrpn', x * jnp.exp(a_end[:, :, None] - acum)[..., None], bc)

    def step(h, inp):
        sl, ae = inp
        return jnp.exp(ae)[..., None, None] * h + sl, h

    h_final, h_prev = lax.scan(step, h0, (jnp.moveaxis(s_loc, 1, 0), jnp.moveaxis(a_end, 1, 0)))
    h_prev = jnp.moveaxis(h_prev, 0, 1)
    causal = jnp.tril(jnp.ones((L, L), dtype=bool))[:, :, None, None]
    seg = jnp.exp(jnp.where(causal, acum[:, :, :, None] - acum[:, :, None, :], -jnp.inf))
    mmat = jnp.einsum('bcjgn,bcsgn->bcjsg', cc, bc)[..., None] * seg
    y = jnp.einsum('bcjsgr,bcsgrp->bcjgrp', mmat, x)
    y = y + jnp.einsum('bcjgn,bcgrpn->bcjgrp', cc, h_prev) * jnp.exp(acum)[..., None]
    return y.reshape(bsz, t, ng, nr, hp), h_final


def ssd_branch(parts_c, parts_l, conv_w, conv_b, dt_bias, a_log, d_skip, norm_g, ctx_out):
    a = -jnp.exp(a_log.astype(jnp.float32)).reshape(2, SS_GROUPS, SS_RPG)

    def prep(parts, width):
        z, xbc, dt = parts
        xbc = jax.nn.silu(depthwise_conv2d(xbc, conv_w, conv_b, width))
        xs, bm, cm = jnp.split(xbc, [SS_INNER, SS_INNER + SS_GROUPS * SS_STATE], axis=-1)
        bsz, t, _ = xs.shape
        xs = xs.reshape(bsz, t, SS_GROUPS, SS_RPG, SS_HEADDIM)
        bm = bm.reshape(bsz, t, SS_GROUPS, SS_STATE)
        cm = cm.reshape(bsz, t, SS_GROUPS, SS_STATE)
        dt = jax.nn.softplus(dt.reshape(bsz, t, 2, SS_HEADS) + dt_bias).reshape(bsz, t, 2, SS_GROUPS, SS_RPG)
        return z, xs, bm, cm, dt

    def bidir(pre, init):
        _, xs, bm, cm, dt = pre
        fl = lambda u: jnp.flip(u, axis=1)
        y_f, s_f = ssd_scan(xs, dt[:, :, 0], a[0], bm, cm, init[0])
        y_b, s_b = ssd_scan(fl(xs), fl(dt[:, :, 1]), a[1], fl(bm), fl(cm), init[1])
        y = y_f + fl(y_b) + d_skip.reshape(SS_GROUPS, SS_RPG)[..., None] * xs
        return y, (s_f, s_b)

    def post(pre, y):
        z = pre[0]
        bsz, t, _ = z.shape
        u = (y.reshape(bsz, t, SS_INNER) * jax.nn.silu(z)).reshape(bsz, t, SS_GROUPS, SS_INNER // SS_GROUPS)
        return rmsnorm(u, norm_g.reshape(SS_GROUPS, -1)).reshape(bsz, t, SS_INNER)

    pc = prep(parts_c, parts_c[0].shape[1])
    pl = prep(parts_l, GRID_W)
    bsz = pc[1].shape[0]
    zero = jnp.zeros((bsz, SS_GROUPS, SS_RPG, SS_HEADDIM, SS_STATE), jnp.float32)
    y_c, ctx_states = bidir(pc, (zero, zero))
    y_l, _ = bidir(pl, ctx_states)
    return (post(pc, y_c) if ctx_out else None), post(pl, y_l)


def mixer_ab(h_c, h_l, w_in, w_out, gate_b, ml_norm_g, conv_w, conv_b, dt_bias, a_log, d_skip, ss_norm_g, ctx_out):
    splits = np.cumsum(AB_SIZES)[:-1].tolist()
    pc = jnp.split((h_c @ w_in).astype(jnp.float32), splits, axis=-1)
    pl = jnp.split((h_l @ w_in).astype(jnp.float32), splits, axis=-1)
    ml_c, ml_l = mlstm_branch(pc[:5], pl[:5], gate_b, ml_norm_g, ctx_out)
    ss_c, ss_l = ssd_branch(pc[5:], pl[5:], conv_w, conv_b, dt_bias, a_log, d_skip, ss_norm_g, ctx_out)
    out_l = (jnp.concatenate([ml_l, ss_l], axis=-1) @ w_out).astype(h_l.dtype)
    out_c = (jnp.concatenate([ml_c, ss_c], axis=-1) @ w_out).astype(h_c.dtype) if ctx_out else None
    return out_c, out_l


def rwkv7_scan(r, w, k, v, a, b, s0, reverse):
    def step(s, inp):
        rt, wt, kt, vt, at, bt = inp
        sa = jnp.einsum('bhvk,bhk->bhv', s, at)
        s = s * wt[..., None, :] + sa[..., None] * bt[..., None, :] + vt[..., None] * kt[..., None, :]
        return s, jnp.einsum('bhvk,bhk->bhv', s, rt)

    xs = tuple(jnp.swapaxes(u, 0, 1) for u in (r, w, k, v, a, b))
    s_final, ys = lax.scan(step, s0, xs, reverse=reverse)
    return jnp.swapaxes(ys, 0, 1), s_final


def mixer_rwkv(h_c, h_l, mu, wr, wk, wv, wo, w0, w1, w2, a0, a1, a2, g1, g2, k_k, k_a, r_k, lnx_g, lnx_b, ctx_out):
    out_dtype = h_l.dtype

    def heads(u):
        return u.reshape(*u.shape[:-1], RW_HEADS, RW_HEADSZ)

    def prep(h):
        h = h.astype(jnp.float32)
        prev = jnp.pad(h[:, :-1], ((0, 0), (1, 0), (0, 0)))
        nxt = jnp.pad(h[:, 1:], ((0, 0), (0, 1), (0, 0)))
        xx = 0.5 * (prev + nxt) - h
        xr, xw, xk, xv, xa, xg = [h + xx * mu[n] for n in range(6)]
        r = xr @ wr
        k = xk @ wk
        v = xv @ wv
        lw = w0[:, None, None, :] + jnp.einsum('ebtr,erd->ebtd', jnp.tanh(jnp.einsum('btd,edr->ebtr', xw, w1)), w2)
        decay = jnp.exp(-jnp.exp(-jax.nn.softplus(-lw) - 0.5))
        a = jax.nn.sigmoid(a0 + (xa @ a1) @ a2)
        g = jax.nn.sigmoid(xg @ g1) @ g2
        kk = heads(k * k_k)
        kk = kk * lax.rsqrt(jnp.sum(kk * kk, axis=-1, keepdims=True) + 1e-12)
        k = k * (1.0 + (a - 1.0) * k_a)
        return heads(r), heads(decay), heads(k), heads(v), -kk, kk * heads(a), g

    def bidir(pre, init):
        r, decay, k, v, aa, bb, _ = pre
        y_f, s_f = rwkv7_scan(r, decay[0], k, v, aa, bb, init[0], False)
        y_b, s_b = rwkv7_scan(r, decay[1], k, v, aa, bb, init[1], True)
        return y_f + y_b, (s_f, s_b)

    def post(pre, y):
        r, _, k, v, _, _, g = pre
        bsz, t = y.shape[:2]
        mean = jnp.mean(y, axis=-1, keepdims=True)
        var = jnp.mean(jnp.square(y - mean), axis=-1, keepdims=True)
        y = ((y - mean) * lax.rsqrt(var + RW_GN_EPS)).reshape(bsz, t, D_MODEL) * lnx_g + lnx_b
        y = y + (jnp.sum(r * k * r_k, axis=-1, keepdims=True) * v).reshape(bsz, t, D_MODEL)
        return ((y * g) @ wo).astype(out_dtype)

    pc, pl = prep(h_c), prep(h_l)
    bsz = h_l.shape[0]
    zero = jnp.zeros((bsz, RW_HEADS, RW_HEADSZ, RW_HEADSZ), jnp.float32)
    y_c, ctx_states = bidir(pc, (zero, zero))
    y_l, _ = bidir(pl, ctx_states)
    return (post(pc, y_c) if ctx_out else None), post(pl, y_l)


def ec_moe(h, router_w, w1, w3, w2):
    bsz, n, d = h.shape
    cap = EC_CAPACITY_FACTOR * n // N_EXPERTS
    affinity = jax.nn.softmax((h @ router_w).astype(jnp.float32), axis=-1)
    gate, idx = lax.top_k(jnp.swapaxes(affinity, 1, 2), cap)
    xg = jax.vmap(lambda hb, ib: hb[ib])(h, idx)
    hid = jax.nn.silu(jnp.einsum('becd,edf->becf', xg, w1)) * jnp.einsum('becd,edf->becf', xg, w3)
    out = jnp.einsum('becf,efd->becd', hid, w2) * gate[..., None].astype(h.dtype)
    return jax.vmap(lambda ob, ib: jnp.zeros((n, d), ob.dtype).at[ib.reshape(-1)].add(ob.reshape(-1, d)))(out, idx)


def channel_sublayer(x, mod, ng, router_w, w1, w3, w2):
    h = modulate(rmsnorm(x, ng[2]), mod[3], mod[4])
    return x + mod[5] * rmsnorm(ec_moe(h, router_w, w1, w3, w2), ng[3])


def setup_inputs(seed: int = 0) -> dict:
    keys = jax.random.split(jax.random.key(seed), 48)
    counter = [0]

    def nxt():
        counter[0] += 1
        return keys[counter[0] - 1]

    def nrm(shape, scale):
        return jax.random.normal(nxt(), shape, jnp.float32) * scale

    def uni(shape, lo, hi):
        return jax.random.uniform(nxt(), shape, jnp.float32, lo, hi)

    d, e, f = D_MODEL, N_EXPERTS, EXPERT_FF
    ne, no = (DEPTH + 1) // 2, DEPTH // 2
    dt0 = jnp.exp(uni((ne, 2, SS_HEADS), math.log(1e-3), math.log(1e-1)))
    return {
        'x': nrm((BATCH, SEQ, d), 1.0),
        'c': nrm((BATCH, d), 1.0),
        'ctx': nrm((BATCH, CTX_LEN, d), 1.0),
        'c_ctx': nrm((d,), 1.0),
        'ada_w': nrm((DEPTH, d, N_MOD * d), 0.5 * d ** -0.5),
        'ada_b': nrm((DEPTH, N_MOD * d), 0.02),
        'norm_g': 1.0 + nrm((DEPTH, 4, d), 0.02),
        'router_w': nrm((DEPTH, d, e), d ** -0.5),
        'exp_w1': nrm((DEPTH, e, d, f), d ** -0.5),
        'exp_w3': nrm((DEPTH, e, d, f), d ** -0.5),
        'exp_w2': nrm((DEPTH, e, f, d), f ** -0.5),
        'ab_w_in': nrm((ne, d, AB_COLS), d ** -0.5),
        'ab_w_out': nrm((ne, MIX_W, d), MIX_W ** -0.5),
        'ml_gate_b': jnp.array([0.0, 3.0], jnp.float32)[None, None, :, None] + nrm((ne, 2, 2, ML_HEADS), 0.3),
        'ml_norm_g': 1.0 + nrm((ne, ML_HEADS * ML_DV), 0.02),
        'ss_conv_w': nrm((ne, 3, 3, SS_CONV_CH), 1.0 / 3.0),
        'ss_conv_b': nrm((ne, SS_CONV_CH), 0.02),
        'ss_dt_bias': dt0 + jnp.log(-jnp.expm1(-dt0)),
        'ss_A_log': jnp.log(uni((ne, 2, SS_HEADS), 1.0, 16.0)),
        'ss_D': 1.0 + nrm((ne, SS_HEADS), 0.1),
        'ss_norm_g': 1.0 + nrm((ne, SS_INNER), 0.02),
        'rw_mu': uni((no, 6, d), 0.0, 1.0),
        'rw_wr': nrm((no, d, d), d ** -0.5),
        'rw_wk': nrm((no, d, d), d ** -0.5),
        'rw_wv': nrm((no, d, d), d ** -0.5),
        'rw_wo': nrm((no, d, d), d ** -0.5),
        'rw_w0': uni((no, 2, d), -6.5, -1.5),
        'rw_w1': nrm((no, 2, d, RW_DECAY_LORA), d ** -0.5),
        'rw_w2': nrm((no, 2, RW_DECAY_LORA, d), 0.1 * RW_DECAY_LORA ** -0.5),
        'rw_a0': nrm((no, d), 0.1),
        'rw_a1': nrm((no, d, RW_ICLR_LORA), d ** -0.5),
        'rw_a2': nrm((no, RW_ICLR_LORA, d), 0.1 * RW_ICLR_LORA ** -0.5),
        'rw_g1': nrm((no, d, RW_GATE_LORA), d ** -0.5),
        'rw_g2': nrm((no, RW_GATE_LORA, d), RW_GATE_LORA ** -0.5),
        'rw_kk': 0.85 + nrm((no, d), 0.02),
        'rw_ka': 1.0 + nrm((no, d), 0.02),
        'rw_rk': nrm((no, RW_HEADS, RW_HEADSZ), 0.1),
        'rw_lnx_g': 1.0 + nrm((no, d), 0.02),
        'rw_lnx_b': nrm((no, d), 0.02),
    }


def reference(x, c, ctx, c_ctx, ada_w, ada_b, norm_g, router_w, exp_w1, exp_w3, exp_w2,
              ab_w_in, ab_w_out, ml_gate_b, ml_norm_g, ss_conv_w, ss_conv_b, ss_dt_bias, ss_A_log, ss_D, ss_norm_g,
              rw_mu, rw_wr, rw_wk, rw_wv, rw_wo, rw_w0, rw_w1, rw_w2, rw_a0, rw_a1, rw_a2, rw_g1, rw_g2,
              rw_kk, rw_ka, rw_rk, rw_lnx_g, rw_lnx_b):
    sc = jax.nn.silu(c)
    sc_ctx = jax.nn.silu(c_ctx)
    for i in range(DEPTH):
        last = i == DEPTH - 1
        j = i // 2
        ng = norm_g[i]
        mod_l = (sc @ ada_w[i] + ada_b[i]).reshape(x.shape[0], N_MOD, 1, D_MODEL).swapaxes(0, 1)
        mod_c = (sc_ctx @ ada_w[i] + ada_b[i]).reshape(N_MOD, 1, 1, D_MODEL)
        h_l = modulate(rmsnorm(x, ng[0]), mod_l[0], mod_l[1])
        h_c = modulate(rmsnorm(ctx, ng[0]), mod_c[0], mod_c[1])
        if i % 2 == 0:
            o_c, o_l = mixer_ab(h_c, h_l, ab_w_in[j], ab_w_out[j], ml_gate_b[j], ml_norm_g[j], ss_conv_w[j],
                                ss_conv_b[j], ss_dt_bias[j], ss_A_log[j], ss_D[j], ss_norm_g[j], not last)
        else:
            o_c, o_l = mixer_rwkv(h_c, h_l, rw_mu[j], rw_wr[j], rw_wk[j], rw_wv[j], rw_wo[j], rw_w0[j], rw_w1[j],
                                  rw_w2[j], rw_a0[j], rw_a1[j], rw_a2[j], rw_g1[j], rw_g2[j], rw_kk[j], rw_ka[j],
                                  rw_rk[j], rw_lnx_g[j], rw_lnx_b[j], not last)
        x = x + mod_l[2] * rmsnorm(o_l, ng[1])
        x = channel_sublayer(x, mod_l, ng, router_w[i], exp_w1[i], exp_w3[i], exp_w2[i])
        if not last:
            ctx = ctx + mod_c[2] * rmsnorm(o_c, ng[1])
            ctx = channel_sublayer(ctx, mod_c, ng, router_w[i], exp_w1[i], exp_w3[i], exp_w2[i])
    return x
```

```cpp
#define MK_ONE_LAUNCH 1
#define MK_NPH 25
#include <hip/hip_runtime.h>
#include <stdint.h>

#define DI __device__ __forceinline__
#define LAS __attribute__((address_space(3)))
typedef unsigned short bf16_t;
typedef short bf16x8 __attribute__((ext_vector_type(8)));
typedef short s16x4 __attribute__((ext_vector_type(4)));
typedef float f32x4 __attribute__((ext_vector_type(4)));
typedef float f32x2 __attribute__((ext_vector_type(2)));
typedef unsigned u32x4 __attribute__((ext_vector_type(4)));
typedef unsigned u32x2 __attribute__((ext_vector_type(2)));

constexpr int NB = 8, T = 8192, TC = 256, D = 1024;
constexpr int NL = NB * T;
constexpr int NCX = NB * TC;
constexpr int NR = NL + NCX;
constexpr int NE = 16, FF = 1408;
constexpr float RMS_EPS = 1e-6f;

constexpr size_t MiB = (size_t)1 << 20;
constexpr size_t WS_CTL = 0;
constexpr size_t WS_MOD = 1 * MiB;
constexpr size_t WS_AFF = 2 * MiB;
constexpr size_t WS_SLOT = 7 * MiB;
constexpr size_t WS_IDX = 12 * MiB;
constexpr size_t WS_GATE = 13 * MiB;
constexpr size_t WS_CTXS = 14 * MiB;
constexpr size_t WS_WIN = 22 * MiB;
constexpr size_t WS_WOUT = 34 * MiB;
constexpr size_t WS_LORA1 = 2 * MiB;
constexpr size_t WS_WRW = 38 * MiB;
constexpr size_t WS_WO = 52 * MiB;
constexpr size_t WS_W2A = 54 * MiB;
constexpr size_t WS_G2 = 56 * MiB;
constexpr size_t WS_GD = 57 * MiB;
constexpr size_t WS_LORA2 = 57 * MiB;
constexpr size_t WS_SLOTS = 100 * MiB;
constexpr size_t USZ = (size_t)NR * 1024 * 2;
DI constexpr size_t slot_off(int i) { return WS_SLOTS + (size_t)i * USZ; }
constexpr size_t WS_NEED = WS_SLOTS + 7 * USZ;

DI int tid_op() { int t = (int)threadIdx.x; asm volatile("" : "+v"(t)); return t; }
DI void lds_barrier() { asm volatile("s_waitcnt lgkmcnt(0)" ::: "memory"); __builtin_amdgcn_s_barrier(); asm volatile("" ::: "memory"); }
DI float bflo(unsigned w) { return __uint_as_float(w << 16); }
DI float bfhi(unsigned w) { return __uint_as_float(w & 0xffff0000u); }
DI float bf2f(bf16_t x) { return __uint_as_float(((unsigned)x) << 16); }
typedef __bf16 bf16v2_t __attribute__((ext_vector_type(2)));
DI unsigned pkbf(float lo, float hi) { const f32x2 v = {lo, hi}; const bf16v2_t b = __builtin_convertvector(v, bf16v2_t); return __builtin_bit_cast(unsigned, b); }
DI bf16_t f2bf(float x) { return (bf16_t)(pkbf(x, 0.f) & 0xffffu); }
DI float frcp(float x) { return __builtin_amdgcn_rcpf(x); }
DI float sigmoidf_(float x) { return frcp(1.f + __expf(-x)); }
DI float siluf_(float x) { return x * sigmoidf_(x); }
DI float softplusf_(float x) { return fmaxf(x, 0.f) + __logf(1.f + __expf(-fabsf(x))); }
DI float tanhf_(float x) { return 1.f - 2.f * frcp(1.f + __expf(2.f * x)); }
DI float wave_sum(float v) {
#pragma unroll
    for (int o = 32; o >= 1; o >>= 1) v += __shfl_xor(v, o);
    return v;
}
template <int CTRL, int RMASK> DI float dpp_addz(float x) { return x + __int_as_float(__builtin_amdgcn_update_dpp(0, __float_as_int(x), CTRL, RMASK, 0xf, true)); }
DI float wave_incl_scan(float v) {
    v = dpp_addz<0x111, 0xf>(v); v = dpp_addz<0x112, 0xf>(v); v = dpp_addz<0x114, 0xf>(v); v = dpp_addz<0x118, 0xf>(v);
    v = dpp_addz<0x142, 0xa>(v); v = dpp_addz<0x143, 0xc>(v); return v; }
DI float clamp_f8(float x) { return fminf(fmaxf(x, -440.f), 440.f); }
DI unsigned pk_fp8x4(float a, float b, float c, float d) { int w = __builtin_amdgcn_cvt_pk_fp8_f32(clamp_f8(a), clamp_f8(b), 0, false); w = __builtin_amdgcn_cvt_pk_fp8_f32(clamp_f8(c), clamp_f8(d), w, true); return (unsigned)w; }
DI void unpack8(const u32x4 w, float (&f)[8]) { f[0] = bflo(w.x); f[1] = bfhi(w.x); f[2] = bflo(w.y); f[3] = bfhi(w.y); f[4] = bflo(w.z); f[5] = bfhi(w.z); f[6] = bflo(w.w); f[7] = bfhi(w.w); }
DI u32x4 pack8(const float (&f)[8]) { u32x4 w; w.x = pkbf(f[0], f[1]); w.y = pkbf(f[2], f[3]); w.z = pkbf(f[4], f[5]); w.w = pkbf(f[6], f[7]); return w; }

#define XB_TMO      128
#define XB_XCNT(j)  (256  + 64 * (j))
#define XB_XSUB(j)  (1280 + 64 * (j))
#define XB_XGEN(j)  (2304 + 64 * (j))
#define XB_TOP      3328
#define XB_TOPGEN   3392
#define XCD_BAR_WORDS 3456
#define XB_SPIN_CAP (1u << 18)
__device__ __forceinline__ unsigned xb_ld(unsigned* p)              { return __hip_atomic_load(p, __ATOMIC_RELAXED, __HIP_MEMORY_SCOPE_AGENT); }
__device__ __forceinline__ unsigned xb_add(unsigned* p, unsigned v) { return __hip_atomic_fetch_add(p, v, __ATOMIC_RELAXED, __HIP_MEMORY_SCOPE_AGENT); }
__device__ __forceinline__ unsigned xb_xcc_id() { return (unsigned)__builtin_amdgcn_s_getreg((3 << 11) | 20) & 0xFu; }
#define XB_SPIN(cond, bar) do { unsigned _sp = 0; while (cond) { __builtin_amdgcn_s_sleep(1); \
    if ((++_sp & 255u) == 0u) { if (xb_ld(&(bar)[XB_TMO])) break; if (_sp > XB_SPIN_CAP) { atomicAdd(&(bar)[XB_TMO], 1u); break; } } } } while (0)
struct XcdBarrier { unsigned* bar; unsigned x; volatile LAS unsigned* st; };
__device__ __forceinline__ XcdBarrier xcd_barrier_post(unsigned* bar, volatile LAS unsigned* st) {
    XcdBarrier b; b.bar = bar; b.x = xb_xcc_id(); b.st = st;
    if (threadIdx.x == 0) (void)xb_add(&bar[XB_XCNT(b.x)], 1u);
    return b;
}
__device__ __forceinline__ void xcd_barrier_complete(unsigned* bar, unsigned x, unsigned& nloc, unsigned& nx) {
    const unsigned G = gridDim.x * gridDim.y * gridDim.z;
    unsigned sum, cnt, mine, sp = 0u;
    for (;;) {
        sum = 0u; cnt = 0u; mine = 0u;
#pragma unroll
        for (unsigned j = 0; j < 16; ++j) { const unsigned c = xb_ld(&bar[XB_XCNT(j)]); sum += c; cnt += (c > 0u) ? 1u : 0u; mine = (j == x) ? c : mine; }
        if (sum == G) break;
        __builtin_amdgcn_s_sleep(1);
        if ((++sp & 255u) == 0u) { if (xb_ld(&bar[XB_TMO])) break; if (sp > XB_SPIN_CAP) { atomicAdd(&bar[XB_TMO], 1u); break; } }
    }
    nloc = mine > 0u ? mine : 1u; nx = cnt > 0u ? cnt : 1u;
}
__device__ __forceinline__ void xcd_barrier(const XcdBarrier& b) {
    asm volatile("s_waitcnt vmcnt(0)" ::: "memory");
    __syncthreads();
    if (threadIdx.x == 0) {
        unsigned* bar = b.bar;
        __builtin_amdgcn_s_waitcnt(0);
        unsigned nloc = b.st[0], nx = b.st[1];
        if (nloc == 0u) { xcd_barrier_complete(bar, b.x, nloc, nx); b.st[0] = nloc; b.st[1] = nx; }
        const unsigned old = xb_add(&bar[XB_XSUB(b.x)], 1u);
        const unsigned gen = old / nloc;
        if (old + 1u == (gen + 1u) * nloc) {
            __builtin_amdgcn_fence(__ATOMIC_RELEASE, "agent");
            asm volatile("s_waitcnt vmcnt(0)" ::: "memory");
            const unsigned og = xb_add(&bar[XB_TOP], 1u);
            const unsigned tg = og / nx;
            if (og + 1u == (tg + 1u) * nx) xb_add(&bar[XB_TOPGEN], 1u);
            else XB_SPIN(xb_ld(&bar[XB_TOPGEN]) == tg, bar);
            __builtin_amdgcn_fence(__ATOMIC_ACQUIRE, "agent");
            xb_add(&bar[XB_XGEN(b.x)], 1u);
            asm volatile("s_waitcnt vmcnt(0)" ::: "memory");
        } else {
            XB_SPIN(xb_ld(&bar[XB_XGEN(b.x)]) == gen, bar);
            __builtin_amdgcn_fence(__ATOMIC_ACQUIRE, "agent");
            asm volatile("s_waitcnt vmcnt(0)" ::: "memory");
        }
    }
    __syncthreads();
}

#ifndef MK_SPLIT
#define MK_SPLIT false
#endif
#ifndef MK_SPLIT_SWIGLU
#define MK_SPLIT_SWIGLU true
#endif
namespace pg8 {
constexpr int BM = 256, BK = 64, HALF = 128, HTB = HALF * BK * 2, STAGE_BYTES = 8 * HTB, NXCD = 8, WGM = 8;
__host__ __device__ __forceinline__ int lds_byte(int r, int c) { const int st = (r >> 4) * 2 + (c >> 5), rr = r & 15, cc = c & 31, ob = rr * 64 + cc * 2; return st * 1024 + (ob ^ (((ob >> 9) & 1) << 5)); }
__host__ __device__ __forceinline__ void stage_rc(int b, int& R, int& C) { const int st = b / 1024, sb = b % 1024, swz = sb ^ (((sb >> 9) & 1) << 5); R = (st >> 1) * 16 + swz / 64; C = (st & 1) * 32 + (swz % 64) / 2; }
__host__ __device__ __forceinline__ int perm32(int rho) { const int n = rho >> 4, i = rho & 15; return 8 * (i >> 2) + 4 * n + (i & 3); }
struct Unit { int pm, pn; };
struct Gemm { const bf16_t* A; const bf16_t* Bt; int lda, K; int ash = 0; int ldb = 0; size_t agrp = 0, bgrp = 0; };

struct StaticOrder {
    int nM, nN, nwg, G, c;
    __device__ void init(int M, int N, int G_, int c_) { nM = M / BM; nN = N / BM; nwg = nM * nN; G = G_; c = c_; }
    __device__ bool next(int i, Unit& u) const {
        const long L = (long)i * G + c; if (L >= nwg) return false;
        int wgid = (int)L; { const int q = nwg / NXCD, r = nwg % NXCD, xcd = wgid % NXCD, off = wgid / NXCD; wgid = (xcd < r ? xcd * (q + 1) : r * (q + 1) + (xcd - r) * q) + off; }
        const int nig = WGM * nN, gid = wgid / nig, fm = gid * WGM, gsz = (nM - fm) < WGM ? (nM - fm) : WGM;
        u.pm = fm + ((wgid % nig) % gsz); u.pn = (wgid % nig) / gsz; return true;
    }
};
struct SkipOrder {
    int nM, nN, nwg, G, c, nskip;
    __device__ void init(int M, int N, int G_, int c_, int nskip_) { nM = M / BM; nN = N / BM; nwg = nM * nN; G = G_; c = c_; nskip = nskip_; }
    __device__ bool next(int i, Unit& u) const {
        long L; if (i == 0) L = c; else { if (c < nskip) return false; L = G + (long)(i - 1) * (G - nskip) + (c - nskip); }
        if (L >= nwg) return false;
        int wgid = (int)L; { const int q = nwg / NXCD, r = nwg % NXCD, xcd = wgid % NXCD, off = wgid / NXCD; wgid = (xcd < r ? xcd * (q + 1) : r * (q + 1) + (xcd - r) * q) + off; }
        const int nig = WGM * nN, gid = wgid / nig, fm = gid * WGM, gsz = (nM - fm) < WGM ? (nM - fm) : WGM;
        u.pm = fm + ((wgid % nig) % gsz); u.pn = (wgid % nig) / gsz; return true;
    }
};
struct GroupOrder {
    int tpe, npe, nwg, G, c;
    __device__ void init(int tpe_, int npe_, int G_, int c_) { tpe = tpe_; npe = npe_; nwg = NE * tpe_ * npe_; G = G_; c = c_; }
    __device__ bool next(int i, Unit& u) const {
        const long L = (long)i * G + c; if (L >= nwg) return false;
        const int per = tpe * npe, e = (int)L / per, r = (int)L % per;
        u.pm = e * tpe + r % tpe; u.pn = e * npe + r / tpe; return true;
    }
};

typedef int i32x4_t __attribute__((ext_vector_type(4)));
typedef int i32x8_t __attribute__((ext_vector_type(8)));
template <class Epi, class Sched, bool ALIGN_EPI_ = true, bool SP2 = true, bool F8 = false>
__device__ __forceinline__ void gemm_phase(LAS unsigned char* lds, const Gemm g, const Sched& S, const Epi& E, const bool dry = false) {
#ifndef MK_ALIGN_EPI
#define MK_ALIGN_EPI 1
#endif
    constexpr bool ALIGN_EPI = ALIGN_EPI_ && MK_ALIGN_EPI;
    const int tid = tid_op(), wid = __builtin_amdgcn_readfirstlane(tid >> 6), lane = tid & 63, wr = wid >> 2, wc = wid & 3, fr = lane & 15, fq = lane >> 4;
    int K = g.K, lda = g.lda, ldb = g.ldb ? g.ldb : g.K; asm volatile("" : "+s"(K), "+s"(lda), "+s"(ldb));
    const int nt = K / BK;
    unsigned voffA[2], voffB[2];
#pragma unroll
    for (int i = 0; i < 2; ++i) { int R, C; stage_rc(tid * 16 + i * 8192, R, C); const int Rb = Epi::PERM ? ((R & ~31) + perm32(R & 31)) : R;
        voffA[i] = (unsigned)(R * lda + C) * 2u; voffB[i] = (unsigned)(Rb * ldb + C) * 2u; }
    const size_t kstep = (size_t)(BK * 2);
    const size_t hstepA = (size_t)HALF * lda * 2, hstepB = (size_t)HALF * ldb * 2;
    const size_t tstepA = 2 * hstepA, tstepB = 2 * hstepB;
    const unsigned ldsw = (unsigned)wid * 1024u, ldsb = (unsigned)(size_t)lds + ldsw;
    const int aoff = lds_byte(wr * 64 + fr, fq * 8), boff = lds_byte(wc * 32 + fr, fq * 8);
#define PG8_SA(b, h) (((b) * 2 + (h)) * HTB)
#define PG8_SB(b, h) ((4 + (b) * 2 + (h)) * HTB)
#define PG8_STAGE(bufoff, gbase, voff) do { _Pragma("unroll") for (int _i = 0; _i < 2; ++_i) \
        asm volatile("s_mov_b32 m0, %2\n\ts_nop 0\n\tglobal_load_lds_dwordx4 %0, %1" :: "v"((voff)[_i]), "s"((const char*)(gbase)), "s"(ldsb + (unsigned)((bufoff) + _i * 8192)) : "memory", "m0"); } while (0)
#define PG8_RD(off) (*(const LAS i32x4_t*)(lds + (off)))
#define PG8_LDA(dst, b, h) do { _Pragma("unroll") for (int m = 0; m < 4; ++m) { if constexpr (F8) dst##8[m] = __builtin_shufflevector(PG8_RD(PG8_SA(b, h) + aoff + m * 2048), PG8_RD(PG8_SA(b, h) + aoff + m * 2048 + 1024), 0, 1, 2, 3, 4, 5, 6, 7); \
        else { _Pragma("unroll") for (int k = 0; k < 2; ++k) dst[m][k] = *(const LAS bf16x8*)(lds + PG8_SA(b, h) + aoff + m * 2048 + k * 1024); } } } while (0)
#define PG8_LDB(dst, b, h) do { _Pragma("unroll") for (int n = 0; n < 2; ++n) { if constexpr (F8) dst##8[n] = __builtin_shufflevector(PG8_RD(PG8_SB(b, h) + boff + n * 2048), PG8_RD(PG8_SB(b, h) + boff + n * 2048 + 1024), 0, 1, 2, 3, 4, 5, 6, 7); \
        else { _Pragma("unroll") for (int k = 0; k < 2; ++k) dst[n][k] = *(const LAS bf16x8*)(lds + PG8_SB(b, h) + boff + n * 2048 + k * 1024); } } } while (0)
#define PG8_MMA(ai, bj, At, Bt) do { __builtin_amdgcn_s_setprio(1); _Pragma("unroll") for (int m = 0; m < 4; ++m) _Pragma("unroll") for (int n = 0; n < 2; ++n) { \
        if constexpr (F8) asm volatile("v_mfma_scale_f32_16x16x128_f8f6f4 %0, %1, %2, %0, %3, %4 op_sel_hi:[0,0,0]" : "+v"(acc[ai][bj][m][n]) : "v"(Bt##8[n]), "v"(At##8[m]), "v"(sc_w), "v"(sc_1)); \
        else { _Pragma("unroll") for (int k = 0; k < 2; ++k) acc[ai][bj][m][n] = __builtin_amdgcn_mfma_f32_16x16x32_bf16(Bt[n][k], At[m][k], acc[ai][bj][m][n], 0, 0, 0); } } __builtin_amdgcn_s_setprio(0); } while (0)
#define PG8_WAIT_V(n) asm volatile("s_waitcnt vmcnt(" #n ")" ::: "memory")
#define PG8_WAIT_VE(n) do { if (fe) asm volatile("s_waitcnt vmcnt(%0)" :: "n"(n) : "memory"); else PG8_WAIT_V(8); } while (0)
#define PG8_WAIT_L(n) asm volatile("s_waitcnt lgkmcnt(" #n ")" ::: "memory")
#define PG8_BAR __builtin_amdgcn_s_barrier()
#define PG8_SCHED __builtin_amdgcn_sched_barrier(0)
    constexpr int W12 = 8 + Epi::NST, W3 = 8 + (Epi::SPLIT ? Epi::NST / 2 : Epi::NST);
    Unit cur, nxt; int ui = 0; bool est = false;
    if (!S.next(0, cur)) return;
    f32x4 acc[2][2][4][2];
#pragma unroll
    for (int a = 0; a < 2; ++a)
#pragma unroll
        for (int b = 0; b < 2; ++b)
#pragma unroll
            for (int m = 0; m < 4; ++m)
#pragma unroll
                for (int n = 0; n < 2; ++n) acc[a][b][m][n] = (f32x4){0.f, 0.f, 0.f, 0.f};
    bf16x8 At[4][2], B0[2][2], B1[2][2];
    i32x8_t At8[4], B08[2], B18[2];
    const int sc_w = 0x7A7A7A7A, sc_1 = (0x7F - g.ash) * 0x01010101;
#ifndef MK_GEMMFOLD
#define MK_GEMMFOLD 0
#endif
#define PG8_PM(x) ((MK_GEMMFOLD && dry) ? ((x) & 7) : (x))
    const char* cA = (const char*)g.A + (size_t)PG8_PM(cur.pm) * tstepA + (size_t)(cur.pn >> 2) * g.agrp; const char* cB = (const char*)g.Bt + (size_t)cur.pn * tstepB + (size_t)(cur.pn >> 2) * g.bgrp;
    if constexpr (SP2) {
        PG8_STAGE(PG8_SB(0, 0), cB, voffB); PG8_STAGE(PG8_SB(0, 1), cB + hstepB, voffB); PG8_STAGE(PG8_SA(0, 0), cA, voffA); PG8_STAGE(PG8_SA(0, 1), cA + hstepA, voffA);
        if (wr == 1) PG8_BAR;
        PG8_WAIT_V(2); PG8_BAR;
        PG8_STAGE(PG8_SB(1, 0), cB + kstep, voffB); PG8_STAGE(PG8_SA(1, 0), cA + kstep, voffA); PG8_STAGE(PG8_SB(1, 1), cB + hstepB + kstep, voffB); PG8_STAGE(PG8_SA(1, 1), cA + hstepA + kstep, voffA);
        PG8_WAIT_V(8); PG8_BAR;
    } else {
        PG8_STAGE(PG8_SB(0, 0), cB, voffB); PG8_STAGE(PG8_SA(0, 0), cA, voffA); PG8_STAGE(PG8_SB(0, 1), cB + hstepB, voffB); PG8_STAGE(PG8_SA(0, 1), cA + hstepA, voffA);
        if (wr == 1) PG8_BAR;
        PG8_WAIT_V(4); PG8_BAR;
        PG8_STAGE(PG8_SB(1, 0), cB + kstep, voffB); PG8_STAGE(PG8_SA(1, 0), cA + kstep, voffA); PG8_STAGE(PG8_SB(1, 1), cB + hstepB + kstep, voffB);
        PG8_WAIT_V(6); PG8_BAR;
    }
    for (;;) {
        bool has_next = false; const char* nA = cA; const char* nB = cB;
        if constexpr (!SP2) { has_next = S.next(ui + 1, nxt); if (has_next) { nA = (const char*)g.A + (size_t)PG8_PM(nxt.pm) * tstepA + (size_t)(nxt.pn >> 2) * g.agrp; nB = (const char*)g.Bt + (size_t)nxt.pn * tstepB + (size_t)(nxt.pn >> 2) * g.bgrp; } }
        for (int t = 0; t < nt; t += 2) {
            const bool last = (t == nt - 2);
            [[maybe_unused]] const char* a1 = cA + (size_t)(t + 1) * kstep;
            const bool fe = (t == 0) && est;
            if constexpr (SP2) {
            PG8_LDB(B0, 0, 0); PG8_LDB(B1, 0, 1); PG8_SCHED; PG8_LDA(At, 0, 0);
            PG8_WAIT_VE(W12); PG8_WAIT_L(0); PG8_BAR; PG8_MMA(0, 0, At, B0); PG8_MMA(0, 1, At, B1); PG8_BAR; PG8_SCHED;
            if (t == 0) { has_next = S.next(ui + 1, nxt); if (has_next) { nA = (const char*)g.A + (size_t)PG8_PM(nxt.pm) * tstepA + (size_t)(nxt.pn >> 2) * g.agrp; nB = (const char*)g.Bt + (size_t)nxt.pn * tstepB + (size_t)(nxt.pn >> 2) * g.bgrp; } }
            const char* a2 = last ? nA : cA + (size_t)(t + 2) * kstep; const char* b2 = last ? nB : cB + (size_t)(t + 2) * kstep;
            const char* a3 = a2 + kstep; const char* b3 = b2 + kstep;
            PG8_LDA(At, 0, 1); PG8_STAGE(PG8_SB(0, 0), b2, voffB); PG8_STAGE(PG8_SB(0, 1), b2 + hstepB, voffB); PG8_STAGE(PG8_SA(0, 0), a2, voffA);
            PG8_WAIT_VE(W12); PG8_WAIT_L(0); PG8_BAR; PG8_MMA(1, 0, At, B0); PG8_MMA(1, 1, At, B1); PG8_BAR; PG8_SCHED;
            PG8_LDB(B0, 1, 0); PG8_LDB(B1, 1, 1); PG8_SCHED; PG8_LDA(At, 1, 0); PG8_STAGE(PG8_SA(0, 1), a2 + hstepA, voffA);
            PG8_WAIT_VE(W3); PG8_WAIT_L(0); PG8_BAR; PG8_MMA(0, 0, At, B0); PG8_MMA(0, 1, At, B1); PG8_BAR; PG8_SCHED;
            PG8_LDA(At, 1, 1); PG8_STAGE(PG8_SB(1, 0), b3, voffB); PG8_STAGE(PG8_SB(1, 1), b3 + hstepB, voffB); PG8_STAGE(PG8_SA(1, 0), a3, voffA);
            PG8_WAIT_V(8);
            if constexpr (Epi::SPLIT) { if (last && !dry) { const int te = tid_op(), we = __builtin_amdgcn_readfirstlane(te >> 6), le = te & 63; E.template half<0>(acc, cur, we >> 2, we & 3, le & 15, le >> 4); } }
            PG8_WAIT_L(0); PG8_BAR; PG8_MMA(1, 0, At, B0); PG8_MMA(1, 1, At, B1); PG8_BAR; PG8_SCHED;
            PG8_STAGE(PG8_SA(1, 1), a3 + hstepA, voffA);
            } else {
            const char* a2 = last ? nA : cA + (size_t)(t + 2) * kstep; const char* b2 = last ? nB : cB + (size_t)(t + 2) * kstep;
            const char* a3 = a2 + kstep; const char* b3 = b2 + kstep;
            PG8_LDB(B0, 0, 0); PG8_SCHED; PG8_LDA(At, 0, 0); PG8_STAGE(PG8_SA(1, 1), a1 + hstepA, voffA);
            PG8_WAIT_L(8); PG8_BAR; PG8_WAIT_L(0); PG8_MMA(0, 0, At, B0); PG8_BAR; PG8_SCHED;
            PG8_LDB(B1, 0, 1); PG8_STAGE(PG8_SB(0, 0), b2, voffB);
            PG8_BAR; PG8_WAIT_L(0); PG8_MMA(0, 1, At, B1); PG8_BAR;
            PG8_LDA(At, 0, 1); PG8_STAGE(PG8_SA(0, 0), a2, voffA);
            PG8_BAR; PG8_WAIT_L(0); PG8_MMA(1, 0, At, B0); PG8_BAR; PG8_SCHED;
            PG8_STAGE(PG8_SB(0, 1), b2 + hstepB, voffB);
            PG8_WAIT_V(6); PG8_BAR; PG8_MMA(1, 1, At, B1); PG8_BAR;
            PG8_LDB(B0, 1, 0); PG8_SCHED; PG8_LDA(At, 1, 0); PG8_STAGE(PG8_SA(0, 1), a2 + hstepA, voffA);
            PG8_WAIT_L(8); PG8_BAR; PG8_WAIT_L(0); PG8_MMA(0, 0, At, B0); PG8_BAR; PG8_SCHED;
            PG8_LDB(B1, 1, 1); PG8_STAGE(PG8_SB(1, 0), b3, voffB);
            PG8_BAR; PG8_WAIT_L(0); PG8_MMA(0, 1, At, B1); PG8_BAR;
            PG8_LDA(At, 1, 1); PG8_STAGE(PG8_SA(1, 0), a3, voffA);
            PG8_BAR; PG8_WAIT_L(0); PG8_MMA(1, 0, At, B0); PG8_BAR; PG8_SCHED;
            PG8_STAGE(PG8_SB(1, 1), b3 + hstepB, voffB);
            PG8_WAIT_V(6); PG8_BAR; PG8_MMA(1, 1, At, B1); PG8_BAR;
            }
        }
        if constexpr (ALIGN_EPI) { if (wr == 0) PG8_BAR; }
        if constexpr (F8) asm volatile("s_nop 15\n\ts_nop 15" ::: "memory");
        if (!dry) { const int te = tid_op(), we = __builtin_amdgcn_readfirstlane(te >> 6), le = te & 63;
            if constexpr (Epi::SPLIT) E.template half<1>(acc, cur, we >> 2, we & 3, le & 15, le >> 4); else E(acc, cur, we >> 2, we & 3, le & 15, le >> 4); }
        est = !dry && E.counted(cur);
        if (!has_next) break;
#pragma unroll
        for (int a = 0; a < 2; ++a)
#pragma unroll
            for (int b = 0; b < 2; ++b)
#pragma unroll
                for (int m = 0; m < 4; ++m)
#pragma unroll
                    for (int n = 0; n < 2; ++n) acc[a][b][m][n] = (f32x4){0.f, 0.f, 0.f, 0.f};
        cur = nxt; cA = nA; cB = nB; ++ui;
        if constexpr (ALIGN_EPI) { if (wr == 1) PG8_BAR; }
    }
    PG8_WAIT_V(0);
    if constexpr (!ALIGN_EPI) { if (wr == 0) PG8_BAR; }
    PG8_BAR;
#undef PG8_SA
#undef PG8_SB
#undef PG8_STAGE
#undef PG8_LDA
#undef PG8_LDB
#undef PG8_MMA
#undef PG8_RD
#undef PG8_WAIT_V
#undef PG8_WAIT_VE
#undef PG8_WAIT_L
#undef PG8_BAR
#undef PG8_SCHED
}
}
#ifndef MK_F8_RKV
#define MK_F8_RKV 1
#endif
#ifndef MK_F8_OUT0
#define MK_F8_OUT0 1
#endif
#ifndef MK_F8_OUT1
#define MK_F8_OUT1 1
#endif
enum { I_X = 0, I_C, I_CTX, I_CCTX, I_ADAW, I_ADAB, I_NORMG, I_ROUTER, I_W1, I_W3, I_W2, I_ABIN, I_ABOUT, I_MLGB, I_MLNG, I_CONVW, I_CONVB, I_DTB, I_ALOG, I_SSD, I_SSNG,
       I_MU, I_WR, I_WK, I_WV, I_WO, I_W0, I_RW1, I_RW2, I_A0, I_A1, I_A2, I_G1, I_G2, I_KK, I_KA, I_RK, I_LNG, I_LNB, N_IN };
struct Args { const float* in[N_IN]; float* out; unsigned char* ws; int ph_lo, ph_hi; };
DI const float* inp(int i) { return ((const float* const volatile __attribute__((address_space(4)))*)__builtin_amdgcn_kernarg_segment_ptr())[i]; }

constexpr int LDS_BYTES = 163840;
constexpr int LDS_BARW = 163824;

DI const float* modp(const Args& a, int layer, int s, int n) { return (const float*)(a.ws + WS_MOD) + ((size_t)(layer * 9 + s) * 6 + n) * 1024; }
DI int row_mod_s(int row) { return row < NL ? (row >> 13) : 8; }

constexpr int CVT_KT = 256;
template <class F> DI void cvt_tile(LAS bf16_t* tl, bf16_t* dst, int ldk, int n0, int k0, F f) {
    const int tid = tid_op();
    float v[CVT_KT / 8];
#pragma unroll
    for (int p = 0; p < CVT_KT / 8; ++p) { const int kl = p * 8 + (tid >> 6), nl = tid & 63; v[p] = f(k0 + kl, n0 + nl); }
#pragma unroll
    for (int p = 0; p < CVT_KT / 8; ++p) { const int kl = p * 8 + (tid >> 6), nl = tid & 63; tl[nl * (CVT_KT + 8) + kl] = f2bf(v[p]); }
    __syncthreads();
#pragma unroll
    for (int q = 0; q < CVT_KT / 64; ++q) { const int nl = tid >> 3, kc = (tid & 7) + 8 * q; const u32x4 w = *(const LAS u32x4*)(tl + nl * (CVT_KT + 8) + kc * 8); *(u32x4*)(dst + (size_t)(n0 + nl) * ldk + k0 + kc * 8) = w; }
    __syncthreads();
}

DI void cvt_tile_f8(LAS unsigned char* tl, const float* src, int ld, int c0, int k0, unsigned char* dst, int ldk, int n0, bool zero) {
    const int tid = tid_op(), f4 = tid & 15, kq = tid >> 4;
    if (!zero) {
        f32x4 v[4];
#pragma unroll
        for (int j = 0; j < 4; ++j) v[j] = *(const f32x4*)(src + (size_t)(k0 + kq + 32 * j) * ld + c0 + 4 * f4);
#pragma unroll
        for (int j = 0; j < 4; ++j)
#pragma unroll
            for (int i = 0; i < 4; ++i) tl[(4 * f4 + i) * 144 + kq + 32 * j] = (unsigned char)(pk_fp8x4(v[j][i] * 32.f, 0.f, 0.f, 0.f) & 0xffu);
    }
    __syncthreads();
    { const int nl = tid >> 3, pc = tid & 7; u32x4 w = (u32x4){0u, 0u, 0u, 0u}; if (!zero) w = *(const LAS u32x4*)(tl + nl * 144 + pc * 16);
      *(u32x4*)(dst + (size_t)(n0 + nl) * ldk + k0 + pc * 16) = w; }
    __syncthreads();
}
constexpr int IT_MOD = 192;
constexpr int IT_WIN = 92 * (1024 / CVT_KT), IT_WOUT = MK_F8_OUT0 ? 16 * 16 : 16 * (2048 / CVT_KT), IT_WRW = MK_F8_RKV ? 48 * 8 + 8 * (2048 / CVT_KT) : 56 * (2048 / CVT_KT), IT_WO = MK_F8_OUT1 ? 16 * 8 : 16 * (1024 / CVT_KT), IT_W2A = 48 * (256 / CVT_KT), IT_G2 = 16 * (256 / CVT_KT);
constexpr int IT_P0A = IT_MOD + IT_WIN + IT_WOUT + IT_WRW + IT_WO + IT_W2A + IT_G2;

DI void mod_item(const Args& a, LAS unsigned char* lds, int item) {
    LAS float* sc = (LAS float*)lds;
    LAS float* red = sc + 9 * 1024;
    const int tid = tid_op(), l = item / 96, cg = item % 96;
    const float* pc = inp(I_C); const float* pcc = inp(I_CCTX); const float* padab = inp(I_ADAB);
    for (int i = tid; i < 9 * 1024; i += 512) { const int s = i >> 10, k = i & 1023; const float c = (s < 8) ? pc[s * 1024 + k] : pcc[k]; sc[i] = siluf_(c); }
    __syncthreads();
    const int col = tid & 63, ks = tid >> 6;
    float acc[9];
#pragma unroll
    for (int s = 0; s < 9; ++s) acc[s] = 0.f;
    const float* w = inp(I_ADAW) + (size_t)l * 1024 * 6144 + cg * 64 + col;
    for (int kb = 0; kb < 128; kb += 32) { float wv[32];
#pragma unroll
        for (int j = 0; j < 32; ++j) wv[j] = w[(size_t)(ks * 128 + kb + j) * 6144];
#pragma unroll
        for (int j = 0; j < 32; ++j) { const int k = ks * 128 + kb + j;
#pragma unroll
            for (int s = 0; s < 9; ++s) acc[s] += sc[s * 1024 + k] * wv[j]; } }
#pragma unroll
    for (int s = 0; s < 9; ++s) red[(ks * 9 + s) * 64 + col] = acc[s];
    __syncthreads();
    for (int i = tid; i < 9 * 64; i += 512) { const int s = i >> 6, c = i & 63; float v = padab[l * 6144 + cg * 64 + c];
#pragma unroll
        for (int k2 = 0; k2 < 8; ++k2) v += red[(k2 * 9 + s) * 64 + c];
        ((float*)(a.ws + WS_MOD))[(size_t)(l * 9 + s) * 6144 + cg * 64 + c] = v; }
    __syncthreads();
}

DI void p0a_phase(const Args& a, LAS unsigned char* lds) {
    LAS bf16_t* tl = (LAS bf16_t*)lds;
    for (int item = blockIdx.x; item < IT_P0A; item += gridDim.x) {
        int it = item;
        if (it < IT_MOD) { mod_item(a, lds, it); continue; }
        it -= IT_MOD;
        if (it < IT_WIN) { const int n0 = (it % 92) * 64, k0 = (it / 92) * CVT_KT; const float* src = inp(I_ABIN);
            cvt_tile(tl, (bf16_t*)(a.ws + WS_WIN), 1024, n0, k0, [&](int k, int n) -> float {
                if (n >= 5680) return 0.f;
                const int col = n < 3072 ? n : (n < 5632 ? n + 16 : (n < 5648 ? n - 2560 : n));
                const float v = src[(size_t)k * 5680 + col];
                return (n >= 512 && n < 1024) ? v * 0.08838834764831845f : v; });
            continue; }
        it -= IT_WIN;
        if (it < IT_WOUT) { const float* src = inp(I_ABOUT);
            if (MK_F8_OUT0) { const int n0 = (it % 16) * 64, k0 = (it / 16) * 128; cvt_tile_f8(lds, src, 1024, n0, k0, a.ws + WS_WOUT, 2048, n0, false); }
            else { const int n0 = (it % 16) * 64, k0 = (it / 16) * CVT_KT;
            cvt_tile(tl, (bf16_t*)(a.ws + WS_WOUT), 2048, n0, k0, [&](int k, int n) -> float { return src[(size_t)k * 1024 + n]; }); }
            continue; }
        it -= IT_WOUT;
        if (MK_F8_RKV && it < 48 * 8) {
            const int nt_ = it % 48, k0 = (it / 48) * 128, grp = nt_ >> 4, n0 = (nt_ & 15) * 64; const float* src = grp == 0 ? inp(I_WR) : (grp == 1 ? inp(I_WK) : inp(I_WV));
            cvt_tile_f8(lds, src, 1024, n0, k0, a.ws + WS_WRW + (size_t)grp * 1024 * 4096, 4096, n0, false); continue; }
        if (it < IT_WRW) { const int itl = MK_F8_RKV ? it - 48 * 8 : it, ntl = MK_F8_RKV ? 8 : 56; const int n0 = (MK_F8_RKV ? 3072 : 0) + (itl % ntl) * 64, k0 = (itl / ntl) * CVT_KT; const float* mu = inp(I_MU);
            const float *wr = inp(I_WR), *wk = inp(I_WK), *wv = inp(I_WV), *w1 = inp(I_RW1), *a1 = inp(I_A1), *g1 = inp(I_G1);
            cvt_tile(tl, (bf16_t*)(a.ws + WS_WRW), 2048, n0, k0, [&](int k, int n) -> float {
                const int kk = k & 1023; float w; int mi;
                if (n < 1024) { w = wr[(size_t)kk * 1024 + n]; mi = 0; }
                else if (n < 2048) { w = wk[(size_t)kk * 1024 + n - 1024]; mi = 2; }
                else if (n < 3072) { w = wv[(size_t)kk * 1024 + n - 2048]; mi = 3; }
                else if (n < 3136) { w = w1[(size_t)kk * 64 + n - 3072]; mi = 1; }
                else if (n < 3200) { w = w1[(size_t)(1024 + kk) * 64 + n - 3136]; mi = 1; }
                else if (n < 3264) { w = a1[(size_t)kk * 64 + n - 3200]; mi = 4; }
                else if (n < 3328) return 0.f;
                else if (n < 3488) { w = g1[(size_t)kk * 160 + n - 3328]; mi = 5; }
                else return 0.f;
                if (n < 3072) return k < 1024 ? w : 0.f;
                const float m = mu[mi * 1024 + kk];
                return w * (k >= 1024 ? m : 1.f - m); });
            continue; }
        it -= IT_WRW;
        if (it < IT_WO) { const float* src = inp(I_WO);
            if (MK_F8_OUT1) { const int n0 = (it % 16) * 64, k0 = (it / 16) * 128; cvt_tile_f8(lds, src, 1024, n0, k0, a.ws + WS_WO, 1024, n0, false); }
            else { const int n0 = (it % 16) * 64, k0 = (it / 16) * CVT_KT;
            cvt_tile(tl, (bf16_t*)(a.ws + WS_WO), 1024, n0, k0, [&](int k, int n) -> float { return src[(size_t)k * 1024 + n]; }); }
            continue; }
        it -= IT_WO;
        if (it < IT_W2A) { const int n0 = (it % 48) * 64, k0 = (it / 48) * CVT_KT; const float *w2 = inp(I_RW2), *a2 = inp(I_A2);
            cvt_tile(tl, (bf16_t*)(a.ws + WS_W2A), 256, n0, k0, [&](int k, int n) -> float {
                if (n < 1024) return k < 64 ? w2[(size_t)k * 1024 + n] : 0.f;
                if (n < 2048) return (k >= 64 && k < 128) ? w2[(size_t)k * 1024 + n - 1024] : 0.f;
                return (k >= 128 && k < 192) ? a2[(size_t)(k - 128) * 1024 + n - 2048] : 0.f; });
            continue; }
        it -= IT_W2A;
        { const int n0 = (it % 16) * 64, k0 = (it / 16) * CVT_KT; const float* g2 = inp(I_G2);
            cvt_tile(tl, (bf16_t*)(a.ws + WS_G2), 256, n0, k0, [&](int k, int n) -> float { return k < 160 ? g2[(size_t)k * 1024 + n] : 0.f; }); }
    }
}

constexpr int IT_W13 = 16 * 44 * 8, IT_W2E = 16 * 16 * 12;
constexpr size_t W13_BYTES = (size_t)16 * 2816 * 1024;
constexpr int FFP = 1536;
DI void expert_cvt_items(const Args& a, LAS unsigned char* lds, int layer, unsigned char* dst, int max_tiles = 1 << 30) {
    const float* pw1 = inp(I_W1); const float* pw3 = inp(I_W3); const float* pw2 = inp(I_W2);
    unsigned* q = (unsigned*)(a.ws + WS_CTL + 32768) + 64 * layer;
    LAS unsigned* slot = (LAS unsigned*)(lds + 16384);
    for (int n = 0; n < max_tiles; ++n) {
        if (threadIdx.x == 0) *slot = __hip_atomic_fetch_add(q, 1u, __ATOMIC_RELAXED, __HIP_MEMORY_SCOPE_AGENT);
        __syncthreads();
        const int item = (int)*slot;
        __syncthreads();
        if (item >= IT_W13 + IT_W2E) break;
        if (item < IT_W13) { const int e = item / 352, r = item % 352, nt = r % 44, k0 = (r / 44) * 128;
            const int tile = nt >> 2, half = (nt >> 1) & 1, c0 = tile * 128 + (nt & 1) * 64;
            const float* src = (half ? pw3 : pw1) + (size_t)(layer * 16 + e) * 1024 * 1408;
            cvt_tile_f8(lds, src, 1408, c0, k0, dst + (size_t)e * 2816 * 1024, 1024, nt * 64, false);
        } else { const int it = item - IT_W13, e = it / 192, r = it % 192, nt = r % 16, kt = r / 16;
            const float* src = pw2 + (size_t)(layer * 16 + e) * 1408 * 1024;
            cvt_tile_f8(lds, src, 1024, nt * 64, kt * 128, dst + W13_BYTES + (size_t)e * 1024 * FFP, FFP, nt * 64, kt == 11);
        }
    }
}

DI void ld_row_f32(const float* p, int lane, f32x4 (&v)[4]) {
#pragma unroll
    for (int i = 0; i < 4; ++i) v[i] = *(const f32x4*)(p + i * 256 + lane * 4);
}
DI void ld_row_bf16(const bf16_t* p, int lane, f32x4 (&v)[4]) {
#pragma unroll
    for (int i = 0; i < 4; ++i) { const u32x2 w = *(const u32x2*)(p + i * 256 + lane * 4); v[i] = (f32x4){bflo(w.x), bfhi(w.x), bflo(w.y), bfhi(w.y)}; }
}
DI void ld_row_raw(const bf16_t* p, int lane, u32x2 (&v)[4]) {
#pragma unroll
    for (int i = 0; i < 4; ++i) v[i] = *(const u32x2*)(p + i * 256 + lane * 4);
}
DI void cvt_row(const u32x2 (&w)[4], f32x4 (&v)[4]) {
#pragma unroll
    for (int i = 0; i < 4; ++i) v[i] = (f32x4){bflo(w[i].x), bfhi(w[i].x), bflo(w[i].y), bfhi(w[i].y)};
}
DI void st_row_bf16(bf16_t* p, int lane, const f32x4 (&v)[4]) {
#pragma unroll
    for (int i = 0; i < 4; ++i) { u32x2 w; w.x = pkbf(v[i][0], v[i][1]); w.y = pkbf(v[i][2], v[i][3]); *(u32x2*)(p + i * 256 + lane * 4) = w; }
}
constexpr float F8_ACT = 8.f; constexpr int F8_ACT_SH = 3;
constexpr float F8_HID = 4.f; constexpr int F8_HID_SH = 2;
DI void st_row_f8(unsigned char* p, int lane, const f32x4 (&v)[4]) {
#pragma unroll
    for (int i = 0; i < 4; ++i) *(unsigned*)(p + i * 256 + lane * 4) = pk_fp8x4(v[i][0] * F8_ACT, v[i][1] * F8_ACT, v[i][2] * F8_ACT, v[i][3] * F8_ACT);
}
DI float sumsq4(const f32x4 (&v)[4]) { float s = 0.f;
#pragma unroll
    for (int i = 0; i < 4; ++i) s += (v[i][0] * v[i][0] + v[i][1] * v[i][1]) + (v[i][2] * v[i][2] + v[i][3] * v[i][3]);
    return s; }
DI void norm_mod(const f32x4 (&x)[4], const float* g, const float* shift, const float* scale, int lane, f32x4 (&h)[4]) {
    const float r = rsqrtf(wave_sum(sumsq4(x)) * (1.f / 1024.f) + RMS_EPS);
#pragma unroll
    for (int i = 0; i < 4; ++i) { const int c = i * 256 + lane * 4; const f32x4 gv = *(const f32x4*)(g + c), sh = *(const f32x4*)(shift + c), sc = *(const f32x4*)(scale + c);
        h[i] = x[i] * r * gv * (sc + 1.f) + sh; }
}

DI void p0b_phase(const Args& a, bf16_t* hbuf) {
    const int tid_ = tid_op(), lane = tid_ & 63, wid = tid_ >> 6;
    const float* px = inp(I_X); const float* pctx = inp(I_CTX); const float* png = inp(I_NORMG);
    const int stride = gridDim.x * 8;
    int row = blockIdx.x * 8 + wid;
    f32x4 x[4];
    if (row < NR) ld_row_f32(row < NL ? px + (size_t)row * 1024 : pctx + (size_t)(row - NL) * 1024, lane, x);
    for (; row < NR; row += stride) {
        f32x4 xn[4], h[4]; const int nr = row + stride;
#pragma unroll
        for (int i = 0; i < 4; ++i) xn[i] = x[i];
        if (nr < NR) ld_row_f32(nr < NL ? px + (size_t)nr * 1024 : pctx + (size_t)(nr - NL) * 1024, lane, xn);
        const int s = row_mod_s(row);
        norm_mod(x, png, modp(a, 0, s, 0), modp(a, 0, s, 1), lane, h);
        st_row_bf16(hbuf + (size_t)row * 1024, lane, h);
#pragma unroll
        for (int i = 0; i < 4; ++i) x[i] = xn[i];
    }
}

typedef pg8::Unit Unit;
DI u32x4 pack_acc(const f32x4 v0, const f32x4 v1) { u32x4 w; w.x = pkbf(v0[0], v0[1]); w.y = pkbf(v0[2], v0[3]); w.z = pkbf(v1[0], v1[1]); w.w = pkbf(v1[2], v1[3]); return w; }

struct EpiProj {
    static constexpr bool PERM = true; static constexpr bool SPLIT = MK_SPLIT; static constexpr int NST = 16; DI bool counted(const Unit& u) const { return u.pn < 22; }
    unsigned char* ws; float* GD;
    template <int ai> DI void half(const f32x4 (&acc)[2][2][4][2], const Unit& u, int wr, int wc, int fr, int fq) const {
        const int row0 = u.pm * 256 + wr * 64 + fr, pn = u.pn;
        if (pn < 22) {
            const int slot = pn < 4 ? 1 : pn < 8 ? 4 : pn < 16 ? 5 : 2, first = pn < 4 ? 0 : pn < 8 ? 4 : pn < 16 ? 8 : 16, ldc = pn < 8 ? 1024 : pn < 16 ? 2048 : 1536;
            bf16_t* base = (bf16_t*)(ws + slot_off(slot));
            const int col0 = (pn - first) * 256 + wc * 32 + 8 * fq;
#pragma unroll
            for (int m = 0; m < 4; ++m) { bf16_t* rowp = base + (size_t)(row0 + ai * 128 + m * 16) * ldc + col0;
#pragma unroll
                for (int bj = 0; bj < 2; ++bj) *(u32x4*)(rowp + bj * 128) = pack_acc(acc[ai][bj][m][0], acc[ai][bj][m][1]); }
        } else if (wc * 32 + 8 * fq < 48) {
            const int c0 = wc * 32 + 8 * fq;
#pragma unroll
            for (int m = 0; m < 4; ++m) { float* rowp = GD + (size_t)(row0 + ai * 128 + m * 16) * 48 + c0;
                *(f32x4*)(rowp) = acc[ai][0][m][0]; *(f32x4*)(rowp + 4) = acc[ai][0][m][1]; }
        }
    }
    DI void operator()(const f32x4 (&acc)[2][2][4][2], const Unit& u, int wr, int wc, int fr, int fq) const { half<0>(acc, u, wr, wc, fr, fq); half<1>(acc, u, wr, wc, fr, fq); }
};
struct EpiPlain {
    static constexpr bool PERM = true; static constexpr bool SPLIT = MK_SPLIT; static constexpr int NST = 16; DI bool counted(const Unit& u) const { return true; }
    bf16_t* O; int ldc;
    template <int ai> DI void half(const f32x4 (&acc)[2][2][4][2], const Unit& u, int wr, int wc, int fr, int fq) const {
        const int row0 = u.pm * 256 + wr * 64 + fr, col0 = u.pn * 256 + wc * 32 + 8 * fq;
#pragma unroll
        for (int m = 0; m < 4; ++m) { bf16_t* rowp = O + (size_t)(row0 + ai * 128 + m * 16) * ldc + col0;
#pragma unroll
            for (int bj = 0; bj < 2; ++bj) *(u32x4*)(rowp + bj * 128) = pack_acc(acc[ai][bj][m][0], acc[ai][bj][m][1]); }
    }
    DI void operator()(const f32x4 (&acc)[2][2][4][2], const Unit& u, int wr, int wc, int fr, int fq) const { half<0>(acc, u, wr, wc, fr, fq); half<1>(acc, u, wr, wc, fr, fq); }
};
struct EpiPlainG {
    static constexpr bool PERM = true; static constexpr bool SPLIT = MK_SPLIT; static constexpr int NST = 16; DI bool counted(const Unit& u) const { return true; }
    bf16_t* O;
    template <int ai> DI void half(const f32x4 (&acc)[2][2][4][2], const Unit& u, int wr, int wc, int fr, int fq) const {
        const int row0 = u.pm * 256 + wr * 64 + fr, col0 = (u.pn & 3) * 256 + wc * 32 + 8 * fq;
        bf16_t* base = O + (size_t)(u.pn >> 2) * (USZ / 2);
#pragma unroll
        for (int m = 0; m < 4; ++m) { bf16_t* rowp = base + (size_t)(row0 + ai * 128 + m * 16) * 1024 + col0;
#pragma unroll
            for (int bj = 0; bj < 2; ++bj) *(u32x4*)(rowp + bj * 128) = pack_acc(acc[ai][bj][m][0], acc[ai][bj][m][1]); }
    }
    DI void operator()(const f32x4 (&acc)[2][2][4][2], const Unit& u, int wr, int wc, int fr, int fq) const { half<0>(acc, u, wr, wc, fr, fq); half<1>(acc, u, wr, wc, fr, fq); }
};
struct EpiSwiglu {
    static constexpr bool PERM = true; static constexpr bool SPLIT = MK_SPLIT_SWIGLU; static constexpr int NST = 8; DI bool counted(const Unit& u) const { return true; }
    unsigned char* HID;
    DI void operator()(const f32x4 (&acc)[2][2][4][2], const Unit& u, int wr, int wc, int fr, int fq) const { half<0>(acc, u, wr, wc, fr, fq); half<1>(acc, u, wr, wc, fr, fq); }
    template <int ai> DI void half(const f32x4 (&acc)[2][2][4][2], const Unit& u, int wr, int wc, int fr, int fq) const {
        const int row0 = u.pm * 256 + wr * 64 + fr, t = u.pn % 11, col0 = t * 128 + wc * 32 + 8 * fq;
        {
#pragma unroll
            for (int m = 0; m < 4; ++m) { f32x4 h0, h1;
#pragma unroll
                for (int j = 0; j < 4; ++j) { h0[j] = siluf_(acc[ai][0][m][0][j]) * acc[ai][1][m][0][j] * F8_HID; h1[j] = siluf_(acc[ai][0][m][1][j]) * acc[ai][1][m][1][j] * F8_HID; }
                unsigned char* rp = HID + (size_t)(row0 + ai * 128 + m * 16) * FFP + col0;
                u32x2 w; w.x = pk_fp8x4(h0[0], h0[1], h0[2], h0[3]); w.y = pk_fp8x4(h1[0], h1[1], h1[2], h1[3]); *(u32x2*)rp = w;
                if (t == 10) *(u32x2*)(rp + 128) = (u32x2){0u, 0u}; }
        }
    }
};
struct EpiGate {
    static constexpr bool PERM = true; static constexpr bool SPLIT = false; static constexpr int NST = 16; DI bool counted(const Unit& u) const { return true; }
    bf16_t* Y; const float* gate;
    DI void operator()(const f32x4 (&acc)[2][2][4][2], const Unit& u, int wr, int wc, int fr, int fq) const {
        const int row0 = u.pm * 256 + wr * 64 + fr, col0 = (u.pn & 3) * 256 + wc * 32 + 8 * fq;
#pragma unroll
        for (int ai = 0; ai < 2; ++ai)
#pragma unroll
            for (int m = 0; m < 4; ++m) { const int row = row0 + ai * 128 + m * 16; const float gv = gate[row]; bf16_t* rowp = Y + (size_t)row * 1024 + col0;
#pragma unroll
                for (int bj = 0; bj < 2; ++bj) *(u32x4*)(rowp + bj * 128) = pack_acc(acc[ai][bj][m][0] * gv, acc[ai][bj][m][1] * gv); }
    }
};
DI void cv_unpack(const u32x4 w, float (&f)[8]) { unpack8(w, f); }
DI void conv_phase(const Args& a, LAS unsigned char* lds, const bf16_t* XBC, bf16_t* XC) {
    const int tid = tid_op(), ch = tid & 7, x = tid >> 3;
    const float* pw = inp(I_CONVW); const float* pb = inp(I_CONVB);
    for (int item = blockIdx.x; item < 768 + 768; item += gridDim.x) {
        const bool lat = item < 768; const int it = lat ? item : item - 768, seg = it & 3, cg = (it >> 2) % 24, b = (it >> 2) / 24, c0 = (cg * 8 + ch) * 8;
        float w[9][8], acc0[8];
#pragma unroll
        for (int t = 0; t < 9; ++t) { const f32x4 w0 = *(const f32x4*)(pw + t * 1536 + c0), w1 = *(const f32x4*)(pw + t * 1536 + c0 + 4);
#pragma unroll
            for (int j = 0; j < 4; ++j) { w[t][j] = w0[j]; w[t][4 + j] = w1[j]; } }
        { const f32x4 b0 = *(const f32x4*)(pb + c0), b1 = *(const f32x4*)(pb + c0 + 4);
#pragma unroll
          for (int j = 0; j < 4; ++j) { acc0[j] = b0[j]; acc0[4 + j] = b1[j]; } }
        const u32x4 z4 = (u32x4){0u, 0u, 0u, 0u};
        if (lat) {
            const int y0 = seg * 32; const bf16_t* base = XBC + (size_t)(b * T) * 1536 + c0;
            auto ldrow = [&](int y, u32x4 (&r)[3]) {
                const bool yok = (y >= 0) && (y < 128); const bf16_t* p = base + (size_t)(y * 64 + x) * 1536;
                r[0] = (yok && x > 0) ? *(const u32x4*)(p - 1536) : z4; r[1] = yok ? *(const u32x4*)p : z4; r[2] = (yok && x < 63) ? *(const u32x4*)(p + 1536) : z4; };
            float ra[3][8], rb[3][8], rc[3][8]; u32x4 raw[3];
            ldrow(y0 - 1, raw);
#pragma unroll
            for (int d = 0; d < 3; ++d) cv_unpack(raw[d], ra[d]);
            ldrow(y0, raw);
#pragma unroll
            for (int d = 0; d < 3; ++d) cv_unpack(raw[d], rb[d]);
            ldrow(y0 + 1, raw);
            for (int yy = 0; yy < 32; ++yy) {
                const int y = y0 + yy;
#pragma unroll
                for (int d = 0; d < 3; ++d) cv_unpack(raw[d], rc[d]);
                ldrow(y + 2, raw);
                float acc[8];
#pragma unroll
                for (int j = 0; j < 8; ++j) { float s = acc0[j];
#pragma unroll
                    for (int d = 0; d < 3; ++d) s += w[d][j] * ra[d][j] + w[3 + d][j] * rb[d][j] + w[6 + d][j] * rc[d][j];
                    acc[j] = siluf_(s); }
                *(u32x4*)(XC + (size_t)(b * T + y * 64 + x) * 1536 + c0) = pack8(acc);
#pragma unroll
                for (int d = 0; d < 3; ++d)
#pragma unroll
                    for (int j = 0; j < 8; ++j) { ra[d][j] = rb[d][j]; rb[d][j] = rc[d][j]; }
            }
        } else {
            const int tt = seg * 64 + x; const bf16_t* p = XBC + (size_t)(NL + b * TC + tt) * 1536 + c0;
            const u32x4 r0 = tt > 0 ? *(const u32x4*)(p - 1536) : z4, r1 = *(const u32x4*)p, r2 = tt < TC - 1 ? *(const u32x4*)(p + 1536) : z4;
            float f0[8], f1[8], f2[8], acc[8]; unpack8(r0, f0); unpack8(r1, f1); unpack8(r2, f2);
#pragma unroll
            for (int j = 0; j < 8; ++j) acc[j] = siluf_(acc0[j] + w[3][j] * f0[j] + w[4][j] * f1[j] + w[5][j] * f2[j]);
            *(u32x4*)(XC + (size_t)(NL + b * TC + tt) * 1536 + c0) = pack8(acc);
        }
    }
}

#define MFMA16(a, b, c) __builtin_amdgcn_mfma_f32_16x16x32_bf16((a), (b), (c), 0, 0, 0)
constexpr int MP = 136;
constexpr int SP = 72;
DI float rdlane(float x, int l) { return __int_as_float(__builtin_amdgcn_readlane(__float_as_int(x), l)); }
DI bf16x8 ld_frag(const LAS bf16_t* p) { return *(const LAS bf16x8*)p; }
DI bf16x8 ld_frag2(const LAS bf16_t* p) {
    const u32x2 lo = *(const LAS u32x2*)p, hi = *(const LAS u32x2*)(p + 16); u32x4 w; w.x = lo.x; w.y = lo.y; w.z = hi.x; w.w = hi.y; return __builtin_bit_cast(bf16x8, w); }
DI bf16x8 pack_frag(const float (&p)[8]) { return __builtin_bit_cast(bf16x8, pack8(p)); }

constexpr int VP = 80;
typedef short s16x4 __attribute__((ext_vector_type(4)));
DI s16x4 ld_tr4(const LAS unsigned char* p) { return __builtin_amdgcn_ds_read_tr16_b64_v4i16((LAS s16x4*)p); }
DI bf16x8 ld_tr8(const LAS unsigned char* p, int second) { const s16x4 lo = ld_tr4(p), hi = ld_tr4(p + second); return __builtin_shufflevector(lo, hi, 0, 1, 2, 3, 4, 5, 6, 7); }
constexpr int ML_KS = 0, ML_VS = 128 * MP * 2, ML_CB = ML_VS + 128 * VP * 2, ML_F = ML_CB + 80 * MP * 2;
template <int SKIP = 0> DI void mlstm_item(const Args& a, LAS unsigned char* lds, int item, const bf16_t* QK, const bf16_t* V, const float* GD, bf16_t* HM) {
    const int tid = tid_op(), lane = tid & 63, wid = __builtin_amdgcn_readfirstlane(tid >> 6), fr = lane & 15, fq = lane >> 4;
    const int b = item >> 4, h = (item >> 2) & 3, vs = item & 3;
    LAS bf16_t* Ks = (LAS bf16_t*)(lds + ML_KS); LAS bf16_t* Vs = (LAS bf16_t*)(lds + ML_VS); LAS bf16_t* Cb = (LAS bf16_t*)(lds + ML_CB);
    LAS float* fb = (LAS float*)(lds + ML_F);
    const int J = wid < 4 ? wid : 11 - wid;
    const int jj = 16 * J + fr;
    constexpr int YP = 68, ML_YB = ML_F + 2048;
    const int orow = tid >> 3, opc = tid & 7;
    for (int i = tid; i < 128 * 16; i += 512) Vs[(i >> 4) * VP + 64 + (i & 15)] = ((i & 15) == 0) ? (bf16_t)0x3F80 : (bf16_t)0;
    const float* pgb = inp(I_MLGB);
    for (int dir = 0; dir < 2; ++dir) {
        f32x4 accC[5];
#pragma unroll
        for (int vt = 0; vt < 5; ++vt) accC[vt] = (f32x4){0.f, 0.f, 0.f, 0.f};
        for (int i = tid; i < 80 * MP; i += 512) Cb[i] = 0;
        const float gbi = pgb[dir * 8 + h], gbf = pgb[dir * 8 + 4 + h];
        const int sg = dir == 0 ? 1 : -1;
        auto r0_of = [&](int c) -> int { const bool isc = c < 2; const int cc = isc ? c : c - 2, n = isc ? TC : T, rbase = isc ? NL + b * TC : b * T; return rbase + (dir == 0 ? cc * 128 : n - 1 - cc * 128); };
        u32x4 kreg[4], vreg[2]; bf16x8 qn[4]; float graw[4] = {0.f, 0.f, 0.f, 0.f};
        const int sr = tid & 31, ch = tid >> 5;
        const int vr = tid >> 2, vc = tid & 3;
        auto issue = [&](int c) { const int r0 = r0_of(c); const size_t jrow = (size_t)(r0 + sg * jj);
#pragma unroll
            for (int i = 0; i < 4; ++i) { const size_t srow = (size_t)(r0 + sg * (4 * sr + i)); kreg[i] = *(const u32x4*)(QK + srow * 1024 + 512 + h * 128 + ch * 8); }
            { const bf16_t* pv = V + (size_t)(r0 + sg * vr) * 1024 + h * 256 + vs * 64 + vc * 16; vreg[0] = *(const u32x4*)pv; vreg[1] = *(const u32x4*)(pv + 8); }
#pragma unroll
            for (int kk = 0; kk < 4; ++kk) qn[kk] = *(const bf16x8*)(QK + jrow * 1024 + h * 128 + kk * 32 + fq * 8);
            if (wid == 0) { const float* g0 = GD + (size_t)(r0 + sg * (2 * lane)) * 48 + dir * 8 + h; const float* g1 = GD + (size_t)(r0 + sg * (2 * lane + 1)) * 48 + dir * 8 + h;
                graw[0] = g0[0]; graw[1] = g0[4]; graw[2] = g1[0]; graw[3] = g1[4]; } };
        auto gates = [&]() {
            const float ig0 = graw[0] + gbi, ig1 = graw[2] + gbi, lf0 = -softplusf_(-(graw[1] + gbf)), lf1 = -softplusf_(-(graw[3] + gbf));
            const float s = wave_incl_scan(lf0 + lf1);
            const float bend = rdlane(s, 63), b1 = s, b0 = s - lf1;
            fb[2 * lane] = b0; fb[2 * lane + 1] = b1; fb[128 + 2 * lane] = ig0 - b0; fb[128 + 2 * lane + 1] = ig1 - b1;
            fb[256 + 2 * lane] = __expf(bend - b0 + ig0); fb[256 + 2 * lane + 1] = __expf(bend - b1 + ig1);
            if (lane == 0) fb[384] = bend; };
        u32x4 oldv[2];
        auto writeout = [&](int c) {
            const int r0w = r0_of(c);
#pragma unroll
            for (int q = 0; q < 2; ++q) { const int row = orow + 64 * q; const LAS bf16_t* yb = (const LAS bf16_t*)(lds + ML_YB) + row * YP + opc * 8;
                const u32x2 lo = *(const LAS u32x2*)yb, hi = *(const LAS u32x2*)(yb + 4); u32x4 w; w.x = lo.x; w.y = lo.y; w.z = hi.x; w.w = hi.y;
                if (dir == 1) { float f[8], o[8]; unpack8(w, f); unpack8(oldv[q], o);
#pragma unroll
                    for (int j = 0; j < 8; ++j) f[j] += o[j];
                    w = pack8(f); }
                if (!(SKIP & 1)) *(u32x4*)(HM + (size_t)(r0w + sg * row) * 1024 + h * 256 + vs * 64 + opc * 8) = w; } };
        issue(0);
        if (wid == 0) gates();
        for (int c = 0; c < 66; ++c) {
            const int r0 = r0_of(c);
            lds_barrier();
            if (!(SKIP & 2)) {
#pragma unroll
                for (int i = 0; i < 4; ++i) *(LAS u32x4*)(Ks + (4 * sr + i) * MP + ch * 8) = kreg[i];
                *(LAS u32x4*)(Vs + vr * VP + vc * 16) = vreg[0]; *(LAS u32x4*)(Vs + vr * VP + vc * 16 + 8) = vreg[1]; }
            bf16x8 qf[4];
#pragma unroll
            for (int kk = 0; kk < 4; ++kk) qf[kk] = qn[kk];
            lds_barrier();
            if (c + 1 < 66) issue(c + 1);
            if (dir == 1 && !(SKIP & 1)) {
#pragma unroll
                for (int q = 0; q < 2; ++q) oldv[q] = *(const u32x4*)(HM + (size_t)(r0 + sg * (orow + 64 * q)) * 1024 + h * 256 + vs * 64 + opc * 8); }
            if (!(SKIP & 4)) {
            f32x4 as[8];
#pragma unroll
            for (int st = 0; st < 8; ++st) { as[st] = (f32x4){0.f, 0.f, 0.f, 0.f};
                if (st <= J) {
#pragma unroll
                for (int kk = 0; kk < 4; ++kk) as[st] = MFMA16(ld_frag(Ks + (16 * st + fr) * MP + kk * 32 + fq * 8), qf[kk], as[st]); } }
            const float bj = fb[jj];
            bf16x8 pf[4];
#pragma unroll
            for (int kk = 0; kk < 4; ++kk) { float p[8];
#pragma unroll
                for (int hf = 0; hf < 2; ++hf) { const int st = 2 * kk + hf, s0 = 16 * st + 4 * fq;
                    if (st < J) { const f32x4 ev = *(const LAS f32x4*)(fb + 128 + s0);
#pragma unroll
                        for (int i = 0; i < 4; ++i) p[hf * 4 + i] = as[st][i] * __expf(bj + ev[i]); }
                    else if (st == J) { const f32x4 ev = *(const LAS f32x4*)(fb + 128 + s0);
#pragma unroll
                        for (int i = 0; i < 4; ++i) p[hf * 4 + i] = (4 * fq + i <= fr) ? as[st][i] * __expf(bj + ev[i]) : 0.f; }
                    else {
#pragma unroll
                        for (int i = 0; i < 4; ++i) p[hf * 4 + i] = 0.f; } }
                pf[kk] = pack_frag(p); }
            f32x4 num[5];
#pragma unroll
            for (int vt = 0; vt < 5; ++vt) num[vt] = (f32x4){0.f, 0.f, 0.f, 0.f};
            const float eend = __expf(fb[384]);
#pragma unroll
            for (int vt = 0; vt < 5; ++vt) accC[vt] = accC[vt] * eend;
            { const int tq = fr >> 2, tp = fr & 3;
              const LAS unsigned char* vb = lds + ML_VS + (4 * fq + tq) * (VP * 2) + 8 * tp;
              const LAS unsigned char* kb = lds + ML_KS + (4 * fq + tq) * (MP * 2) + 32 * wid + 8 * tp;
#pragma unroll
              for (int kk = 0; kk < 4; ++kk) {
                  bf16x8 vf[5];
#pragma unroll
                  for (int vt = 0; vt < 5; ++vt) vf[vt] = ld_tr8(vb + kk * 32 * (VP * 2) + 32 * vt, 16 * (VP * 2));
                  const bf16x8 kr = ld_tr8(kb + kk * 32 * (MP * 2), 16 * (MP * 2));
                  const f32x4 w0 = *(const LAS f32x4*)(fb + 256 + 32 * kk + 4 * fq), w1 = *(const LAS f32x4*)(fb + 256 + 32 * kk + 16 + 4 * fq);
                  float kf[8]; unpack8(__builtin_bit_cast(u32x4, kr), kf);
#pragma unroll
                  for (int e = 0; e < 4; ++e) { kf[e] *= w0[e]; kf[4 + e] *= w1[e]; }
                  const bf16x8 kw = pack_frag(kf);
#pragma unroll
                  for (int vt = 0; vt < 5; ++vt) accC[vt] = MFMA16(kw, vf[vt], accC[vt]);
                  if (2 * kk <= J) {
#pragma unroll
                      for (int vt = 0; vt < 5; ++vt) num[vt] = MFMA16(vf[vt], pf[kk], num[vt]); } } }
            const float ebj = __expf(bj);
#pragma unroll
            for (int vt = 0; vt < 5; ++vt) { f32x4 ai = (f32x4){0.f, 0.f, 0.f, 0.f};
#pragma unroll
                for (int kk = 0; kk < 4; ++kk) ai = MFMA16(ld_frag(Cb + (16 * vt + fr) * MP + kk * 32 + fq * 8), qf[kk], ai);
                num[vt] = num[vt] + ai * ebj; }
            const float den = __shfl(num[4][0], fr);
            const float inv = frcp(fmaxf(fabsf(den), 1.f));
            { LAS bf16_t* yb = (LAS bf16_t*)(lds + ML_YB) + jj * YP + 4 * fq;
#pragma unroll
              for (int vt = 0; vt < 4; ++vt) { const f32x4 o = num[vt] * inv; u32x2 w; w.x = pkbf(o[0], o[1]); w.y = pkbf(o[2], o[3]); *(LAS u32x2*)(yb + 16 * vt) = w; } }
            }
            lds_barrier();
#pragma unroll
            for (int vt = 0; vt < 5; ++vt) { u32x2 w; w.x = pkbf(accC[vt][0], accC[vt][1]); w.y = pkbf(accC[vt][2], accC[vt][3]);
                *(LAS u32x2*)(Cb + (16 * vt + fr) * MP + 16 * wid + 4 * fq) = w; }
            writeout(c);
            if (wid == 0 && c + 1 < 66) gates();
        }
        __syncthreads();
    }
}

constexpr int SS_BM = 0, SS_XS = 64 * MP * 2, SS_HB = SS_XS + 64 * VP * 2, SS_F = SS_HB + 64 * MP * 2;
constexpr int SS_STREAM = SS_F + 1024;
template <int SKIP = 0> DI void ssd_item(const Args& a, LAS unsigned char* lds, int item, const bf16_t* XC, const float* GD, bf16_t* YS) {
    const bool st_on = !(SKIP & 1) || (a.ph_hi < 0);
    const int tid = tid_op(), lane = tid & 63, wid = __builtin_amdgcn_readfirstlane(tid >> 6), fr = lane & 15, fq = lane >> 4;
    const int b = item >> 4, hd = item & 15, g = hd >> 3, dw = wid >> 2, jw = dw ? 3 - (wid & 3) : (wid & 3);
    const int jj = 16 * jw + fr;
    constexpr int YP = 68, SS_YB = 2 * SS_STREAM;
    const int orow = tid >> 3, opc = tid & 7;
    const float* palog = inp(I_ALOG); const float* pdtb = inp(I_DTB);
    const int gd = wid & 1;
    const float acoef = -__expf(palog[gd * 16 + hd]), dtb = pdtb[gd * 16 + hd];
    f32x4 accH[2][4];
#pragma unroll
    for (int d = 0; d < 2; ++d) {
#pragma unroll
        for (int pt = 0; pt < 4; ++pt) accH[d][pt] = (f32x4){0.f, 0.f, 0.f, 0.f};
        LAS bf16_t* Hb = (LAS bf16_t*)(lds + d * SS_STREAM + SS_HB); for (int i = tid; i < 64 * MP; i += 512) Hb[i] = 0; }
    auto r0_of = [&](int c, int d) -> int { const bool isc = c < 4; const int cc = isc ? c : c - 4, n = isc ? TC : T, rbase = isc ? NL + b * TC : b * T; return rbase + (d == 0 ? cc * 64 : n - 1 - cc * 64); };
    u32x4 breg[2][2], xreg[2]; bf16x8 cn[4]; float draw = 0.f;
    const int srw = tid >> 3, spc = tid & 7;
    auto issue = [&](int c) {
#pragma unroll
        for (int d = 0; d < 2; ++d) { const int r0 = r0_of(c, d), sg = d == 0 ? 1 : -1;
            const bf16_t* pr = XC + (size_t)(r0 + sg * srw) * 1536;
            breg[d][0] = *(const u32x4*)(pr + 1024 + g * 128 + spc * 16); breg[d][1] = *(const u32x4*)(pr + 1024 + g * 128 + spc * 16 + 8); xreg[d] = *(const u32x4*)(pr + hd * 64 + spc * 8); }
        { const size_t jrow = (size_t)(r0_of(c, dw) + (dw == 0 ? 1 : -1) * jj);
#pragma unroll
          for (int kk = 0; kk < 4; ++kk) cn[kk] = *(const bf16x8*)(XC + jrow * 1536 + 1280 + g * 128 + kk * 32 + fq * 8); }
        if (wid < 2) draw = GD[(size_t)(r0_of(c, gd) + (gd == 0 ? 1 : -1) * lane) * 48 + 16 + gd * 16 + hd]; };
    auto gates = [&]() { LAS float* fs = (LAS float*)(lds + gd * SS_STREAM + SS_F);
        const float dtv = softplusf_(draw + dtb);
        const float s = wave_incl_scan(dtv * acoef);
        const float aend = rdlane(s, 63);
        fs[lane] = dtv; fs[64 + lane] = s; fs[128 + lane] = __expf(aend - s);
        if (lane == 0) fs[192] = aend; };
    u32x4 oldv[2];
    auto is_second = [&](int c) -> bool { return (c >= 68) || (c == 2) || (c == 3); };
    auto writeout = [&](int c) {
#pragma unroll
        for (int d = 0; d < 2; ++d) { const LAS bf16_t* yb = (const LAS bf16_t*)(lds + SS_YB + d * 64 * YP * 2) + orow * YP + opc * 8;
            const u32x2 lo = *(const LAS u32x2*)yb, hi = *(const LAS u32x2*)(yb + 4); u32x4 w; w.x = lo.x; w.y = lo.y; w.z = hi.x; w.w = hi.y;
            if (is_second(c)) { float f[8], o[8]; unpack8(w, f); unpack8(oldv[d], o);
#pragma unroll
                for (int j = 0; j < 8; ++j) f[j] += o[j];
                w = pack8(f); }
            if (st_on) *(u32x4*)(YS + (size_t)(r0_of(c, d) + (d == 0 ? 1 : -1) * orow) * 1024 + hd * 64 + opc * 8) = w; } };
    issue(0);
    if (wid < 2) gates();
    for (int c = 0; c < 132; ++c) {
        const bool second = is_second(c);
        const bool handoff = (c == 2) || (c == 68);
        if (handoff) __syncthreads(); else lds_barrier();
#pragma unroll
        for (int d = 0; d < 2; ++d) { LAS unsigned char* L = lds + d * SS_STREAM;
            LAS bf16_t* Bm = (LAS bf16_t*)(L + SS_BM); LAS bf16_t* Xs = (LAS bf16_t*)(L + SS_XS);
            if (!((SKIP & 2) && !st_on)) { *(LAS u32x4*)(Bm + srw * MP + spc * 16) = breg[d][0]; *(LAS u32x4*)(Bm + srw * MP + spc * 16 + 8) = breg[d][1]; *(LAS u32x4*)(Xs + srw * VP + spc * 8) = xreg[d]; } }
        bf16x8 cf[4];
#pragma unroll
        for (int kk = 0; kk < 4; ++kk) cf[kk] = cn[kk];
        lds_barrier();
        if (c + 1 < 132) issue(c + 1);
        if (second) {
#pragma unroll
            for (int d = 0; d < 2; ++d) oldv[d] = *(const u32x4*)(YS + (size_t)(r0_of(c, d) + (d == 0 ? 1 : -1) * orow) * 1024 + hd * 64 + opc * 8); }
#pragma unroll
        for (int d = 0; d < 2; ++d) { LAS unsigned char* L = lds + d * SS_STREAM;
            const LAS bf16_t* Bm = (const LAS bf16_t*)(L + SS_BM);
            const LAS bf16_t* Hb = (const LAS bf16_t*)(L + SS_HB); const LAS float* fs = (const LAS float*)(L + SS_F);
            const bool own = (d == dw) && !((SKIP & 4) && !st_on);
            bf16x8 mf[2] = {}; float acj = 0.f;
            if (own) {
            f32x4 ag[4];
#pragma unroll
            for (int st = 0; st < 4; ++st) { ag[st] = (f32x4){0.f, 0.f, 0.f, 0.f};
                if (st <= jw) {
#pragma unroll
                for (int kk = 0; kk < 4; ++kk) ag[st] = MFMA16(ld_frag(Bm + (16 * st + fr) * MP + kk * 32 + fq * 8), cf[kk], ag[st]); } }
            acj = fs[64 + jj];
#pragma unroll
            for (int kk = 0; kk < 2; ++kk) { float p[8];
#pragma unroll
                for (int hf = 0; hf < 2; ++hf) { const int st = 2 * kk + hf, s0 = 16 * st + 4 * fq;
                    if (st < jw) { const f32x4 av = *(const LAS f32x4*)(fs + 64 + s0), dv = *(const LAS f32x4*)(fs + s0);
#pragma unroll
                        for (int i = 0; i < 4; ++i) p[hf * 4 + i] = ag[st][i] * __expf(acj - av[i]) * dv[i]; }
                    else if (st == jw) { const f32x4 av = *(const LAS f32x4*)(fs + 64 + s0), dv = *(const LAS f32x4*)(fs + s0);
#pragma unroll
                        for (int i = 0; i < 4; ++i) p[hf * 4 + i] = (4 * fq + i <= fr) ? ag[st][i] * __expf(acj - av[i]) * dv[i] : 0.f; }
                    else {
#pragma unroll
                        for (int i = 0; i < 4; ++i) p[hf * 4 + i] = 0.f; } }
                mf[kk] = pack_frag(p); }
            }
            f32x4 ay[4];
#pragma unroll
            for (int pt = 0; pt < 4; ++pt) ay[pt] = (f32x4){0.f, 0.f, 0.f, 0.f};
            if (!((SKIP & 8) && !st_on)) { const float eend = __expf(fs[192]);
#pragma unroll
              for (int pt = 0; pt < 4; ++pt) accH[d][pt] = accH[d][pt] * eend;
              const int tq = fr >> 2, tp = fr & 3;
              const LAS unsigned char* xb = L + SS_XS + (4 * fq + tq) * (VP * 2) + 8 * tp;
              const LAS unsigned char* bb = L + SS_BM + (4 * fq + tq) * (MP * 2) + 32 * wid + 8 * tp;
#pragma unroll
              for (int ks = 0; ks < 2; ++ks) {
                  bf16x8 xf[4];
#pragma unroll
                  for (int pt = 0; pt < 4; ++pt) xf[pt] = ld_tr8(xb + ks * 32 * (VP * 2) + 32 * pt, 16 * (VP * 2));
                  const bf16x8 br = ld_tr8(bb + ks * 32 * (MP * 2), 16 * (MP * 2));
                  const int s0 = 32 * ks + 4 * fq;
                  const f32x4 d0 = *(const LAS f32x4*)(fs + s0), d1 = *(const LAS f32x4*)(fs + s0 + 16), e0 = *(const LAS f32x4*)(fs + 128 + s0), e1 = *(const LAS f32x4*)(fs + 128 + s0 + 16);
                  float bf[8]; unpack8(__builtin_bit_cast(u32x4, br), bf);
#pragma unroll
                  for (int e = 0; e < 4; ++e) { bf[e] *= d0[e] * e0[e]; bf[4 + e] *= d1[e] * e1[e]; }
                  const bf16x8 bw = pack_frag(bf);
#pragma unroll
                  for (int pt = 0; pt < 4; ++pt) accH[d][pt] = MFMA16(bw, xf[pt], accH[d][pt]);
                  if (own && 2 * ks <= jw) {
#pragma unroll
                      for (int pt = 0; pt < 4; ++pt) ay[pt] = MFMA16(xf[pt], mf[ks], ay[pt]); } } }
            if (own) { const float eaj = __expf(acj);
              LAS bf16_t* yb = (LAS bf16_t*)(lds + SS_YB + d * 64 * YP * 2) + jj * YP + 4 * fq;
#pragma unroll
              for (int ptile = 0; ptile < 4; ++ptile) { f32x4 ai = (f32x4){0.f, 0.f, 0.f, 0.f};
#pragma unroll
                  for (int kk = 0; kk < 4; ++kk) ai = MFMA16(ld_frag(Hb + (16 * ptile + fr) * MP + kk * 32 + fq * 8), cf[kk], ai);
                  const f32x4 o = ay[ptile] + ai * eaj;
                  u32x2 w; w.x = pkbf(o[0], o[1]); w.y = pkbf(o[2], o[3]); *(LAS u32x2*)(yb + 16 * ptile) = w; } }
        }
        lds_barrier();
#pragma unroll
        for (int d = 0; d < 2; ++d) { LAS bf16_t* Hb = (LAS bf16_t*)(lds + d * SS_STREAM + SS_HB);
#pragma unroll
            for (int pt = 0; pt < 4; ++pt) { u32x2 w; w.x = pkbf(accH[d][pt][0], accH[d][pt][1]); w.y = pkbf(accH[d][pt][2], accH[d][pt][3]);
                *(LAS u32x2*)(Hb + (16 * pt + fr) * MP + 16 * wid + 4 * fq) = w; } }
        writeout(c);
        if (wid < 2 && c + 1 < 132) gates();
    }
    __syncthreads();
}
DI void scan_phase(const Args& a, LAS unsigned char* lds, const bf16_t* QK, const bf16_t* V, const bf16_t* XC, const float* GD, bf16_t* HM, bf16_t* YS) {
#if defined(DBG_TRIVIAL_SCAN)
    const int tid = tid_op(), lane = tid & 63, wid = tid >> 6;
    for (int row = blockIdx.x * 8 + wid; row < NR; row += gridDim.x * 8) {
        for (int i = 0; i < 4; ++i) { *(u32x2*)(HM + (size_t)row * 1024 + i * 256 + lane * 4) = *(const u32x2*)(V + (size_t)row * 1024 + i * 256 + lane * 4);
                                      *(u32x2*)(YS + (size_t)row * 1024 + i * 256 + lane * 4) = *(const u32x2*)(XC + (size_t)row * 1536 + i * 256 + lane * 4); } }
#else
    for (int item = blockIdx.x; item < 256; item += gridDim.x) {
#if defined(DBG_NO_MLSTM)
        if (item < 128) { const int b = item >> 4, h = (item >> 2) & 3, vs = item & 3, tid = tid_op();
            for (int r = tid >> 3; r < T + TC; r += 64) { const size_t row = r < T ? (size_t)(b * T + r) : (size_t)(NL + b * TC + r - T); const int c = h * 256 + vs * 64 + (tid & 7) * 8;
                *(u32x4*)(HM + row * 1024 + c) = *(const u32x4*)(V + row * 1024 + c); } }
        else ssd_item(a, lds, item - 128, XC, GD, YS);
#elif defined(DBG_NO_SSD)
        if (item < 128) mlstm_item(a, lds, item, QK, V, GD, HM);
        else { const int b = (item - 128) >> 4, hd = (item - 128) & 15, tid = tid_op();
            for (int r = tid >> 3; r < T + TC; r += 64) { const size_t row = r < T ? (size_t)(b * T + r) : (size_t)(NL + b * TC + r - T); const int c = hd * 64 + (tid & 7) * 8;
                *(u32x4*)(YS + row * 1024 + c) = *(const u32x4*)(XC + row * 1536 + c); } }
#else
        if (item < 128) {
#if defined(DBG_ML_SKIP)
            mlstm_item<DBG_ML_SKIP>(a, lds, item, QK, V, GD, HM); __syncthreads();
#endif
            mlstm_item(a, lds, item, QK, V, GD, HM);
#if defined(DBG_DUP_ML)
            __syncthreads(); mlstm_item(a, lds, item, QK, V, GD, HM);
#endif
        } else {
#if defined(DBG_SSD_SKIP)
            ssd_item<DBG_SSD_SKIP>(a, lds, item - 128, XC, GD, YS); __syncthreads();
#endif
            ssd_item(a, lds, item - 128, XC, GD, YS);
#if defined(DBG_DUP_SSD)
            __syncthreads(); ssd_item(a, lds, item - 128, XC, GD, YS);
#endif
        }
#endif
        __syncthreads();
    }
#endif
}

struct PmRow { u32x2 hm[4], o[4], ys[4], z[4], xs[4]; };
DI void pm_load(PmRow& d, int row, int lane, const bf16_t* HM, const bf16_t* YS, const bf16_t* XC, const bf16_t* OZ) {
    ld_row_raw(HM + (size_t)row * 1024, lane, d.hm); ld_row_raw(OZ + (size_t)row * 2048, lane, d.o); ld_row_raw(YS + (size_t)row * 1024, lane, d.ys);
    ld_row_raw(OZ + (size_t)row * 2048 + 1024, lane, d.z); ld_row_raw(XC + (size_t)row * 1536, lane, d.xs);
}
DI void post_mix_phase(const Args& a, const bf16_t* HM, const bf16_t* YS, const bf16_t* XC, bf16_t* OZ, unsigned char* OZ8) {
    const int tid_ = tid_op(), lane = tid_ & 63, wid = tid_ >> 6;
    const float* pmlng = inp(I_MLNG); const float* pssd = inp(I_SSD); const float* pssng = inp(I_SSNG);
    const int stride = gridDim.x * 8;
    int row = blockIdx.x * 8 + wid;
    PmRow cur;
    if (row < NR) pm_load(cur, row, lane, HM, YS, XC, OZ);
    for (; row < NR; row += stride) {
        PmRow nxt = cur; const int nr = row + stride;
        if (nr < NR) pm_load(nxt, nr, lane, HM, YS, XC, OZ);
        f32x4 hm[4], o[4], r[4], ys[4], z[4], xs[4], u[4]; float sq[4];
        cvt_row(cur.hm, hm); cvt_row(cur.o, o); cvt_row(cur.ys, ys); cvt_row(cur.z, z); cvt_row(cur.xs, xs);
#pragma unroll
        for (int i = 0; i < 4; ++i) { const float ms = wave_sum(hm[i][0] * hm[i][0] + hm[i][1] * hm[i][1] + hm[i][2] * hm[i][2] + hm[i][3] * hm[i][3]) * (1.f / 256.f);
            const float rs = rsqrtf(ms + RMS_EPS); const f32x4 g = *(const f32x4*)(pmlng + i * 256 + lane * 4);
#pragma unroll
            for (int j = 0; j < 4; ++j) r[i][j] = hm[i][j] * rs * g[j] * sigmoidf_(o[i][j]); }
        if (MK_F8_OUT0) st_row_f8(OZ8 + (size_t)row * 2048, lane, r); else st_row_bf16(OZ + (size_t)row * 2048, lane, r);
#pragma unroll
        for (int i = 0; i < 4; ++i) { const float dk = pssd[i * 4 + (lane >> 4)];
#pragma unroll
            for (int j = 0; j < 4; ++j) u[i][j] = (ys[i][j] + dk * xs[i][j]) * siluf_(z[i][j]);
            sq[i] = wave_sum(u[i][0] * u[i][0] + u[i][1] * u[i][1] + u[i][2] * u[i][2] + u[i][3] * u[i][3]); }
#pragma unroll
        for (int i = 0; i < 4; ++i) { const float rs = rsqrtf((sq[i & 2] + sq[(i & 2) + 1]) * (1.f / 512.f) + RMS_EPS); const f32x4 g = *(const f32x4*)(pssng + i * 256 + lane * 4);
            u[i] = u[i] * rs * g; }
        if (MK_F8_OUT0) st_row_f8(OZ8 + (size_t)row * 2048 + 1024, lane, u); else st_row_bf16(OZ + (size_t)row * 2048 + 1024, lane, u);
        cur = nxt;
    }
}

DI void post_attn_phase(const Args& a, LAS unsigned char* lds, int layer, int nrows, const bf16_t* OL, unsigned char* H2, const bf16_t* XBin, bf16_t* XBout) {
    LAS float* rw = (LAS float*)lds;
    const int tid = tid_op(), lane = tid & 63, wid = tid >> 6;
    { const float* pr = inp(I_ROUTER) + (size_t)layer * 1024 * 16; for (int i = tid; i < 1024 * 16; i += 512) rw[(i & 15) * 1024 + (i >> 4)] = pr[i]; }
    __syncthreads();
    const float* ng = inp(I_NORMG) + (size_t)layer * 4 * 1024; const float* px = inp(I_X); const float* pctx = inp(I_CTX);
    float* aff = (float*)(a.ws + WS_AFF); int* slot = (int*)(a.ws + WS_SLOT); float* ctxs = (float*)(a.ws + WS_CTXS);
    const int stride = gridDim.x * 8;
    int row = blockIdx.x * 8 + wid;
    f32x4 x[4]; u32x2 oraw[4];
    auto ldx = [&](int r, f32x4 (&d)[4]) { if (layer == 0) ld_row_f32(r < NL ? px + (size_t)r * 1024 : pctx + (size_t)(r - NL) * 1024, lane, d); else ld_row_bf16(XBin + (size_t)r * 1024, lane, d); };
    if (row < nrows) { ldx(row, x); ld_row_raw(OL + (size_t)row * 1024, lane, oraw); }
    for (; row < nrows; row += stride) {
        const int s = row_mod_s(row), nr = row + stride;
        f32x4 xn[4], o[4], h[4]; u32x2 on[4];
#pragma unroll
        for (int i = 0; i < 4; ++i) { xn[i] = x[i]; on[i] = oraw[i]; }
        if (nr < nrows) { ldx(nr, xn); ld_row_raw(OL + (size_t)nr * 1024, lane, on); }
        cvt_row(oraw, o);
        const float rs = rsqrtf(wave_sum(sumsq4(o)) * (1.f / 1024.f) + RMS_EPS);
        const float* gm = modp(a, layer, s, 2);
#pragma unroll
        for (int i = 0; i < 4; ++i) { const int c = i * 256 + lane * 4; const f32x4 g = *(const f32x4*)(ng + 1024 + c), gt = *(const f32x4*)(gm + c);
            x[i] = x[i] + gt * (o[i] * rs * g); }
        if (row < NL) st_row_bf16(XBout + (size_t)row * 1024, lane, x); else {
#pragma unroll
            for (int i = 0; i < 4; ++i) *(f32x4*)(ctxs + (size_t)(row - NL) * 1024 + i * 256 + lane * 4) = x[i]; }
        norm_mod(x, ng + 2048, modp(a, layer, s, 3), modp(a, layer, s, 4), lane, h);
        { unsigned char* hp = H2 + (size_t)row * 1024;
#pragma unroll
          for (int i = 0; i < 4; ++i) *(unsigned*)(hp + i * 256 + lane * 4) = pk_fp8x4(h[i][0] * F8_HID, h[i][1] * F8_HID, h[i][2] * F8_HID, h[i][3] * F8_HID); }
        float lg[16];
#pragma unroll
        for (int e = 0; e < 16; ++e) lg[e] = 0.f;
#pragma unroll
        for (int e = 0; e < 16; ++e) {
#pragma unroll
            for (int i = 0; i < 4; ++i) { const f32x4 w = *(const LAS f32x4*)(rw + e * 1024 + i * 256 + lane * 4); lg[e] += (h[i][0] * w[0] + h[i][1] * w[1]) + (h[i][2] * w[2] + h[i][3] * w[3]); }
            if ((e & 3) == 3) asm volatile("" ::: "memory"); }
        float l8[8], l4[4], l2[2], l1;
        { const bool hi = (lane & 32) != 0;
#pragma unroll
          for (int i = 0; i < 8; ++i) { const float keep = hi ? lg[8 + i] : lg[i], send = hi ? lg[i] : lg[8 + i]; l8[i] = keep + __shfl_xor(send, 32); } }
        { const bool hi = (lane & 16) != 0;
#pragma unroll
          for (int i = 0; i < 4; ++i) { const float keep = hi ? l8[4 + i] : l8[i], send = hi ? l8[i] : l8[4 + i]; l4[i] = keep + __shfl_xor(send, 16); } }
        { const bool hi = (lane & 8) != 0;
#pragma unroll
          for (int i = 0; i < 2; ++i) { const float keep = hi ? l4[2 + i] : l4[i], send = hi ? l4[i] : l4[2 + i]; l2[i] = keep + __shfl_xor(send, 8); } }
        { const bool hi = (lane & 4) != 0; const float keep = hi ? l2[1] : l2[0], send = hi ? l2[0] : l2[1]; l1 = keep + __shfl_xor(send, 4); }
        l1 += __shfl_xor(l1, 2); l1 += __shfl_xor(l1, 1);
        const int ex = ((lane >> 5) & 1) * 8 + ((lane >> 4) & 1) * 4 + ((lane >> 3) & 1) * 2 + ((lane >> 2) & 1);
        float mx = l1;
#pragma unroll
        for (int o = 4; o <= 32; o <<= 1) mx = fmaxf(mx, __shfl_xor(mx, o));
        const float pe = __expf(l1 - mx); float sum = pe;
#pragma unroll
        for (int o = 4; o <= 32; o <<= 1) sum += __shfl_xor(sum, o);
        if ((lane & 3) == 0) { aff[(size_t)row * 16 + ex] = pe / sum; slot[(size_t)row * 16 + ex] = -1; }
#pragma unroll
        for (int i = 0; i < 4; ++i) { x[i] = xn[i]; oraw[i] = on[i]; }
    }
    __syncthreads();
}

DI void topk_item(const Args& a, LAS unsigned char* lds, int item, int rpe, const unsigned char* H2, unsigned char* XG) {
    LAS unsigned* keys = (LAS unsigned*)lds;
    LAS unsigned* hist = keys + 8192;
    LAS unsigned* wsum = hist + 256;
    LAS unsigned* misc = wsum + 8;
    LAS int* sel = (LAS int*)(misc + 8);
    const int tid = tid_op(), lane = tid & 63, wid = tid >> 6;
    const bool lat = item < 128; const int it = lat ? item : item - 128, b = it >> 4, e = it & 15;
    const int n = lat ? T : TC, cap = lat ? 1024 : 32, rbase = lat ? b * T : NL + b * TC;
    const float* aff = (const float*)(a.ws + WS_AFF); int* slot = (int*)(a.ws + WS_SLOT); float* gate = (float*)(a.ws + WS_GATE);
    for (int i = tid; i < n; i += 512) keys[i] = __float_as_uint(aff[(size_t)(rbase + i) * 16 + e]);
    unsigned prefix = 0u, mask = 0u, need = (unsigned)cap;
    for (int pass = 0; pass < 4; ++pass) {
        const int shift = 24 - 8 * pass;
        if (tid < 256) hist[tid] = 0u;
        __syncthreads();
        for (int i = tid; i < n; i += 512) { const unsigned k = keys[i]; if ((k & mask) == prefix) __hip_atomic_fetch_add(hist + ((k >> shift) & 255u), 1u, __ATOMIC_RELAXED, __HIP_MEMORY_SCOPE_WORKGROUP); }
        __syncthreads();
        if (wid == 0) {
            const u32x4 hc = *(const LAS u32x4*)(hist + 4 * lane); const unsigned tot = hc.x + hc.y + hc.z + hc.w;
            unsigned suf = tot;
#pragma unroll
            for (int o = 1; o < 64; o <<= 1) { const unsigned t = __shfl_down(suf, o); if (lane + o < 64) suf += t; }
            const unsigned long long bal = __ballot(suf >= need); const int ls = 63 - __builtin_clzll(bal);
            if (lane == ls) { unsigned nd = need - (suf - tot); int bin;
                if (hc.w >= nd) bin = 3; else { nd -= hc.w; if (hc.z >= nd) bin = 2; else { nd -= hc.z; if (hc.y >= nd) bin = 1; else { nd -= hc.y; bin = 0; } } }
                misc[0] = (unsigned)(4 * lane + bin); misc[1] = nd; } }
        __syncthreads();
        prefix |= misc[0] << shift; mask |= 0xffu << shift; need = misc[1];
        __syncthreads();
    }
    const int per = lat ? 16 : 1, i0 = tid * per; const bool act = i0 < n;
    unsigned cnt = 0u;
    if (act) for (int j = 0; j < per; ++j) { const unsigned k = keys[i0 + j]; cnt += (k > prefix ? 1u : 0u) + (k == prefix ? 0x10000u : 0u); }
    unsigned inc = cnt;
#pragma unroll
    for (int o = 1; o < 64; o <<= 1) { const unsigned t = __shfl_up(inc, o); if (lane >= o) inc += t; }
    if (lane == 63) wsum[wid] = inc;
    __syncthreads();
    unsigned base = 0u;
    for (int w = 0; w < wid; ++w) base += wsum[w];
    unsigned ex = base + inc - cnt;
    if (act) for (int j = 0; j < per; ++j) { const unsigned k = keys[i0 + j]; const unsigned gtb = ex & 0xffffu, eqb = ex >> 16;
        const bool take = (k > prefix) || (k == prefix && eqb < need);
        if (take) { const int s = (int)(gtb + (eqb < need ? eqb : need)); const int tok = i0 + j, erow = lat ? b * 1024 + s : 8192 + b * 32 + s;
            sel[s] = tok; gate[(size_t)e * rpe + erow] = __uint_as_float(k); slot[(size_t)(rbase + tok) * 16 + e] = erow; }
        ex += (k > prefix ? 1u : 0u) + (k == prefix ? 0x10000u : 0u); }
    __syncthreads();
    const int sub = tid >> 6, c16 = tid & 63;
    for (int r0 = sub; r0 < cap; r0 += 32) {
        u32x4 v[4];
#pragma unroll
        for (int q = 0; q < 4; ++q) { const int r = r0 + 8 * q; if (r < cap) v[q] = *(const u32x4*)(H2 + (size_t)(rbase + sel[r]) * 1024 + c16 * 16); }
#pragma unroll
        for (int q = 0; q < 4; ++q) { const int r = r0 + 8 * q; if (r < cap) { const int erow = lat ? b * 1024 + r : 8192 + b * 32 + r; *(u32x4*)(XG + ((size_t)e * rpe + erow) * 1024 + c16 * 16) = v[q]; } }
    }
    __syncthreads();
}

DI void combine_phase(const Args& a, int layer, int nrows, int rpe, const bf16_t* Y, bf16_t* HS, bf16_t* XB) {
    const int tid_ = tid_op(), lane = tid_ & 63, wid = tid_ >> 6;
    const int* slot = (const int*)(a.ws + WS_SLOT); float* ctxs = (float*)(a.ws + WS_CTXS);
    const float* ng0 = inp(I_NORMG); const float* ng = ng0 + (size_t)layer * 4 * 1024;
    const int stride = gridDim.x * 8;
    int row = blockIdx.x * 8 + wid;
    auto ldx = [&](int r, f32x4 (&d)[4]) { if (r < NL) ld_row_bf16(XB + (size_t)r * 1024, lane, d); else ld_row_f32(ctxs + (size_t)(r - NL) * 1024, lane, d); };
    int sl = -1; f32x4 x[4];
    if (row < nrows) { sl = slot[(size_t)row * 16 + (lane & 15)]; ldx(row, x); }
    for (; row < nrows; row += stride) {
        const int s = row_mod_s(row), nr = row + stride;
        f32x4 m[4];
#pragma unroll
        for (int i = 0; i < 4; ++i) m[i] = (f32x4){0.f, 0.f, 0.f, 0.f};
#pragma unroll
        for (int e = 0; e < 16; ++e) { const int se = __builtin_amdgcn_readlane(sl, e);
            if (se >= 0) { f32x4 y[4]; ld_row_bf16(Y + ((size_t)e * rpe + se) * 1024, lane, y);
#pragma unroll
                for (int i = 0; i < 4; ++i) m[i] = m[i] + y[i]; } }
        int sln = sl; f32x4 xn[4];
#pragma unroll
        for (int i = 0; i < 4; ++i) xn[i] = x[i];
        if (nr < nrows) { sln = slot[(size_t)nr * 16 + (lane & 15)]; ldx(nr, xn); }
        const float rs = rsqrtf(wave_sum(sumsq4(m)) * (1.f / 1024.f) + RMS_EPS);
        const float* gm = modp(a, layer, s, 5);
#pragma unroll
        for (int i = 0; i < 4; ++i) { const int c = i * 256 + lane * 4; const f32x4 g = *(const f32x4*)(ng + 3072 + c), gt = *(const f32x4*)(gm + c);
            x[i] = x[i] + gt * (m[i] * rs * g); }
        if (layer == 1) {
#pragma unroll
            for (int i = 0; i < 4; ++i) *(f32x4*)(a.out + (size_t)row * 1024 + i * 256 + lane * 4) = x[i]; }
        else if (row < NL) st_row_bf16(XB + (size_t)row * 1024, lane, x);
        else {
#pragma unroll
            for (int i = 0; i < 4; ++i) *(f32x4*)(ctxs + (size_t)(row - NL) * 1024 + i * 256 + lane * 4) = x[i]; }
        if (layer == 0) { f32x4 h[4]; norm_mod(x, ng0 + 4096, modp(a, 1, s, 0), modp(a, 1, s, 1), lane, h);
#pragma unroll
            for (int i = 0; i < 4; ++i) { u32x2 w; w.x = pkbf(h[i][0], h[i][1]); w.y = pkbf(h[i][2], h[i][3]); *(u32x2*)(HS + (size_t)row * 2048 + i * 256 + lane * 4) = w; } }
        sl = sln;
#pragma unroll
        for (int i = 0; i < 4; ++i) x[i] = xn[i];
    }
}
DI void mix_phase(bf16_t* HS, bf16_t* XM) {
    const int tid_ = tid_op(), lane = tid_ & 63, wid = tid_ >> 6;
    const float* mu = inp(I_MU);
    f32x4 mr[4], mk[4], mv[4];
#pragma unroll
    for (int i = 0; i < 4; ++i) { const int c = i * 256 + lane * 4; mr[i] = *(const f32x4*)(mu + c); mk[i] = *(const f32x4*)(mu + 2 * 1024 + c); mv[i] = *(const f32x4*)(mu + 3 * 1024 + c); }
    for (int row = blockIdx.x * 8 + wid; row < NR; row += gridDim.x * 8) {
        const int t = row < NL ? (row & (T - 1)) : ((row - NL) & (TC - 1)), n = row < NL ? T : TC;
        const bool first = t == 0, last = t == n - 1;
        u32x2 p[4], q[4], hh[4];
#pragma unroll
        for (int i = 0; i < 4; ++i) { const int c = i * 256 + lane * 4; p[i] = (u32x2){0u, 0u}; q[i] = (u32x2){0u, 0u};
            if (!first) p[i] = *(const u32x2*)(HS + (size_t)(row - 1) * 2048 + c);
            if (!last) q[i] = *(const u32x2*)(HS + (size_t)(row + 1) * 2048 + c);
            hh[i] = *(const u32x2*)(HS + (size_t)row * 2048 + c); }
#pragma unroll
        for (int i = 0; i < 4; ++i) { const int c = i * 256 + lane * 4;
            const f32x4 h = (f32x4){bflo(hh[i].x), bfhi(hh[i].x), bflo(hh[i].y), bfhi(hh[i].y)};
            const f32x4 sh = (f32x4){0.5f * (bflo(p[i].x) + bflo(q[i].x)), 0.5f * (bfhi(p[i].x) + bfhi(q[i].x)), 0.5f * (bflo(p[i].y) + bflo(q[i].y)), 0.5f * (bfhi(p[i].y) + bfhi(q[i].y))};
            const f32x4 xx = sh - h, xr = h + xx * mr[i], xk = h + xx * mk[i], xv = h + xx * mv[i];
            u32x2 w; w.x = pkbf(sh[0], sh[1]); w.y = pkbf(sh[2], sh[3]); *(u32x2*)(HS + (size_t)row * 2048 + 1024 + c) = w;
            if (MK_F8_RKV) { unsigned char* xb = (unsigned char*)XM + (size_t)row * 1024 + c;
                *(unsigned*)xb = pk_fp8x4(xr[0] * F8_ACT, xr[1] * F8_ACT, xr[2] * F8_ACT, xr[3] * F8_ACT);
                *(unsigned*)(xb + USZ) = pk_fp8x4(xk[0] * F8_ACT, xk[1] * F8_ACT, xk[2] * F8_ACT, xk[3] * F8_ACT);
                *(unsigned*)(xb + 2 * USZ) = pk_fp8x4(xv[0] * F8_ACT, xv[1] * F8_ACT, xv[2] * F8_ACT, xv[3] * F8_ACT); }
            else {
            w.x = pkbf(xr[0], xr[1]); w.y = pkbf(xr[2], xr[3]); *(u32x2*)(XM + (size_t)row * 1024 + c) = w;
            w.x = pkbf(xk[0], xk[1]); w.y = pkbf(xk[2], xk[3]); *(u32x2*)(XM + (USZ / 2) + (size_t)row * 1024 + c) = w;
            w.x = pkbf(xv[0], xv[1]); w.y = pkbf(xv[2], xv[3]); *(u32x2*)(XM + 2 * (USZ / 2) + (size_t)row * 1024 + c) = w; } }
    }
}

struct EpiRw1 {
    static constexpr bool PERM = true; static constexpr bool SPLIT = MK_SPLIT; static constexpr int NST = 16; DI bool counted(const Unit& u) const { return true; }
    bf16_t *L1, *L2;
    DI void operator()(const f32x4 (&acc)[2][2][4][2], const Unit& u, int wr, int wc, int fr, int fq) const { half<0>(acc, u, wr, wc, fr, fq); half<1>(acc, u, wr, wc, fr, fq); }
    template <int ai> DI void half(const f32x4 (&acc)[2][2][4][2], const Unit& u, int wr, int wc, int fr, int fq) const {
        const int row0 = u.pm * 256 + wr * 64 + fr, pn = u.pn + 12, cl = wc * 32 + 8 * fq;
        {
#pragma unroll
            for (int m = 0; m < 4; ++m) { const size_t row = (size_t)(row0 + ai * 128 + m * 16);
#pragma unroll
                for (int bj = 0; bj < 2; ++bj) { f32x4 v0 = acc[ai][bj][m][0], v1 = acc[ai][bj][m][1]; bf16_t* dst;
                    if (pn == 12) { dst = L1 + row * 256 + bj * 128 + cl;
                        if (bj == 0) {
#pragma unroll
                            for (int j = 0; j < 4; ++j) { v0[j] = tanhf_(v0[j]); v1[j] = tanhf_(v1[j]); } } }
                    else { dst = L2 + row * 256 + bj * 128 + cl;
#pragma unroll
                        for (int j = 0; j < 4; ++j) { v0[j] = sigmoidf_(v0[j]); v1[j] = sigmoidf_(v1[j]); } }
                    *(u32x4*)dst = pack_acc(v0, v1); } }
        }
    }
};
struct EpiRw2 {
    static constexpr bool PERM = true; static constexpr bool SPLIT = false; static constexpr int NST = 16; DI bool counted(const Unit& u) const { return true; }
    bf16_t* LWA; const float* w0; const float* a0;
    DI void operator()(const f32x4 (&acc)[2][2][4][2], const Unit& u, int wr, int wc, int fr, int fq) const {
        const int row0 = u.pm * 256 + wr * 64 + fr, pn = u.pn;
        const float sc = pn < 8 ? -0.60653065971263342f : 1.f;
#pragma unroll
        for (int bj = 0; bj < 2; ++bj) { const int c = pn * 256 + bj * 128 + wc * 32 + 8 * fq;
            const float* bp = pn < 8 ? w0 + c : a0 + (c - 2048);
            const f32x4 b0 = *(const f32x4*)bp, b1 = *(const f32x4*)(bp + 4);
#pragma unroll
            for (int ai = 0; ai < 2; ++ai)
#pragma unroll
                for (int m = 0; m < 4; ++m) { f32x4 v0 = acc[ai][bj][m][0] + b0, v1 = acc[ai][bj][m][1] + b1;
#pragma unroll
                    for (int j = 0; j < 4; ++j) { v0[j] = sc * sigmoidf_(v0[j]); v1[j] = sc * sigmoidf_(v1[j]); }
                    *(u32x4*)(LWA + (size_t)(row0 + ai * 128 + m * 16) * 3072 + c) = pack_acc(v0, v1); } }
    }
};

DI float grp16_sum(float v) { v += __shfl_xor(v, 1); v += __shfl_xor(v, 2); v += __shfl_xor(v, 4); v += __shfl_xor(v, 8); return v; }

constexpr int RC_AT = 0, RC_RT = 2304, RC_NAK = 4608, RC_TIN = 5120, RC_MBR = 5632, RC_MKR = 6144, RC_BT = 6656, RC_KT = 9216, RC_VT = 11776, RC_GAM = 14336, RC_BN = 14592, RC_KN = 16896, RC_SLOT = 19200;
template <int N> DI float ror_add(float x) { const int y = __builtin_amdgcn_update_dpp(0, __float_as_int(x), 0x120 + N, 0xf, 0xf, false); return x + __int_as_float(y); }
DI float grp16_allsum(float x) { x = ror_add<8>(x); x = ror_add<4>(x); x = ror_add<2>(x); x = ror_add<1>(x); return x; }
DI bf16x8 mk_frag(const u32x2 lo, const u32x2 hi) { u32x4 w; w.x = lo.x; w.y = lo.y; w.z = hi.x; w.w = hi.y; return __builtin_bit_cast(bf16x8, w); }
DI float rdl(float x, int l) { return __int_as_float(__builtin_amdgcn_readlane(__float_as_int(x), l)); }
DI void rwkv_scan_item(LAS unsigned char* lds, int item, const bf16_t* Rm, const bf16_t* Km, const bf16_t* Vm, bf16_t* LWA, int mode) {
    const bool dry = mode != 0;
    const int tid = tid_op(), lane = tid & 63, wid = __builtin_amdgcn_readfirstlane(tid >> 6), fr = lane & 15, fq = lane >> 4;
    const int b = item >> 5, h = (item >> 1) & 15, dir = item & 1;
    auto row_of = [&](int p) -> size_t { return p < TC ? (size_t)(NL + b * TC + (dir == 0 ? p : TC - 1 - p)) : (size_t)(b * T + (dir == 0 ? p - TC : T - 1 - (p - TC))); };
    constexpr int NGRP = (TC + T) / 64;
    const u32x2 z2 = (u32x2){0u, 0u};
    LAS unsigned* acnt = (LAS unsigned*)(lds + 8 * RC_SLOT);
    if (tid == 0) *acnt = 0u;
    if (wid >= 4) {
        const int j = wid - 4, pt = lane & 15, cq = lane >> 4;
        float kkw[16], kaw[16];
        { const float* pkk = inp(I_KK) + h * 64 + 16 * cq; const float* pka = inp(I_KA) + h * 64 + 16 * cq;
#pragma unroll
          for (int i = 0; i < 16; i += 4) { const f32x4 a4 = *(const f32x4*)(pkk + i), b4 = *(const f32x4*)(pka + i);
#pragma unroll
              for (int q = 0; q < 4; ++q) { kkw[i + q] = a4[q]; kaw[i + q] = b4[q]; } } }
        u32x4 raw[5][2];
        auto issue = [&](int g) { const size_t row = row_of(16 * (4 * g + j) + pt); const size_t ro = row * 1024 + h * 64 + 16 * cq; const bf16_t* pl = LWA + row * 3072 + h * 64 + 16 * cq;
#pragma unroll
            for (int q = 0; q < 2; ++q) { raw[0][q] = *(const u32x4*)(Rm + ro + 8 * q); raw[1][q] = *(const u32x4*)(Km + ro + 8 * q); raw[2][q] = *(const u32x4*)(Vm + ro + 8 * q);
                                          raw[3][q] = *(const u32x4*)(pl + dir * 1024 + 8 * q); raw[4][q] = *(const u32x4*)(pl + 2048 + 8 * q); } };
        auto prep = [&](int g) {
            LAS unsigned char* sl = lds + (((g & 1) * 4 + j) * RC_SLOT);
            LAS bf16_t* At = (LAS bf16_t*)(sl + RC_AT); LAS bf16_t* Rt = (LAS bf16_t*)(sl + RC_RT); LAS bf16_t* BT = (LAS bf16_t*)(sl + RC_BT); LAS bf16_t* KT = (LAS bf16_t*)(sl + RC_KT); LAS bf16_t* VT = (LAS bf16_t*)(sl + RC_VT);
            LAS bf16_t* Bn = (LAS bf16_t*)(sl + RC_BN); LAS bf16_t* Kn = (LAS bf16_t*)(sl + RC_KN);
            float fr_[16], fk[16], fl[16], fa[16]; u32x4 vraw[2] = {raw[2][0], raw[2][1]};
            unpack8(raw[0][0], *(float(*)[8])&fr_[0]); unpack8(raw[0][1], *(float(*)[8])&fr_[8]); unpack8(raw[1][0], *(float(*)[8])&fk[0]); unpack8(raw[1][1], *(float(*)[8])&fk[8]);
            unpack8(raw[3][0], *(float(*)[8])&fl[0]); unpack8(raw[3][1], *(float(*)[8])&fl[8]); unpack8(raw[4][0], *(float(*)[8])&fa[0]); unpack8(raw[4][1], *(float(*)[8])&fa[8]);
            if (g + 1 < NGRP) issue(g + 1);
            float kk[16], ss = 0.f;
#pragma unroll
            for (int i = 0; i < 16; ++i) { kk[i] = fk[i] * kkw[i]; ss += kk[i] * kk[i]; }
            ss += __shfl_xor(ss, 16); ss += __shfl_xor(ss, 32);
            const float rn = rsqrtf(ss + 1e-12f);
            float at[16], rt[16], bt[16], kt[16], cc[16], ec[16];
#pragma unroll
            for (int i = 0; i < 16; ++i) cc[i] = fl[i] + __int_as_float(__builtin_amdgcn_update_dpp(0, __float_as_int(fl[i]), 0x111, 0xf, 0xf, true));
#pragma unroll
            for (int i = 0; i < 16; ++i) cc[i] += __int_as_float(__builtin_amdgcn_update_dpp(0, __float_as_int(cc[i]), 0x112, 0xf, 0xf, true));
#pragma unroll
            for (int i = 0; i < 16; ++i) cc[i] += __int_as_float(__builtin_amdgcn_update_dpp(0, __float_as_int(cc[i]), 0x114, 0xf, 0xf, true));
#pragma unroll
            for (int i = 0; i < 16; ++i) cc[i] += __int_as_float(__builtin_amdgcn_update_dpp(0, __float_as_int(cc[i]), 0x118, 0xf, 0xf, true));
#pragma unroll
            for (int i = 0; i < 16; ++i) ec[i] = __expf(cc[i]);
#pragma unroll
            for (int i = 0; i < 16; ++i) {
                const float einv = __expf(-cc[i]);
                float eprev = __int_as_float(__builtin_amdgcn_update_dpp(0, __float_as_int(ec[i]), 0x111, 0xf, 0xf, true)); eprev = pt == 0 ? 1.f : eprev;
                const float kn = kk[i] * rn, kp = fk[i] * ((fa[i] - 1.f) * kaw[i] + 1.f);
                at[i] = -kn * eprev; rt[i] = fr_[i] * ec[i]; bt[i] = kn * fa[i] * einv; kt[i] = kp * einv; }
            if (pt == 15) {
#pragma unroll
                for (int i = 0; i < 16; i += 4) *(LAS f32x4*)(sl + RC_GAM + (16 * cq + i) * 4) = (f32x4){ec[i], ec[i + 1], ec[i + 2], ec[i + 3]}; }
            { u32x4 w0, w1;
#define RC_PK16(src) w0.x = pkbf(src[0], src[1]); w0.y = pkbf(src[2], src[3]); w0.z = pkbf(src[4], src[5]); w0.w = pkbf(src[6], src[7]); w1.x = pkbf(src[8], src[9]); w1.y = pkbf(src[10], src[11]); w1.z = pkbf(src[12], src[13]); w1.w = pkbf(src[14], src[15]);
              RC_PK16(at) *(LAS u32x4*)(At + pt * 72 + 16 * cq) = w0; *(LAS u32x4*)(At + pt * 72 + 16 * cq + 8) = w1;
              RC_PK16(rt) *(LAS u32x4*)(Rt + pt * 72 + 16 * cq) = w0; *(LAS u32x4*)(Rt + pt * 72 + 16 * cq + 8) = w1;
              RC_PK16(bt) *(LAS u32x4*)(Bn + pt * 72 + 16 * cq) = w0; *(LAS u32x4*)(Bn + pt * 72 + 16 * cq + 8) = w1;
              { const unsigned wv[8] = {w0.x, w0.y, w0.z, w0.w, w1.x, w1.y, w1.z, w1.w};
#pragma unroll
                for (int q = 0; q < 8; ++q) { BT[(16 * cq + 2 * q) * 20 + pt] = (bf16_t)(wv[q] & 0xffffu); BT[(16 * cq + 2 * q + 1) * 20 + pt] = (bf16_t)(wv[q] >> 16); } }
              RC_PK16(kt) *(LAS u32x4*)(Kn + pt * 72 + 16 * cq) = w0; *(LAS u32x4*)(Kn + pt * 72 + 16 * cq + 8) = w1;
              { const unsigned wv[8] = {w0.x, w0.y, w0.z, w0.w, w1.x, w1.y, w1.z, w1.w};
#pragma unroll
                for (int q = 0; q < 8; ++q) { KT[(16 * cq + 2 * q) * 20 + pt] = (bf16_t)(wv[q] & 0xffffu); KT[(16 * cq + 2 * q + 1) * 20 + pt] = (bf16_t)(wv[q] >> 16); } }
              { const unsigned wv[8] = {vraw[0].x, vraw[0].y, vraw[0].z, vraw[0].w, vraw[1].x, vraw[1].y, vraw[1].z, vraw[1].w};
#pragma unroll
                for (int q = 0; q < 8; ++q) { VT[(16 * cq + 2 * q) * 20 + pt] = (bf16_t)(wv[q] & 0xffffu); VT[(16 * cq + 2 * q + 1) * 20 + pt] = (bf16_t)(wv[q] >> 16); } }
#undef RC_PK16
            }
        };
        issue(0);
        prep(0);
        lds_barrier();
        for (int g = 0; g < NGRP; ++g) { if (g + 1 < NGRP && mode != 3) prep(g + 1); lds_barrier();   }
    } else {
        f32x4 st[4];
#pragma unroll
        for (int kt = 0; kt < 4; ++kt) st[kt] = (f32x4){0.f, 0.f, 0.f, 0.f};
        lds_barrier();
        for (int g = 0; g < NGRP; ++g) {
            if (mode != 2) {
                LAS unsigned char* sl = lds + (((g & 1) * 4 + wid) * RC_SLOT);
                const LAS bf16_t* At = (const LAS bf16_t*)(sl + RC_AT); const LAS bf16_t* Rt = (const LAS bf16_t*)(sl + RC_RT); LAS bf16_t* Bn = (LAS bf16_t*)(sl + RC_BN); const LAS bf16_t* Kn = (const LAS bf16_t*)(sl + RC_KN);
            f32x4 nab = (f32x4){0.f, 0.f, 0.f, 0.f}, nak = nab, mbr = nab, mkr = nab;
#pragma unroll
            for (int s2 = 0; s2 < 2; ++s2) { const bf16x8 fb_ = ld_frag(Bn + fr * 72 + 32 * s2 + 8 * fq), fk_ = ld_frag(Kn + fr * 72 + 32 * s2 + 8 * fq), fa_ = ld_frag(At + fr * 72 + 32 * s2 + 8 * fq), fr2 = ld_frag(Rt + fr * 72 + 32 * s2 + 8 * fq);
                nab = MFMA16(fb_, fa_, nab); nak = MFMA16(fk_, fa_, nak); mbr = MFMA16(fb_, fr2, mbr); mkr = MFMA16(fk_, fr2, mkr); }
#pragma unroll
            for (int jj = 0; jj < 4; ++jj) { const int i = 4 * fq + jj; if (!(i < fr)) { nab[jj] = 0.f; nak[jj] = 0.f; } if (!(i <= fr)) { mbr[jj] = 0.f; mkr[jj] = 0.f; } }
            { u32x2 w; w.x = pkbf(nak[0], nak[1]); w.y = pkbf(nak[2], nak[3]); *(LAS u32x2*)(sl + RC_NAK + fr * 32 + 8 * fq) = w;
              w.x = pkbf(mbr[0], mbr[1]); w.y = pkbf(mbr[2], mbr[3]); *(LAS u32x2*)(sl + RC_MBR + fr * 32 + 8 * fq) = w;
              w.x = pkbf(mkr[0], mkr[1]); w.y = pkbf(mkr[2], mkr[3]); *(LAS u32x2*)(sl + RC_MKR + fr * 32 + 8 * fq) = w; }
            LAS float* nf = (LAS float*)Bn;
            *(LAS f32x4*)(nf + fr * 16 + 4 * fq) = nab;
            float rw_[16];
#pragma unroll
            for (int t = 0; t < 16; ++t) { float acc0 = (fr == t) ? 1.f : 0.f, acc1 = 0.f;
#pragma unroll
                for (int i4 = 0; i4 < (t + 3) / 4; ++i4) { const f32x4 cf = *(const LAS f32x4*)(nf + t * 16 + 4 * i4);
#pragma unroll
                    for (int jj = 0; jj < 4; ++jj) { const int i = 4 * i4 + jj; if (i < t) { if (jj & 1) acc1 += cf[jj] * rw_[i]; else acc0 += cf[jj] * rw_[i]; } } }
                rw_[t] = acc0 + acc1; }
            if (lane < 16) {
#pragma unroll
                for (int t = 0; t < 16; t += 2) {   ((LAS bf16_t*)(sl + RC_TIN))[t * 16 + lane] = f2bf(rw_[t]); ((LAS bf16_t*)(sl + RC_TIN))[(t + 1) * 16 + lane] = f2bf(rw_[t + 1]); } }
            }
            asm volatile("s_waitcnt lgkmcnt(0)" ::: "memory");
            if (lane == 0) __hip_atomic_fetch_add(acnt, 1u, __ATOMIC_RELAXED, __HIP_MEMORY_SCOPE_WORKGROUP);
            while (__hip_atomic_load(acnt, __ATOMIC_RELAXED, __HIP_MEMORY_SCOPE_WORKGROUP) < 4u * (unsigned)(g + 1)) __builtin_amdgcn_s_sleep(1);
            asm volatile("" ::: "memory");
#pragma unroll 1
            for (int cc = 0; cc < (mode == 2 ? 0 : 4); ++cc) {
                const int c = 4 * g + cc; const LAS unsigned char* sl = lds + (((g & 1) * 4 + cc) * RC_SLOT);
                const LAS bf16_t* At = (const LAS bf16_t*)(sl + RC_AT); const LAS bf16_t* Rt = (const LAS bf16_t*)(sl + RC_RT);
                bf16x8 sb[2];
#pragma unroll
                for (int s2 = 0; s2 < 2; ++s2) { u32x4 w; w.x = pkbf(st[2 * s2][0], st[2 * s2][1]); w.y = pkbf(st[2 * s2][2], st[2 * s2][3]); w.z = pkbf(st[2 * s2 + 1][0], st[2 * s2 + 1][1]); w.w = pkbf(st[2 * s2 + 1][2], st[2 * s2 + 1][3]); sb[s2] = __builtin_bit_cast(bf16x8, w); }
                const u32x2 vv = *(const LAS u32x2*)(sl + RC_VT + (16 * wid + fr) * 40 + 8 * fq);
                const f32x4 zero4 = (f32x4){0.f, 0.f, 0.f, 0.f};
                f32x4 x = MFMA16(ld_frag2(At + fr * 72 + 4 * fq), sb[0], zero4);
                x = MFMA16(ld_frag2(At + fr * 72 + 32 + 4 * fq), sb[1], x);
                x = MFMA16(mk_frag(z2, *(const LAS u32x2*)(sl + RC_NAK + fr * 32 + 8 * fq)), mk_frag(z2, vv), x);
                u32x2 xb; xb.x = pkbf(x[0], x[1]); xb.y = pkbf(x[2], x[3]);
                const f32x4 u = MFMA16(mk_frag(*(const LAS u32x2*)(sl + RC_TIN + fr * 32 + 8 * fq), z2), mk_frag(xb, z2), zero4);
                u32x2 ub; ub.x = pkbf(u[0], u[1]); ub.y = pkbf(u[2], u[3]);
                const bf16x8 uv = mk_frag(ub, vv);
                f32x4 y = MFMA16(ld_frag2(Rt + fr * 72 + 4 * fq), sb[0], zero4);
                y = MFMA16(ld_frag2(Rt + fr * 72 + 32 + 4 * fq), sb[1], y);
                y = MFMA16(mk_frag(*(const LAS u32x2*)(sl + RC_MBR + fr * 32 + 8 * fq), *(const LAS u32x2*)(sl + RC_MKR + fr * 32 + 8 * fq)), uv, y);
#pragma unroll
                for (int kt = 0; kt < 4; ++kt) { const int k = 16 * kt + fr;
                    st[kt] = MFMA16(mk_frag(*(const LAS u32x2*)(sl + RC_BT + k * 40 + 8 * fq), *(const LAS u32x2*)(sl + RC_KT + k * 40 + 8 * fq)), uv, st[kt]);
                    const f32x4 gm = *(const LAS f32x4*)(sl + RC_GAM + (16 * kt + 4 * fq) * 4); st[kt] = st[kt] * gm; }
                if (!dry) {
                    bf16_t* yp = LWA + row_of(16 * c) * 3072 + dir * 1024 + h * 64 + 16 * wid + fr + (dir == 0 ? 1 : -1) * (4 * fq) * 3072;
#pragma unroll
                    for (int i = 0; i < 4; ++i) yp[(dir == 0 ? i : -i) * 3072] = f2bf(y[i]); }
            }
            lds_barrier();
        }
    }
}

struct RpRow { u32x2 yf[4], yb[4], r[4], k[4], v[4], g[4], av[4]; };
DI void rp_load(RpRow& d, int row, int lane, const bf16_t* Rm, const bf16_t* Km, const bf16_t* Vm, const bf16_t* LWA, const bf16_t* G) {
    ld_row_raw(LWA + (size_t)row * 3072, lane, d.yf); ld_row_raw(LWA + (size_t)row * 3072 + 1024, lane, d.yb); ld_row_raw(LWA + (size_t)row * 3072 + 2048, lane, d.av);
    ld_row_raw(Rm + (size_t)row * 1024, lane, d.r); ld_row_raw(Km + (size_t)row * 1024, lane, d.k); ld_row_raw(Vm + (size_t)row * 1024, lane, d.v);
    ld_row_raw(G + (size_t)row * 1024, lane, d.g);
}
DI void rw_post_phase(const Args& a, const bf16_t* Rm, const bf16_t* Km, const bf16_t* Vm, bf16_t* LWA, const bf16_t* G) {
    const int tid_ = tid_op(), lane = tid_ & 63, wid = tid_ >> 6;
    const float* plg = inp(I_LNG); const float* plb = inp(I_LNB); const float* prk = inp(I_RK); const float* pka = inp(I_KA);
    const int stride = gridDim.x * 8;
    int row = blockIdx.x * 8 + wid;
    RpRow cur;
    if (row < NL) rp_load(cur, row, lane, Rm, Km, Vm, LWA, G);
    for (; row < NL; row += stride) {
        RpRow nxt = cur; const int nr = row + stride;
        if (nr < NL) rp_load(nxt, nr, lane, Rm, Km, Vm, LWA, G);
        f32x4 yf[4], yb[4], r[4], k[4], v[4], g[4], av[4], z[4];
        cvt_row(cur.yf, yf); cvt_row(cur.yb, yb); cvt_row(cur.r, r); cvt_row(cur.k, k); cvt_row(cur.v, v); cvt_row(cur.g, g); cvt_row(cur.av, av);
#pragma unroll
        for (int i = 0; i < 4; ++i) { const int c = i * 256 + lane * 4; const f32x4 y = yf[i] + yb[i];
            const f32x4 kaw = *(const f32x4*)(pka + c); const f32x4 kp = k[i] * ((av[i] - 1.f) * kaw + 1.f);
            const float mean = grp16_sum((y[0] + y[1]) + (y[2] + y[3])) * (1.f / 64.f); const f32x4 d = y - mean;
            const float var = grp16_sum((d[0] * d[0] + d[1] * d[1]) + (d[2] * d[2] + d[3] * d[3])) * (1.f / 64.f);
            const float rs = rsqrtf(var + 64e-5f);
            const f32x4 lg = *(const f32x4*)(plg + c), lb = *(const f32x4*)(plb + c), rk = *(const f32x4*)(prk + c);
            const f32x4 rkk = r[i] * kp * rk; const float rks = grp16_sum((rkk[0] + rkk[1]) + (rkk[2] + rkk[3]));
            z[i] = (d * rs * lg + lb + v[i] * rks) * g[i]; }
        if (MK_F8_OUT1) st_row_f8((unsigned char*)(LWA + (size_t)row * 3072 + 2048), lane, z);
        else st_row_bf16(LWA + (size_t)row * 3072 + 2048, lane, z);
        cur = nxt;
    }
}
#ifndef MK_ONE_LAUNCH
#define MK_ONE_LAUNCH 1
#endif
#ifndef MK_NPH
#define MK_NPH 25
#endif
constexpr int NPH = 25;

__global__ void __launch_bounds__(512, 2) mk_fwd(Args a) {
    extern __shared__ __attribute__((aligned(16))) unsigned char lds_raw[];
    LAS unsigned char* lds = (LAS unsigned char*)lds_raw;
    const int lo = a.ph_lo, hi = a.ph_hi;
    if (threadIdx.x < 4) ((LAS unsigned*)(lds + LDS_BARW))[threadIdx.x] = 0u;
    __syncthreads();
    XcdBarrier bar; bar.bar = (unsigned*)(a.ws + WS_CTL); bar.x = 0; bar.st = nullptr;
    if (hi - lo > 1) bar = xcd_barrier_post((unsigned*)(a.ws + WS_CTL), (volatile LAS unsigned*)(lds + LDS_BARW));
#ifndef MK_PHMASK
#define MK_PHMASK 0xffffffffu
#endif
#ifndef MK_RWMODE
#define MK_RWMODE 1
#endif
#ifndef MK_DUPMASK
#define MK_DUPMASK 0u
#endif
#define PH(k) if (((MK_PHMASK >> (k)) & 1u) && lo <= (k) && (k) < hi) for (int _r = 0; _r < 1 + (int)((MK_DUPMASK >> (k)) & 1u); ++_r)
#ifndef MK_ALIGN_SWIGLU
#define MK_ALIGN_SWIGLU true
#endif
#ifndef MK_ALIGN_RW2
#define MK_ALIGN_RW2 true
#endif
#ifndef MK_GEMMDRY
#define MK_GEMMDRY 0
#endif
#define GDRY(k) (MK_GEMMDRY && ((MK_DUPMASK >> (k)) & 1u) && _r == 0 && lo == 0)
#define SEAM(k) do { if (lo <= (k) && (k) + 1 < hi) xcd_barrier(bar); } while (0)
    unsigned char* ws = a.ws;
    bf16_t* const S0 = (bf16_t*)(ws + slot_off(0)); bf16_t* const S1 = (bf16_t*)(ws + slot_off(1)); bf16_t* const S2 = (bf16_t*)(ws + slot_off(2));
    bf16_t* const S3 = (bf16_t*)(ws + slot_off(3)); bf16_t* const S4 = (bf16_t*)(ws + slot_off(4)); bf16_t* const S5 = (bf16_t*)(ws + slot_off(5)); bf16_t* const S6 = (bf16_t*)(ws + slot_off(6));
    float* const GD = (float*)(ws + WS_GD); bf16_t* const XC = (bf16_t*)a.out; bf16_t* const XB = (bf16_t*)a.out;
    unsigned char* const EW1 = (unsigned char*)a.out + ((size_t)128 << 20);
    const int G = gridDim.x, bx = blockIdx.x;
#ifndef MK_CVT13
#define MK_CVT13 8
#endif
#ifndef MK_G6K
#define MK_G6K 128
#endif
#ifndef MK_LORA1_S6
#define MK_LORA1_S6 0
#endif
    bf16_t* const LORA1P = MK_LORA1_S6 ? S6 : (bf16_t*)(ws + WS_LORA1);

    PH(0) { p0a_phase(a, lds); } SEAM(0);
    PH(1) { p0b_phase(a, S0); } SEAM(1);
    PH(2) { pg8::Gemm g{S0, (const bf16_t*)(ws + WS_WIN), 1024, 1024}; pg8::StaticOrder S; S.init(NR, 5888, G, bx);
            EpiProj E{ws, GD}; pg8::gemm_phase(lds, g, S, E, GDRY(2)); } SEAM(2);
    PH(3) { conv_phase(a, lds, S2, XC); } SEAM(3);
    PH(4) { scan_phase(a, lds, S1, S4, XC, GD, S0, S2); } SEAM(4);
    PH(5) { post_mix_phase(a, S0, S2, XC, S5, (unsigned char*)S3); } SEAM(5);
    PH(6) { pg8::StaticOrder S; S.init(NR, 1024, G, bx); EpiPlain E{S1, 1024};
            if (MK_F8_OUT0) { pg8::Gemm g{S3, (const bf16_t*)(ws + WS_WOUT), 1024, 1024, F8_ACT_SH}; pg8::gemm_phase<EpiPlain, pg8::StaticOrder, true, true, true>(lds, g, S, E); }
            else { pg8::Gemm g{S5, (const bf16_t*)(ws + WS_WOUT), 2048, 2048}; pg8::gemm_phase(lds, g, S, E); }
            if (bx >= (NR / 256 * 4) % G) expert_cvt_items(a, lds, 0, (unsigned char*)S4, 12); } SEAM(6);
    PH(7) { post_attn_phase(a, lds, 0, NR, S1, (unsigned char*)S0, nullptr, XB); } SEAM(7);
    PH(8) { for (int item = bx; item < 256; item += G) topk_item(a, lds, item, 8448, (const unsigned char*)S0, (unsigned char*)S5);
            expert_cvt_items(a, lds, 0, (unsigned char*)S4); } SEAM(8);
    PH(9) { pg8::Gemm g{S5, S4, 512, 512, F8_HID_SH}; pg8::GroupOrder S; S.init(33, 11, G, bx);
            EpiSwiglu E{(unsigned char*)S0}; pg8::gemm_phase<EpiSwiglu, pg8::GroupOrder, MK_ALIGN_SWIGLU, true, true>(lds, g, S, E); } SEAM(9);
    PH(10) { pg8::Gemm g{S0, (const bf16_t*)((const unsigned char*)S4 + W13_BYTES), FFP / 2, FFP / 2, F8_HID_SH}; pg8::GroupOrder S; S.init(33, 4, G, bx);
             EpiGate E{S5, (const float*)(ws + WS_GATE)}; pg8::gemm_phase<EpiGate, pg8::GroupOrder, true, true, true>(lds, g, S, E);
             if (bx >= (NE * 33 * 4) % G) expert_cvt_items(a, lds, 1, EW1, 10); } SEAM(10);
    PH(11) { combine_phase(a, 0, NR, 8448, S5, S0, XB); } SEAM(11);
    PH(12) { mix_phase(S0, S2); } SEAM(12);
    PH(13) { { pg8::Gemm g{S0, (const bf16_t*)(ws + WS_WRW) + (size_t)3072 * 2048, 2048, 2048}; pg8::StaticOrder S; S.init(NR, 512, G, bx);
               EpiRw1 E{LORA1P, (bf16_t*)(ws + WS_LORA2)}; pg8::gemm_phase(lds, g, S, E); }
             { pg8::SkipOrder S; S.init(NR, 1024, G, bx, 16); EpiPlainG E{S5};
               if (MK_F8_RKV) { pg8::Gemm g{S2, (const bf16_t*)(ws + WS_WRW), 512, 512, F8_ACT_SH, 2048, USZ}; pg8::gemm_phase<EpiPlainG, pg8::SkipOrder, true, true, true>(lds, g, S, E); }
               else { pg8::Gemm g{S2, (const bf16_t*)(ws + WS_WRW), 1024, 1024, 0, 2048, USZ}; pg8::gemm_phase(lds, g, S, E); } }
             if (bx >= 96) expert_cvt_items(a, lds, 1, EW1, MK_CVT13); } SEAM(13);
    PH(14) { pg8::StaticOrder S; S.init(NR, 2048, G, bx); EpiPlainG E{S0};
             if (MK_F8_RKV) { pg8::Gemm g{S3, (const bf16_t*)(ws + WS_WRW) + (size_t)1024 * 2048, 512, 512, F8_ACT_SH, 2048, USZ}; pg8::gemm_phase<EpiPlainG, pg8::StaticOrder, true, true, true>(lds, g, S, E); }
             else { pg8::Gemm g{S3, (const bf16_t*)(ws + WS_WRW) + (size_t)1024 * 2048, 1024, 1024, 0, 2048, USZ}; pg8::gemm_phase(lds, g, S, E); }
             if (bx >= (NR / 256 * 8) % G) expert_cvt_items(a, lds, 1, EW1, 7); } SEAM(14);
    PH(15) { pg8::Gemm g{LORA1P, (const bf16_t*)(ws + WS_W2A), 256, MK_G6K, 0, 256, MK_G6K == 128 ? 128 : 0, MK_G6K == 128 ? 128 : 0}; pg8::StaticOrder S; S.init(NR, 3072, G, bx);
             EpiRw2 E{S2, inp(I_W0), inp(I_A0)}; pg8::gemm_phase<EpiRw2, pg8::StaticOrder, MK_ALIGN_RW2>(lds, g, S, E); } SEAM(15);
    PH(16) { for (int item = bx; item < 256; item += G) { rwkv_scan_item(lds, item, S5, S0, S1, S2, (((MK_DUPMASK >> 16) & 1u) && _r == 0) ? MK_RWMODE : 0); __syncthreads(); } } SEAM(16);
    PH(17) { pg8::Gemm g{(const bf16_t*)(ws + WS_LORA2), (const bf16_t*)(ws + WS_G2), 256, 256}; pg8::StaticOrder S; S.init(NL, 1024, G, bx);
             EpiPlain E{S6, 1024}; pg8::gemm_phase(lds, g, S, E); } SEAM(17);
    PH(18) { rw_post_phase(a, S5, S0, S1, S2, S6); } SEAM(18);
    PH(19) { pg8::StaticOrder S; S.init(NL, 1024, G, bx); EpiPlain E{S6, 1024};
             if (MK_F8_OUT1) { pg8::Gemm g{S2 + 2048, (const bf16_t*)(ws + WS_WO), 3072, 512, F8_ACT_SH}; pg8::gemm_phase<EpiPlain, pg8::StaticOrder, true, true, true>(lds, g, S, E); }
             else { pg8::Gemm g{S2 + 2048, (const bf16_t*)(ws + WS_WO), 3072, 1024}; pg8::gemm_phase(lds, g, S, E); } } SEAM(19);
    PH(20) { post_attn_phase(a, lds, 1, NL, S6, (unsigned char*)S0, XB, S3); } SEAM(20);
    PH(21) { for (int item = bx; item < 128; item += G) topk_item(a, lds, item, 8192, (const unsigned char*)S0, (unsigned char*)S5);
             expert_cvt_items(a, lds, 1, EW1); } SEAM(21);
    PH(22) { pg8::Gemm g{S5, (const bf16_t*)EW1, 512, 512, F8_HID_SH}; pg8::GroupOrder S; S.init(32, 11, G, bx);
             EpiSwiglu E{(unsigned char*)S0}; pg8::gemm_phase<EpiSwiglu, pg8::GroupOrder, MK_ALIGN_SWIGLU, true, true>(lds, g, S, E); } SEAM(22);
    PH(23) { pg8::Gemm g{S0, (const bf16_t*)(EW1 + W13_BYTES), FFP / 2, FFP / 2, F8_HID_SH}; pg8::GroupOrder S; S.init(32, 4, G, bx);
             EpiGate E{S5, (const float*)(ws + WS_GATE)}; pg8::gemm_phase<EpiGate, pg8::GroupOrder, true, true, true>(lds, g, S, E); } SEAM(23);
    PH(24) { combine_phase(a, 1, NL, 8192, S5, S0, S3); }
#undef PH
#undef SEAM
}

extern "C" void kernel_launch(void* const* d_in, const int* in_sizes, int n_in, void* d_out, int out_size, void* d_ws, size_t ws_size, hipStream_t stream) {
    static int grid = 0;
    if (grid == 0) {
        if (n_in != N_IN || out_size != NL * D || ws_size < WS_NEED) { grid = -1; return; }
        int dev = 0, cus = 0;
        if (hipGetDevice(&dev) != hipSuccess || hipDeviceGetAttribute(&cus, hipDeviceAttributeMultiprocessorCount, dev) != hipSuccess) { grid = -1; return; }
        if (hipFuncSetAttribute((const void*)mk_fwd, hipFuncAttributeMaxDynamicSharedMemorySize, LDS_BYTES) != hipSuccess) { grid = -1; return; }
        int per_cu = 0;
        (void)hipOccupancyMaxActiveBlocksPerMultiprocessor(&per_cu, (const void*)mk_fwd, 512, LDS_BYTES);
        (void)hipGetLastError();
        grid = cus;
    }
    if (grid < 0) return;
    (void)hipMemsetAsync((char*)d_ws + WS_CTL, 0, 65536, stream);
    Args a{};
    for (int i = 0; i < N_IN; ++i) a.in[i] = (const float*)d_in[i];
    a.out = (float*)d_out; a.ws = (unsigned char*)d_ws;
#if MK_ONE_LAUNCH
    a.ph_lo = 0; a.ph_hi = MK_NPH;
    hipLaunchKernelGGL(mk_fwd, dim3(grid), dim3(512), LDS_BYTES, stream, a);
#else
    for (int p = 0; p < MK_NPH; ++p) { a.ph_lo = p; a.ph_hi = p + 1; hipLaunchKernelGGL(mk_fwd, dim3(grid), dim3(512), LDS_BYTES, stream, a); }
#endif
}
```

```cpp
#define MK_ONE_LAUNCH 1
#define MK_NPH 25
#include <hip/hip_runtime.h>
#include <stdint.h>

#define DI __device__ __forceinline__
#define LAS __attribute__((address_space(3)))
typedef unsigned short bf16_t;
typedef short bf16x8 __attribute__((ext_vector_type(8)));
typedef short s16x4 __attribute__((ext_vector_type(4)));
typedef float f32x4 __attribute__((ext_vector_type(4)));
typedef float f32x2 __attribute__((ext_vector_type(2)));
typedef unsigned u32x4 __attribute__((ext_vector_type(4)));
typedef unsigned u32x2 __attribute__((ext_vector_type(2)));

constexpr int NB = 8, T = 8192, TC = 256, D = 1024;
constexpr int NL = NB * T;
constexpr int NCX = NB * TC;
constexpr int NR = NL + NCX;
constexpr int NE = 16, FF = 1408;
constexpr float RMS_EPS = 1e-6f;

constexpr size_t MiB = (size_t)1 << 20;
constexpr size_t WS_CTL = 0;
constexpr size_t WS_MOD = 1 * MiB;
constexpr size_t WS_AFF = 2 * MiB;
constexpr size_t WS_SLOT = 7 * MiB;
constexpr size_t WS_IDX = 12 * MiB;
constexpr size_t WS_GATE = 13 * MiB;
constexpr size_t WS_CTXS = 14 * MiB;
constexpr size_t WS_WIN = 22 * MiB;
constexpr size_t WS_WOUT = 34 * MiB;
constexpr size_t WS_LORA1 = 2 * MiB;
constexpr size_t WS_WRW = 38 * MiB;
constexpr size_t WS_WO = 52 * MiB;
constexpr size_t WS_W2A = 54 * MiB;
constexpr size_t WS_G2 = 56 * MiB;
constexpr size_t WS_GD = 57 * MiB;
constexpr size_t WS_LORA2 = 57 * MiB;
constexpr size_t WS_SLOTS = 100 * MiB;
constexpr size_t USZ = (size_t)NR * 1024 * 2;
DI constexpr size_t slot_off(int i) { return WS_SLOTS + (size_t)i * USZ; }
constexpr size_t WS_NEED = WS_SLOTS + 7 * USZ;

DI int tid_op() { int t = (int)threadIdx.x; asm volatile("" : "+v"(t)); return t; }
DI void lds_barrier() { asm volatile("s_waitcnt lgkmcnt(0)" ::: "memory"); __builtin_amdgcn_s_barrier(); asm volatile("" ::: "memory"); }
DI float bflo(unsigned w) { return __uint_as_float(w << 16); }
DI float bfhi(unsigned w) { return __uint_as_float(w & 0xffff0000u); }
DI float bf2f(bf16_t x) { return __uint_as_float(((unsigned)x) << 16); }
typedef __bf16 bf16v2_t __attribute__((ext_vector_type(2)));
DI unsigned pkbf(float lo, float hi) { const f32x2 v = {lo, hi}; const bf16v2_t b = __builtin_convertvector(v, bf16v2_t); return __builtin_bit_cast(unsigned, b); }
DI bf16_t f2bf(float x) { return (bf16_t)(pkbf(x, 0.f) & 0xffffu); }
DI float frcp(float x) { return __builtin_amdgcn_rcpf(x); }
DI float sigmoidf_(float x) { return frcp(1.f + __expf(-x)); }
DI float siluf_(float x) { return x * sigmoidf_(x); }
DI float softplusf_(float x) { return fmaxf(x, 0.f) + __logf(1.f + __expf(-fabsf(x))); }
DI float tanhf_(float x) { return 1.f - 2.f * frcp(1.f + __expf(2.f * x)); }
DI float wave_sum(float v) {
#pragma unroll
    for (int o = 32; o >= 1; o >>= 1) v += __shfl_xor(v, o);
    return v;
}
template <int CTRL, int RMASK> DI float dpp_addz(float x) { return x + __int_as_float(__builtin_amdgcn_update_dpp(0, __float_as_int(x), CTRL, RMASK, 0xf, true)); }
DI float wave_incl_scan(float v) {
    v = dpp_addz<0x111, 0xf>(v); v = dpp_addz<0x112, 0xf>(v); v = dpp_addz<0x114, 0xf>(v); v = dpp_addz<0x118, 0xf>(v);
    v = dpp_addz<0x142, 0xa>(v); v = dpp_addz<0x143, 0xc>(v); return v; }
DI float clamp_f8(float x) { return fminf(fmaxf(x, -440.f), 440.f); }
DI unsigned pk_fp8x4(float a, float b, float c, float d) { int w = __builtin_amdgcn_cvt_pk_fp8_f32(clamp_f8(a), clamp_f8(b), 0, false); w = __builtin_amdgcn_cvt_pk_fp8_f32(clamp_f8(c), clamp_f8(d), w, true); return (unsigned)w; }
DI void unpack8(const u32x4 w, float (&f)[8]) { f[0] = bflo(w.x); f[1] = bfhi(w.x); f[2] = bflo(w.y); f[3] = bfhi(w.y); f[4] = bflo(w.z); f[5] = bfhi(w.z); f[6] = bflo(w.w); f[7] = bfhi(w.w); }
DI u32x4 pack8(const float (&f)[8]) { u32x4 w; w.x = pkbf(f[0], f[1]); w.y = pkbf(f[2], f[3]); w.z = pkbf(f[4], f[5]); w.w = pkbf(f[6], f[7]); return w; }

#define XB_TMO      128
#define XB_XCNT(j)  (256  + 64 * (j))
#define XB_XSUB(j)  (1280 + 64 * (j))
#define XB_XGEN(j)  (2304 + 64 * (j))
#define XB_TOP      3328
#define XB_TOPGEN   3392
#define XCD_BAR_WORDS 3456
#define XB_SPIN_CAP (1u << 18)
__device__ __forceinline__ unsigned xb_ld(unsigned* p)              { return __hip_atomic_load(p, __ATOMIC_RELAXED, __HIP_MEMORY_SCOPE_AGENT); }
__device__ __forceinline__ unsigned xb_add(unsigned* p, unsigned v) { return __hip_atomic_fetch_add(p, v, __ATOMIC_RELAXED, __HIP_MEMORY_SCOPE_AGENT); }
__device__ __forceinline__ unsigned xb_xcc_id() { return (unsigned)__builtin_amdgcn_s_getreg((3 << 11) | 20) & 0xFu; }
#define XB_SPIN(cond, bar) do { unsigned _sp = 0; while (cond) { __builtin_amdgcn_s_sleep(1); \
    if ((++_sp & 255u) == 0u) { if (xb_ld(&(bar)[XB_TMO])) break; if (_sp > XB_SPIN_CAP) { atomicAdd(&(bar)[XB_TMO], 1u); break; } } } } while (0)
struct XcdBarrier { unsigned* bar; unsigned x; volatile LAS unsigned* st; };
__device__ __forceinline__ XcdBarrier xcd_barrier_post(unsigned* bar, volatile LAS unsigned* st) {
    XcdBarrier b; b.bar = bar; b.x = xb_xcc_id(); b.st = st;
    if (threadIdx.x == 0) (void)xb_add(&bar[XB_XCNT(b.x)], 1u);
    return b;
}
__device__ __forceinline__ void xcd_barrier_complete(unsigned* bar, unsigned x, unsigned& nloc, unsigned& nx) {
    const unsigned G = gridDim.x * gridDim.y * gridDim.z;
    unsigned sum, cnt, mine, sp = 0u;
    for (;;) {
        sum = 0u; cnt = 0u; mine = 0u;
#pragma unroll
        for (unsigned j = 0; j < 16; ++j) { const unsigned c = xb_ld(&bar[XB_XCNT(j)]); sum += c; cnt += (c > 0u) ? 1u : 0u; mine = (j == x) ? c : mine; }
        if (sum == G) break;
        __builtin_amdgcn_s_sleep(1);
        if ((++sp & 255u) == 0u) { if (xb_ld(&bar[XB_TMO])) break; if (sp > XB_SPIN_CAP) { atomicAdd(&bar[XB_TMO], 1u); break; } }
    }
    nloc = mine > 0u ? mine : 1u; nx = cnt > 0u ? cnt : 1u;
}
__device__ __forceinline__ void xcd_barrier(const XcdBarrier& b) {
    asm volatile("s_waitcnt vmcnt(0)" ::: "memory");
    __syncthreads();
    if (threadIdx.x == 0) {
        unsigned* bar = b.bar;
        __builtin_amdgcn_s_waitcnt(0);
        unsigned nloc = b.st[0], nx = b.st[1];
        if (nloc == 0u) { xcd_barrier_complete(bar, b.x, nloc, nx); b.st[0] = nloc; b.st[1] = nx; }
        const unsigned old = xb_add(&bar[XB_XSUB(b.x)], 1u);
        const unsigned gen = old / nloc;
        if (old + 1u == (gen + 1u) * nloc) {
            __builtin_amdgcn_fence(__ATOMIC_RELEASE, "agent");
            asm volatile("s_waitcnt vmcnt(0)" ::: "memory");
            const unsigned og = xb_add(&bar[XB_TOP], 1u);
            const unsigned tg = og / nx;
            if (og + 1u == (tg + 1u) * nx) xb_add(&bar[XB_TOPGEN], 1u);
            else XB_SPIN(xb_ld(&bar[XB_TOPGEN]) == tg, bar);
            __builtin_amdgcn_fence(__ATOMIC_ACQUIRE, "agent");
            xb_add(&bar[XB_XGEN(b.x)], 1u);
            asm volatile("s_waitcnt vmcnt(0)" ::: "memory");
        } else {
            XB_SPIN(xb_ld(&bar[XB_XGEN(b.x)]) == gen, bar);
            __builtin_amdgcn_fence(__ATOMIC_ACQUIRE, "agent");
            asm volatile("s_waitcnt vmcnt(0)" ::: "memory");
        }
    }
    __syncthreads();
}

#ifndef MK_SPLIT
#define MK_SPLIT false
#endif
#ifndef MK_SPLIT_SWIGLU
#define MK_SPLIT_SWIGLU true
#endif
namespace pg8 {
constexpr int BM = 256, BK = 64, HALF = 128, HTB = HALF * BK * 2, STAGE_BYTES = 8 * HTB, NXCD = 8, WGM = 8;
__host__ __device__ __forceinline__ int lds_byte(int r, int c) { const int st = (r >> 4) * 2 + (c >> 5), rr = r & 15, cc = c & 31, ob = rr * 64 + cc * 2; return st * 1024 + (ob ^ (((ob >> 9) & 1) << 5)); }
__host__ __device__ __forceinline__ void stage_rc(int b, int& R, int& C) { const int st = b / 1024, sb = b % 1024, swz = sb ^ (((sb >> 9) & 1) << 5); R = (st >> 1) * 16 + swz / 64; C = (st & 1) * 32 + (swz % 64) / 2; }
__host__ __device__ __forceinline__ int perm32(int rho) { const int n = rho >> 4, i = rho & 15; return 8 * (i >> 2) + 4 * n + (i & 3); }
struct Unit { int pm, pn; };
struct Gemm { const bf16_t* A; const bf16_t* Bt; int lda, K; int ash = 0; int ldb = 0; size_t agrp = 0, bgrp = 0; };

struct StaticOrder {
    int nM, nN, nwg, G, c;
    __device__ void init(int M, int N, int G_, int c_) { nM = M / BM; nN = N / BM; nwg = nM * nN; G = G_; c = c_; }
    __device__ bool next(int i, Unit& u) const {
        const long L = (long)i * G + c; if (L >= nwg) return false;
        int wgid = (int)L; { const int q = nwg / NXCD, r = nwg % NXCD, xcd = wgid % NXCD, off = wgid / NXCD; wgid = (xcd < r ? xcd * (q + 1) : r * (q + 1) + (xcd - r) * q) + off; }
        const int nig = WGM * nN, gid = wgid / nig, fm = gid * WGM, gsz = (nM - fm) < WGM ? (nM - fm) : WGM;
        u.pm = fm + ((wgid % nig) % gsz); u.pn = (wgid % nig) / gsz; return true;
    }
};
struct SkipOrder {
    int nM, nN, nwg, G, c, nskip;
    __device__ void init(int M, int N, int G_, int c_, int nskip_) { nM = M / BM; nN = N / BM; nwg = nM * nN; G = G_; c = c_; nskip = nskip_; }
    __device__ bool next(int i, Unit& u) const {
        long L; if (i == 0) L = c; else { if (c < nskip) return false; L = G + (long)(i - 1) * (G - nskip) + (c - nskip); }
        if (L >= nwg) return false;
        int wgid = (int)L; { const int q = nwg / NXCD, r = nwg % NXCD, xcd = wgid % NXCD, off = wgid / NXCD; wgid = (xcd < r ? xcd * (q + 1) : r * (q + 1) + (xcd - r) * q) + off; }
        const int nig = WGM * nN, gid = wgid / nig, fm = gid * WGM, gsz = (nM - fm) < WGM ? (nM - fm) : WGM;
        u.pm = fm + ((wgid % nig) % gsz); u.pn = (wgid % nig) / gsz; return true;
    }
};
struct GroupOrder {
    int tpe, npe, nwg, G, c;
    __device__ void init(int tpe_, int npe_, int G_, int c_) { tpe = tpe_; npe = npe_; nwg = NE * tpe_ * npe_; G = G_; c = c_; }
    __device__ bool next(int i, Unit& u) const {
        const long L = (long)i * G + c; if (L >= nwg) return false;
        const int per = tpe * npe, e = (int)L / per, r = (int)L % per;
        u.pm = e * tpe + r % tpe; u.pn = e * npe + r / tpe; return true;
    }
};

typedef int i32x4_t __attribute__((ext_vector_type(4)));
typedef int i32x8_t __attribute__((ext_vector_type(8)));
template <class Epi, class Sched, bool ALIGN_EPI_ = true, bool SP2 = true, bool F8 = false>
__device__ __forceinline__ void gemm_phase(LAS unsigned char* lds, const Gemm g, const Sched& S, const Epi& E, const bool dry = false) {
#ifndef MK_ALIGN_EPI
#define MK_ALIGN_EPI 1
#endif
    constexpr bool ALIGN_EPI = ALIGN_EPI_ && MK_ALIGN_EPI;
    const int tid = tid_op(), wid = __builtin_amdgcn_readfirstlane(tid >> 6), lane = tid & 63, wr = wid >> 2, wc = wid & 3, fr = lane & 15, fq = lane >> 4;
    int K = g.K, lda = g.lda, ldb = g.ldb ? g.ldb : g.K; asm volatile("" : "+s"(K), "+s"(lda), "+s"(ldb));
    const int nt = K / BK;
    unsigned voffA[2], voffB[2];
#pragma unroll
    for (int i = 0; i < 2; ++i) { int R, C; stage_rc(tid * 16 + i * 8192, R, C); const int Rb = Epi::PERM ? ((R & ~31) + perm32(R & 31)) : R;
        voffA[i] = (unsigned)(R * lda + C) * 2u; voffB[i] = (unsigned)(Rb * ldb + C) * 2u; }
    const size_t kstep = (size_t)(BK * 2);
    const size_t hstepA = (size_t)HALF * lda * 2, hstepB = (size_t)HALF * ldb * 2;
    const size_t tstepA = 2 * hstepA, tstepB = 2 * hstepB;
    const unsigned ldsw = (unsigned)wid * 1024u, ldsb = (unsigned)(size_t)lds + ldsw;
    const int aoff = lds_byte(wr * 64 + fr, fq * 8), boff = lds_byte(wc * 32 + fr, fq * 8);
#define PG8_SA(b, h) (((b) * 2 + (h)) * HTB)
#define PG8_SB(b, h) ((4 + (b) * 2 + (h)) * HTB)
#define PG8_STAGE(bufoff, gbase, voff) do { _Pragma("unroll") for (int _i = 0; _i < 2; ++_i) \
        asm volatile("s_mov_b32 m0, %2\n\ts_nop 0\n\tglobal_load_lds_dwordx4 %0, %1" :: "v"((voff)[_i]), "s"((const char*)(gbase)), "s"(ldsb + (unsigned)((bufoff) + _i * 8192)) : "memory", "m0"); } while (0)
#define PG8_RD(off) (*(const LAS i32x4_t*)(lds + (off)))
#define PG8_LDA(dst, b, h) do { _Pragma("unroll") for (int m = 0; m < 4; ++m) { if constexpr (F8) dst##8[m] = __builtin_shufflevector(PG8_RD(PG8_SA(b, h) + aoff + m * 2048), PG8_RD(PG8_SA(b, h) + aoff + m * 2048 + 1024), 0, 1, 2, 3, 4, 5, 6, 7); \
        else { _Pragma("unroll") for (int k = 0; k < 2; ++k) dst[m][k] = *(const LAS bf16x8*)(lds + PG8_SA(b, h) + aoff + m * 2048 + k * 1024); } } } while (0)
#define PG8_LDB(dst, b, h) do { _Pragma("unroll") for (int n = 0; n < 2; ++n) { if constexpr (F8) dst##8[n] = __builtin_shufflevector(PG8_RD(PG8_SB(b, h) + boff + n * 2048), PG8_RD(PG8_SB(b, h) + boff + n * 2048 + 1024), 0, 1, 2, 3, 4, 5, 6, 7); \
        else { _Pragma("unroll") for (int k = 0; k < 2; ++k) dst[n][k] = *(const LAS bf16x8*)(lds + PG8_SB(b, h) + boff + n * 2048 + k * 1024); } } } while (0)
#define PG8_MMA(ai, bj, At, Bt) do { __builtin_amdgcn_s_setprio(1); _Pragma("unroll") for (int m = 0; m < 4; ++m) _Pragma("unroll") for (int n = 0; n < 2; ++n) { \
        if constexpr (F8) asm volatile("v_mfma_scale_f32_16x16x128_f8f6f4 %0, %1, %2, %0, %3, %4 op_sel_hi:[0,0,0]" : "+v"(acc[ai][bj][m][n]) : "v"(Bt##8[n]), "v"(At##8[m]), "v"(sc_w), "v"(sc_1)); \
        else { _Pragma("unroll") for (int k = 0; k < 2; ++k) acc[ai][bj][m][n] = __builtin_amdgcn_mfma_f32_16x16x32_bf16(Bt[n][k], At[m][k], acc[ai][bj][m][n], 0, 0, 0); } } __builtin_amdgcn_s_setprio(0); } while (0)
#define PG8_WAIT_V(n) asm volatile("s_waitcnt vmcnt(" #n ")" ::: "memory")
#define PG8_WAIT_VE(n) do { if (fe) asm volatile("s_waitcnt vmcnt(%0)" :: "n"(n) : "memory"); else PG8_WAIT_V(8); } while (0)
#define PG8_WAIT_L(n) asm volatile("s_waitcnt lgkmcnt(" #n ")" ::: "memory")
#define PG8_BAR __builtin_amdgcn_s_barrier()
#define PG8_SCHED __builtin_amdgcn_sched_barrier(0)
    constexpr int W12 = 8 + Epi::NST, W3 = 8 + (Epi::SPLIT ? Epi::NST / 2 : Epi::NST);
    Unit cur, nxt; int ui = 0; bool est = false;
    if (!S.next(0, cur)) return;
    f32x4 acc[2][2][4][2];
#pragma unroll
    for (int a = 0; a < 2; ++a)
#pragma unroll
        for (int b = 0; b < 2; ++b)
#pragma unroll
            for (int m = 0; m < 4; ++m)
#pragma unroll
                for (int n = 0; n < 2; ++n) acc[a][b][m][n] = (f32x4){0.f, 0.f, 0.f, 0.f};
    bf16x8 At[4][2], B0[2][2], B1[2][2];
    i32x8_t At8[4], B08[2], B18[2];
    const int sc_w = 0x7A7A7A7A, sc_1 = (0x7F - g.ash) * 0x01010101;
#ifndef MK_GEMMFOLD
#define MK_GEMMFOLD 0
#endif
#define PG8_PM(x) ((MK_GEMMFOLD && dry) ? ((x) & 7) : (x))
    const char* cA = (const char*)g.A + (size_t)PG8_PM(cur.pm) * tstepA + (size_t)(cur.pn >> 2) * g.agrp; const char* cB = (const char*)g.Bt + (size_t)cur.pn * tstepB + (size_t)(cur.pn >> 2) * g.bgrp;
    if constexpr (SP2) {
        PG8_STAGE(PG8_SB(0, 0), cB, voffB); PG8_STAGE(PG8_SB(0, 1), cB + hstepB, voffB); PG8_STAGE(PG8_SA(0, 0), cA, voffA); PG8_STAGE(PG8_SA(0, 1), cA + hstepA, voffA);
        if (wr == 1) PG8_BAR;
        PG8_WAIT_V(2); PG8_BAR;
        PG8_STAGE(PG8_SB(1, 0), cB + kstep, voffB); PG8_STAGE(PG8_SA(1, 0), cA + kstep, voffA); PG8_STAGE(PG8_SB(1, 1), cB + hstepB + kstep, voffB); PG8_STAGE(PG8_SA(1, 1), cA + hstepA + kstep, voffA);
        PG8_WAIT_V(8); PG8_BAR;
    } else {
        PG8_STAGE(PG8_SB(0, 0), cB, voffB); PG8_STAGE(PG8_SA(0, 0), cA, voffA); PG8_STAGE(PG8_SB(0, 1), cB + hstepB, voffB); PG8_STAGE(PG8_SA(0, 1), cA + hstepA, voffA);
        if (wr == 1) PG8_BAR;
        PG8_WAIT_V(4); PG8_BAR;
        PG8_STAGE(PG8_SB(1, 0), cB + kstep, voffB); PG8_STAGE(PG8_SA(1, 0), cA + kstep, voffA); PG8_STAGE(PG8_SB(1, 1), cB + hstepB + kstep, voffB);
        PG8_WAIT_V(6); PG8_BAR;
    }
    for (;;) {
        bool has_next = false; const char* nA = cA; const char* nB = cB;
        if constexpr (!SP2) { has_next = S.next(ui + 1, nxt); if (has_next) { nA = (const char*)g.A + (size_t)PG8_PM(nxt.pm) * tstepA + (size_t)(nxt.pn >> 2) * g.agrp; nB = (const char*)g.Bt + (size_t)nxt.pn * tstepB + (size_t)(nxt.pn >> 2) * g.bgrp; } }
        for (int t = 0; t < nt; t += 2) {
            const bool last = (t == nt - 2);
            [[maybe_unused]] const char* a1 = cA + (size_t)(t + 1) * kstep;
            const bool fe = (t == 0) && est;
            if constexpr (SP2) {
            PG8_LDB(B0, 0, 0); PG8_LDB(B1, 0, 1); PG8_SCHED; PG8_LDA(At, 0, 0);
            PG8_WAIT_VE(W12); PG8_WAIT_L(0); PG8_BAR; PG8_MMA(0, 0, At, B0); PG8_MMA(0, 1, At, B1); PG8_BAR; PG8_SCHED;
            if (t == 0) { has_next = S.next(ui + 1, nxt); if (has_next) { nA = (const char*)g.A + (size_t)PG8_PM(nxt.pm) * tstepA + (size_t)(nxt.pn >> 2) * g.agrp; nB = (const char*)g.Bt + (size_t)nxt.pn * tstepB + (size_t)(nxt.pn >> 2) * g.bgrp; } }
            const char* a2 = last ? nA : cA + (size_t)(t + 2) * kstep; const char* b2 = last ? nB : cB + (size_t)(t + 2) * kstep;
            const char* a3 = a2 + kstep; const char* b3 = b2 + kstep;
            PG8_LDA(At, 0, 1); PG8_STAGE(PG8_SB(0, 0), b2, voffB); PG8_STAGE(PG8_SB(0, 1), b2 + hstepB, voffB); PG8_STAGE(PG8_SA(0, 0), a2, voffA);
            PG8_WAIT_VE(W12); PG8_WAIT_L(0); PG8_BAR; PG8_MMA(1, 0, At, B0); PG8_MMA(1, 1, At, B1); PG8_BAR; PG8_SCHED;
            PG8_LDB(B0, 1, 0); PG8_LDB(B1, 1, 1); PG8_SCHED; PG8_LDA(At, 1, 0); PG8_STAGE(PG8_SA(0, 1), a2 + hstepA, voffA);
            PG8_WAIT_VE(W3); PG8_WAIT_L(0); PG8_BAR; PG8_MMA(0, 0, At, B0); PG8_MMA(0, 1, At, B1); PG8_BAR; PG8_SCHED;
            PG8_LDA(At, 1, 1); PG8_STAGE(PG8_SB(1, 0), b3, voffB); PG8_STAGE(PG8_SB(1, 1), b3 + hstepB, voffB); PG8_STAGE(PG8_SA(1, 0), a3, voffA);
            PG8_WAIT_V(8);
            if constexpr (Epi::SPLIT) { if (last && !dry) { const int te = tid_op(), we = __builtin_amdgcn_readfirstlane(te >> 6), le = te & 63; E.template half<0>(acc, cur, we >> 2, we & 3, le & 15, le >> 4); } }
            PG8_WAIT_L(0); PG8_BAR; PG8_MMA(1, 0, At, B0); PG8_MMA(1, 1, At, B1); PG8_BAR; PG8_SCHED;
            PG8_STAGE(PG8_SA(1, 1), a3 + hstepA, voffA);
            } else {
            const char* a2 = last ? nA : cA + (size_t)(t + 2) * kstep; const char* b2 = last ? nB : cB + (size_t)(t + 2) * kstep;
            const char* a3 = a2 + kstep; const char* b3 = b2 + kstep;
            PG8_LDB(B0, 0, 0); PG8_SCHED; PG8_LDA(At, 0, 0); PG8_STAGE(PG8_SA(1, 1), a1 + hstepA, voffA);
            PG8_WAIT_L(8); PG8_BAR; PG8_WAIT_L(0); PG8_MMA(0, 0, At, B0); PG8_BAR; PG8_SCHED;
            PG8_LDB(B1, 0, 1); PG8_STAGE(PG8_SB(0, 0), b2, voffB);
            PG8_BAR; PG8_WAIT_L(0); PG8_MMA(0, 1, At, B1); PG8_BAR;
            PG8_LDA(At, 0, 1); PG8_STAGE(PG8_SA(0, 0), a2, voffA);
            PG8_BAR; PG8_WAIT_L(0); PG8_MMA(1, 0, At, B0); PG8_BAR; PG8_SCHED;
            PG8_STAGE(PG8_SB(0, 1), b2 + hstepB, voffB);
            PG8_WAIT_V(6); PG8_BAR; PG8_MMA(1, 1, At, B1); PG8_BAR;
            PG8_LDB(B0, 1, 0); PG8_SCHED; PG8_LDA(At, 1, 0); PG8_STAGE(PG8_SA(0, 1), a2 + hstepA, voffA);
            PG8_WAIT_L(8); PG8_BAR; PG8_WAIT_L(0); PG8_MMA(0, 0, At, B0); PG8_BAR; PG8_SCHED;
            PG8_LDB(B1, 1, 1); PG8_STAGE(PG8_SB(1, 0), b3, voffB);
            PG8_BAR; PG8_WAIT_L(0); PG8_MMA(0, 1, At, B1); PG8_BAR;
            PG8_LDA(At, 1, 1); PG8_STAGE(PG8_SA(1, 0), a3, voffA);
            PG8_BAR; PG8_WAIT_L(0); PG8_MMA(1, 0, At, B0); PG8_BAR; PG8_SCHED;
            PG8_STAGE(PG8_SB(1, 1), b3 + hstepB, voffB);
            PG8_WAIT_V(6); PG8_BAR; PG8_MMA(1, 1, At, B1); PG8_BAR;
            }
        }
        if constexpr (ALIGN_EPI) { if (wr == 0) PG8_BAR; }
        if constexpr (F8) asm volatile("s_nop 15\n\ts_nop 15" ::: "memory");
        if (!dry) { const int te = tid_op(), we = __builtin_amdgcn_readfirstlane(te >> 6), le = te & 63;
            if constexpr (Epi::SPLIT) E.template half<1>(acc, cur, we >> 2, we & 3, le & 15, le >> 4); else E(acc, cur, we >> 2, we & 3, le & 15, le >> 4); }
        est = !dry && E.counted(cur);
        if (!has_next) break;
#pragma unroll
        for (int a = 0; a < 2; ++a)
#pragma unroll
            for (int b = 0; b < 2; ++b)
#pragma unroll
                for (int m = 0; m < 4; ++m)
#pragma unroll
                    for (int n = 0; n < 2; ++n) acc[a][b][m][n] = (f32x4){0.f, 0.f, 0.f, 0.f};
        cur = nxt; cA = nA; cB = nB; ++ui;
        if constexpr (ALIGN_EPI) { if (wr == 1) PG8_BAR; }
    }
    PG8_WAIT_V(0);
    if constexpr (!ALIGN_EPI) { if (wr == 0) PG8_BAR; }
    PG8_BAR;
#undef PG8_SA
#undef PG8_SB
#undef PG8_STAGE
#undef PG8_LDA
#undef PG8_LDB
#undef PG8_MMA
#undef PG8_RD
#undef PG8_WAIT_V
#undef PG8_WAIT_VE
#undef PG8_WAIT_L
#undef PG8_BAR
#undef PG8_SCHED
}
}
#ifndef MK_F8_RKV
#define MK_F8_RKV 1
#endif
#ifndef MK_F8_OUT0
#define MK_F8_OUT0 1
#endif
#ifndef MK_F8_OUT1
#define MK_F8_OUT1 1
#endif
enum { I_X = 0, I_C, I_CTX, I_CCTX, I_ADAW, I_ADAB, I_NORMG, I_ROUTER, I_W1, I_W3, I_W2, I_ABIN, I_ABOUT, I_MLGB, I_MLNG, I_CONVW, I_CONVB, I_DTB, I_ALOG, I_SSD, I_SSNG,
       I_MU, I_WR, I_WK, I_WV, I_WO, I_W0, I_RW1, I_RW2, I_A0, I_A1, I_A2, I_G1, I_G2, I_KK, I_KA, I_RK, I_LNG, I_LNB, N_IN };
struct Args { const float* in[N_IN]; float* out; unsigned char* ws; int ph_lo, ph_hi; };
DI const float* inp(int i) { return ((const float* const volatile __attribute__((address_space(4)))*)__builtin_amdgcn_kernarg_segment_ptr())[i]; }

constexpr int LDS_BYTES = 163840;
constexpr int LDS_BARW = 163824;

DI const float* modp(const Args& a, int layer, int s, int n) { return (const float*)(a.ws + WS_MOD) + ((size_t)(layer * 9 + s) * 6 + n) * 1024; }
DI int row_mod_s(int row) { return row < NL ? (row >> 13) : 8; }

constexpr int CVT_KT = 256;
template <class F> DI void cvt_tile(LAS bf16_t* tl, bf16_t* dst, int ldk, int n0, int k0, F f) {
    const int tid = tid_op();
    float v[CVT_KT / 8];
#pragma unroll
    for (int p = 0; p < CVT_KT / 8; ++p) { const int kl = p * 8 + (tid >> 6), nl = tid & 63; v[p] = f(k0 + kl, n0 + nl); }
#pragma unroll
    for (int p = 0; p < CVT_KT / 8; ++p) { const int kl = p * 8 + (tid >> 6), nl = tid & 63; tl[nl * (CVT_KT + 8) + kl] = f2bf(v[p]); }
    __syncthreads();
#pragma unroll
    for (int q = 0; q < CVT_KT / 64; ++q) { const int nl = tid >> 3, kc = (tid & 7) + 8 * q; const u32x4 w = *(const LAS u32x4*)(tl + nl * (CVT_KT + 8) + kc * 8); *(u32x4*)(dst + (size_t)(n0 + nl) * ldk + k0 + kc * 8) = w; }
    __syncthreads();
}

DI void cvt_tile_f8(LAS unsigned char* tl, const float* src, int ld, int c0, int k0, unsigned char* dst, int ldk, int n0, bool zero) {
    const int tid = tid_op(), f4 = tid & 15, kq = tid >> 4;
    if (!zero) {
        f32x4 v[4];
#pragma unroll
        for (int j = 0; j < 4; ++j) v[j] = *(const f32x4*)(src + (size_t)(k0 + kq + 32 * j) * ld + c0 + 4 * f4);
#pragma unroll
        for (int j = 0; j < 4; ++j)
#pragma unroll
            for (int i = 0; i < 4; ++i) tl[(4 * f4 + i) * 144 + kq + 32 * j] = (unsigned char)(pk_fp8x4(v[j][i] * 32.f, 0.f, 0.f, 0.f) & 0xffu);
    }
    __syncthreads();
    { const int nl = tid >> 3, pc = tid & 7; u32x4 w = (u32x4){0u, 0u, 0u, 0u}; if (!zero) w = *(const LAS u32x4*)(tl + nl * 144 + pc * 16);
      *(u32x4*)(dst + (size_t)(n0 + nl) * ldk + k0 + pc * 16) = w; }
    __syncthreads();
}
constexpr int IT_MOD = 192;
constexpr int IT_WIN = 92 * (1024 / CVT_KT), IT_WOUT = MK_F8_OUT0 ? 16 * 16 : 16 * (2048 / CVT_KT), IT_WRW = MK_F8_RKV ? 48 * 8 + 8 * (2048 / CVT_KT) : 56 * (2048 / CVT_KT), IT_WO = MK_F8_OUT1 ? 16 * 8 : 16 * (1024 / CVT_KT), IT_W2A = 48 * (256 / CVT_KT), IT_G2 = 16 * (256 / CVT_KT);
constexpr int IT_P0A = IT_MOD + IT_WIN + IT_WOUT + IT_WRW + IT_WO + IT_W2A + IT_G2;

DI void mod_item(const Args& a, LAS unsigned char* lds, int item) {
    LAS float* sc = (LAS float*)lds;
    LAS float* red = sc + 9 * 1024;
    const int tid = tid_op(), l = item / 96, cg = item % 96;
    const float* pc = inp(I_C); const float* pcc = inp(I_CCTX); const float* padab = inp(I_ADAB);
    for (int i = tid; i < 9 * 1024; i += 512) { const int s = i >> 10, k = i & 1023; const float c = (s < 8) ? pc[s * 1024 + k] : pcc[k]; sc[i] = siluf_(c); }
    __syncthreads();
    const int col = tid & 63, ks = tid >> 6;
    float acc[9];
#pragma unroll
    for (int s = 0; s < 9; ++s) acc[s] = 0.f;
    const float* w = inp(I_ADAW) + (size_t)l * 1024 * 6144 + cg * 64 + col;
    for (int kb = 0; kb < 128; kb += 32) { float wv[32];
#pragma unroll
        for (int j = 0; j < 32; ++j) wv[j] = w[(size_t)(ks * 128 + kb + j) * 6144];
#pragma unroll
        for (int j = 0; j < 32; ++j) { const int k = ks * 128 + kb + j;
#pragma unroll
            for (int s = 0; s < 9; ++s) acc[s] += sc[s * 1024 + k] * wv[j]; } }
#pragma unroll
    for (int s = 0; s < 9; ++s) red[(ks * 9 + s) * 64 + col] = acc[s];
    __syncthreads();
    for (int i = tid; i < 9 * 64; i += 512) { const int s = i >> 6, c = i & 63; float v = padab[l * 6144 + cg * 64 + c];
#pragma unroll
        for (int k2 = 0; k2 < 8; ++k2) v += red[(k2 * 9 + s) * 64 + c];
        ((float*)(a.ws + WS_MOD))[(size_t)(l * 9 + s) * 6144 + cg * 64 + c] = v; }
    __syncthreads();
}

DI void p0a_phase(const Args& a, LAS unsigned char* lds) {
    LAS bf16_t* tl = (LAS bf16_t*)lds;
    for (int item = blockIdx.x; item < IT_P0A; item += gridDim.x) {
        int it = item;
        if (it < IT_MOD) { mod_item(a, lds, it); continue; }
        it -= IT_MOD;
        if (it < IT_WIN) { const int n0 = (it % 92) * 64, k0 = (it / 92) * CVT_KT; const float* src = inp(I_ABIN);
            cvt_tile(tl, (bf16_t*)(a.ws + WS_WIN), 1024, n0, k0, [&](int k, int n) -> float {
                if (n >= 5680) return 0.f;
                const int col = n < 3072 ? n : (n < 5632 ? n + 16 : (n < 5648 ? n - 2560 : n));
                const float v = src[(size_t)k * 5680 + col];
                return (n >= 512 && n < 1024) ? v * 0.08838834764831845f : v; });
            continue; }
        it -= IT_WIN;
        if (it < IT_WOUT) { const float* src = inp(I_ABOUT);
            if (MK_F8_OUT0) { const int n0 = (it % 16) * 64, k0 = (it / 16) * 128; cvt_tile_f8(lds, src, 1024, n0, k0, a.ws + WS_WOUT, 2048, n0, false); }
            else { const int n0 = (it % 16) * 64, k0 = (it / 16) * CVT_KT;
            cvt_tile(tl, (bf16_t*)(a.ws + WS_WOUT), 2048, n0, k0, [&](int k, int n) -> float { return src[(size_t)k * 1024 + n]; }); }
            continue; }
        it -= IT_WOUT;
        if (MK_F8_RKV && it < 48 * 8) {
            const int nt_ = it % 48, k0 = (it / 48) * 128, grp = nt_ >> 4, n0 = (nt_ & 15) * 64; const float* src = grp == 0 ? inp(I_WR) : (grp == 1 ? inp(I_WK) : inp(I_WV));
            cvt_tile_f8(lds, src, 1024, n0, k0, a.ws + WS_WRW + (size_t)grp * 1024 * 4096, 4096, n0, false); continue; }
        if (it < IT_WRW) { const int itl = MK_F8_RKV ? it - 48 * 8 : it, ntl = MK_F8_RKV ? 8 : 56; const int n0 = (MK_F8_RKV ? 3072 : 0) + (itl % ntl) * 64, k0 = (itl / ntl) * CVT_KT; const float* mu = inp(I_MU);
            const float *wr = inp(I_WR), *wk = inp(I_WK), *wv = inp(I_WV), *w1 = inp(I_RW1), *a1 = inp(I_A1), *g1 = inp(I_G1);
            cvt_tile(tl, (bf16_t*)(a.ws + WS_WRW), 2048, n0, k0, [&](int k, int n) -> float {
                const int kk = k & 1023; float w; int mi;
                if (n < 1024) { w = wr[(size_t)kk * 1024 + n]; mi = 0; }
                else if (n < 2048) { w = wk[(size_t)kk * 1024 + n - 1024]; mi = 2; }
                else if (n < 3072) { w = wv[(size_t)kk * 1024 + n - 2048]; mi = 3; }
                else if (n < 3136) { w = w1[(size_t)kk * 64 + n - 3072]; mi = 1; }
                else if (n < 3200) { w = w1[(size_t)(1024 + kk) * 64 + n - 3136]; mi = 1; }
                else if (n < 3264) { w = a1[(size_t)kk * 64 + n - 3200]; mi = 4; }
                else if (n < 3328) return 0.f;
                else if (n < 3488) { w = g1[(size_t)kk * 160 + n - 3328]; mi = 5; }
                else return 0.f;
                if (n < 3072) return k < 1024 ? w : 0.f;
                const float m = mu[mi * 1024 + kk];
                return w * (k >= 1024 ? m : 1.f - m); });
            continue; }
        it -= IT_WRW;
        if (it < IT_WO) { const float* src = inp(I_WO);
            if (MK_F8_OUT1) { const int n0 = (it % 16) * 64, k0 = (it / 16) * 128; cvt_tile_f8(lds, src, 1024, n0, k0, a.ws + WS_WO, 1024, n0, false); }
            else { const int n0 = (it % 16) * 64, k0 = (it / 16) * CVT_KT;
            cvt_tile(tl, (bf16_t*)(a.ws + WS_WO), 1024, n0, k0, [&](int k, int n) -> float { return src[(size_t)k * 1024 + n]; }); }
            continue; }
        it -= IT_WO;
        if (it < IT_W2A) { const int n0 = (it % 48) * 64, k0 = (it / 48) * CVT_KT; const float *w2 = inp(I_RW2), *a2 = inp(I_A2);
            cvt_tile(tl, (bf16_t*)(a.ws + WS_W2A), 256, n0, k0, [&](int k, int n) -> float {
                if (n < 1024) return k < 64 ? w2[(size_t)k * 1024 + n] : 0.f;
                if (n < 2048) return (k >= 64 && k < 128) ? w2[(size_t)k * 1024 + n - 1024] : 0.f;
                return (k >= 128 && k < 192) ? a2[(size_t)(k - 128) * 1024 + n - 2048] : 0.f; });
            continue; }
        it -= IT_W2A;
        { const int n0 = (it % 16) * 64, k0 = (it / 16) * CVT_KT; const float* g2 = inp(I_G2);
            cvt_tile(tl, (bf16_t*)(a.ws + WS_G2), 256, n0, k0, [&](int k, int n) -> float { return k < 160 ? g2[(size_t)k * 1024 + n] : 0.f; }); }
    }
}

constexpr int IT_W13 = 16 * 44 * 8, IT_W2E = 16 * 16 * 12;
constexpr size_t W13_BYTES = (size_t)16 * 2816 * 1024;
constexpr int FFP = 1536;
DI void expert_cvt_items(const Args& a, LAS unsigned char* lds, int layer, unsigned char* dst, int max_tiles = 1 << 30, unsigned char* dst2 = nullptr, int parts = 3) {
    const float* pw1 = inp(I_W1); const float* pw3 = inp(I_W3); const float* pw2 = inp(I_W2);
    unsigned* q = (unsigned*)(a.ws + WS_CTL + 32768) + 64 * layer;
    LAS unsigned* slot = (LAS unsigned*)(lds + 16384);
    int n = 0;
    if (parts & 1) for (; n < max_tiles; ++n) {
        if (threadIdx.x == 0) *slot = __hip_atomic_fetch_add(q, 1u, __ATOMIC_RELAXED, __HIP_MEMORY_SCOPE_AGENT);
        __syncthreads();
        const int item = (int)*slot;
        __syncthreads();
        if (item >= IT_W13) break;
        const int e = item / 352, r = item % 352, nt = r % 44, k0 = (r / 44) * 128;
        const int tile = nt >> 2, half = (nt >> 1) & 1, c0 = tile * 128 + (nt & 1) * 64;
        const float* src = (half ? pw3 : pw1) + (size_t)(layer * 16 + e) * 1024 * 1408;
        cvt_tile_f8(lds, src, 1408, c0, k0, dst + (size_t)e * 2816 * 1024, 1024, nt * 64, false);
    }
    if (parts & 2) for (; n < max_tiles; ++n) {
        if (threadIdx.x == 0) *slot = __hip_atomic_fetch_add(q + 1, 1u, __ATOMIC_RELAXED, __HIP_MEMORY_SCOPE_AGENT);
        __syncthreads();
        const int it = (int)*slot;
        __syncthreads();
        if (it >= IT_W2E) break;
        const int e = it / 192, r = it % 192, nt = r % 16, kt = r / 16;
        const float* src = pw2 + (size_t)(layer * 16 + e) * 1408 * 1024;
        cvt_tile_f8(lds, src, 1024, nt * 64, kt * 128, (dst2 ? dst2 : dst + W13_BYTES) + (size_t)e * 1024 * FFP, FFP, nt * 64, kt == 11);
    }
}

DI void ld_row_f32(const float* p, int lane, f32x4 (&v)[4]) {
#pragma unroll
    for (int i = 0; i < 4; ++i) v[i] = *(const f32x4*)(p + i * 256 + lane * 4);
}
DI void ld_row_bf16(const bf16_t* p, int lane, f32x4 (&v)[4]) {
#pragma unroll
    for (int i = 0; i < 4; ++i) { const u32x2 w = *(const u32x2*)(p + i * 256 + lane * 4); v[i] = (f32x4){bflo(w.x), bfhi(w.x), bflo(w.y), bfhi(w.y)}; }
}
DI void ld_row_raw(const bf16_t* p, int lane, u32x2 (&v)[4]) {
#pragma unroll
    for (int i = 0; i < 4; ++i) v[i] = *(const u32x2*)(p + i * 256 + lane * 4);
}
DI void cvt_row(const u32x2 (&w)[4], f32x4 (&v)[4]) {
#pragma unroll
    for (int i = 0; i < 4; ++i) v[i] = (f32x4){bflo(w[i].x), bfhi(w[i].x), bflo(w[i].y), bfhi(w[i].y)};
}
DI void st_row_bf16(bf16_t* p, int lane, const f32x4 (&v)[4]) {
#pragma unroll
    for (int i = 0; i < 4; ++i) { u32x2 w; w.x = pkbf(v[i][0], v[i][1]); w.y = pkbf(v[i][2], v[i][3]); *(u32x2*)(p + i * 256 + lane * 4) = w; }
}
constexpr float F8_ACT = 8.f; constexpr int F8_ACT_SH = 3;
constexpr float F8_HID = 4.f; constexpr int F8_HID_SH = 2;
DI void st_row_f8(unsigned char* p, int lane, const f32x4 (&v)[4]) {
#pragma unroll
    for (int i = 0; i < 4; ++i) *(unsigned*)(p + i * 256 + lane * 4) = pk_fp8x4(v[i][0] * F8_ACT, v[i][1] * F8_ACT, v[i][2] * F8_ACT, v[i][3] * F8_ACT);
}
DI float sumsq4(const f32x4 (&v)[4]) { float s = 0.f;
#pragma unroll
    for (int i = 0; i < 4; ++i) s += (v[i][0] * v[i][0] + v[i][1] * v[i][1]) + (v[i][2] * v[i][2] + v[i][3] * v[i][3]);
    return s; }
DI void norm_mod(const f32x4 (&x)[4], const float* g, const float* shift, const float* scale, int lane, f32x4 (&h)[4]) {
    const float r = rsqrtf(wave_sum(sumsq4(x)) * (1.f / 1024.f) + RMS_EPS);
#pragma unroll
    for (int i = 0; i < 4; ++i) { const int c = i * 256 + lane * 4; const f32x4 gv = *(const f32x4*)(g + c), sh = *(const f32x4*)(shift + c), sc = *(const f32x4*)(scale + c);
        h[i] = x[i] * r * gv * (sc + 1.f) + sh; }
}

DI void p0b_phase(const Args& a, bf16_t* hbuf) {
    const int tid_ = tid_op(), lane = tid_ & 63, wid = tid_ >> 6;
    const float* px = inp(I_X); const float* pctx = inp(I_CTX); const float* png = inp(I_NORMG);
    const int stride = gridDim.x * 8;
    int row = blockIdx.x * 8 + wid;
    f32x4 x[4];
    if (row < NR) ld_row_f32(row < NL ? px + (size_t)row * 1024 : pctx + (size_t)(row - NL) * 1024, lane, x);
    for (; row < NR; row += stride) {
        f32x4 xn[4], h[4]; const int nr = row + stride;
#pragma unroll
        for (int i = 0; i < 4; ++i) xn[i] = x[i];
        if (nr < NR) ld_row_f32(nr < NL ? px + (size_t)nr * 1024 : pctx + (size_t)(nr - NL) * 1024, lane, xn);
        const int s = row_mod_s(row);
        norm_mod(x, png, modp(a, 0, s, 0), modp(a, 0, s, 1), lane, h);
        st_row_bf16(hbuf + (size_t)row * 1024, lane, h);
#pragma unroll
        for (int i = 0; i < 4; ++i) x[i] = xn[i];
    }
}

typedef pg8::Unit Unit;
DI u32x4 pack_acc(const f32x4 v0, const f32x4 v1) { u32x4 w; w.x = pkbf(v0[0], v0[1]); w.y = pkbf(v0[2], v0[3]); w.z = pkbf(v1[0], v1[1]); w.w = pkbf(v1[2], v1[3]); return w; }

struct EpiProj {
    static constexpr bool PERM = true; static constexpr bool SPLIT = MK_SPLIT; static constexpr int NST = 16; DI bool counted(const Unit& u) const { return u.pn < 22; }
    unsigned char* ws; float* GD;
    template <int ai> DI void half(const f32x4 (&acc)[2][2][4][2], const Unit& u, int wr, int wc, int fr, int fq) const {
        const int row0 = u.pm * 256 + wr * 64 + fr, pn = u.pn;
        if (pn < 22) {
            const int slot = pn < 4 ? 1 : pn < 8 ? 4 : pn < 16 ? 5 : 2, first = pn < 4 ? 0 : pn < 8 ? 4 : pn < 16 ? 8 : 16, ldc = pn < 8 ? 1024 : pn < 16 ? 2048 : 1536;
            bf16_t* base = (bf16_t*)(ws + slot_off(slot));
            const int col0 = (pn - first) * 256 + wc * 32 + 8 * fq;
#pragma unroll
            for (int m = 0; m < 4; ++m) { bf16_t* rowp = base + (size_t)(row0 + ai * 128 + m * 16) * ldc + col0;
#pragma unroll
                for (int bj = 0; bj < 2; ++bj) *(u32x4*)(rowp + bj * 128) = pack_acc(acc[ai][bj][m][0], acc[ai][bj][m][1]); }
        } else if (wc * 32 + 8 * fq < 48) {
            const int c0 = wc * 32 + 8 * fq;
#pragma unroll
            for (int m = 0; m < 4; ++m) { float* rowp = GD + (size_t)(row0 + ai * 128 + m * 16) * 48 + c0;
                *(f32x4*)(rowp) = acc[ai][0][m][0]; *(f32x4*)(rowp + 4) = acc[ai][0][m][1]; }
        }
    }
    DI void operator()(const f32x4 (&acc)[2][2][4][2], const Unit& u, int wr, int wc, int fr, int fq) const { half<0>(acc, u, wr, wc, fr, fq); half<1>(acc, u, wr, wc, fr, fq); }
};
struct EpiPlain {
    static constexpr bool PERM = true; static constexpr bool SPLIT = MK_SPLIT; static constexpr int NST = 16; DI bool counted(const Unit& u) const { return true; }
    bf16_t* O; int ldc;
    template <int ai> DI void half(const f32x4 (&acc)[2][2][4][2], const Unit& u, int wr, int wc, int fr, int fq) const {
        const int row0 = u.pm * 256 + wr * 64 + fr, col0 = u.pn * 256 + wc * 32 + 8 * fq;
#pragma unroll
        for (int m = 0; m < 4; ++m) { bf16_t* rowp = O + (size_t)(row0 + ai * 128 + m * 16) * ldc + col0;
#pragma unroll
            for (int bj = 0; bj < 2; ++bj) *(u32x4*)(rowp + bj * 128) = pack_acc(acc[ai][bj][m][0], acc[ai][bj][m][1]); }
    }
    DI void operator()(const f32x4 (&acc)[2][2][4][2], const Unit& u, int wr, int wc, int fr, int fq) const { half<0>(acc, u, wr, wc, fr, fq); half<1>(acc, u, wr, wc, fr, fq); }
};
struct EpiPlainG {
    static constexpr bool PERM = true; static constexpr bool SPLIT = MK_SPLIT; static constexpr int NST = 16; DI bool counted(const Unit& u) const { return true; }
    bf16_t* O;
    template <int ai> DI void half(const f32x4 (&acc)[2][2][4][2], const Unit& u, int wr, int wc, int fr, int fq) const {
        const int row0 = u.pm * 256 + wr * 64 + fr, col0 = (u.pn & 3) * 256 + wc * 32 + 8 * fq;
        bf16_t* base = O + (size_t)(u.pn >> 2) * (USZ / 2);
#pragma unroll
        for (int m = 0; m < 4; ++m) { bf16_t* rowp = base + (size_t)(row0 + ai * 128 + m * 16) * 1024 + col0;
#pragma unroll
            for (int bj = 0; bj < 2; ++bj) *(u32x4*)(rowp + bj * 128) = pack_acc(acc[ai][bj][m][0], acc[ai][bj][m][1]); }
    }
    DI void operator()(const f32x4 (&acc)[2][2][4][2], const Unit& u, int wr, int wc, int fr, int fq) const { half<0>(acc, u, wr, wc, fr, fq); half<1>(acc, u, wr, wc, fr, fq); }
};
struct EpiSwiglu {
    static constexpr bool PERM = true; static constexpr bool SPLIT = MK_SPLIT_SWIGLU; static constexpr int NST = 8; DI bool counted(const Unit& u) const { return true; }
    unsigned char* HID;
    DI void operator()(const f32x4 (&acc)[2][2][4][2], const Unit& u, int wr, int wc, int fr, int fq) const { half<0>(acc, u, wr, wc, fr, fq); half<1>(acc, u, wr, wc, fr, fq); }
    template <int ai> DI void half(const f32x4 (&acc)[2][2][4][2], const Unit& u, int wr, int wc, int fr, int fq) const {
        const int row0 = u.pm * 256 + wr * 64 + fr, t = u.pn % 11, col0 = t * 128 + wc * 32 + 8 * fq;
        {
#pragma unroll
            for (int m = 0; m < 4; ++m) { f32x4 h0, h1;
#pragma unroll
                for (int j = 0; j < 4; ++j) { h0[j] = siluf_(acc[ai][0][m][0][j]) * acc[ai][1][m][0][j] * F8_HID; h1[j] = siluf_(acc[ai][0][m][1][j]) * acc[ai][1][m][1][j] * F8_HID; }
                unsigned char* rp = HID + (size_t)(row0 + ai * 128 + m * 16) * FFP + col0;
                u32x2 w; w.x = pk_fp8x4(h0[0], h0[1], h0[2], h0[3]); w.y = pk_fp8x4(h1[0], h1[1], h1[2], h1[3]); *(u32x2*)rp = w;
                if (t == 10) *(u32x2*)(rp + 128) = (u32x2){0u, 0u}; }
        }
    }
};
struct EpiGate {
    static constexpr bool PERM = true; static constexpr bool SPLIT = false; static constexpr int NST = 16; DI bool counted(const Unit& u) const { return true; }
    bf16_t* Y; const float* gate;
    DI void operator()(const f32x4 (&acc)[2][2][4][2], const Unit& u, int wr, int wc, int fr, int fq) const {
        const int row0 = u.pm * 256 + wr * 64 + fr, col0 = (u.pn & 3) * 256 + wc * 32 + 8 * fq;
#pragma unroll
        for (int ai = 0; ai < 2; ++ai)
#pragma unroll
            for (int m = 0; m < 4; ++m) { const int row = row0 + ai * 128 + m * 16; const float gv = gate[row]; bf16_t* rowp = Y + (size_t)row * 1024 + col0;
#pragma unroll
                for (int bj = 0; bj < 2; ++bj) *(u32x4*)(rowp + bj * 128) = pack_acc(acc[ai][bj][m][0] * gv, acc[ai][bj][m][1] * gv); }
    }
};
DI void cv_unpack(const u32x4 w, float (&f)[8]) { unpack8(w, f); }
DI void conv_phase(const Args& a, LAS unsigned char* lds, const bf16_t* XBC, bf16_t* XC) {
    const int tid = tid_op(), ch = tid & 7, x = tid >> 3;
    const float* pw = inp(I_CONVW); const float* pb = inp(I_CONVB);
    for (int item = blockIdx.x; item < 768 + 768; item += gridDim.x) {
        const bool lat = item < 768; const int it = lat ? item : item - 768, seg = it & 3, cg = (it >> 2) % 24, b = (it >> 2) / 24, c0 = (cg * 8 + ch) * 8;
        float w[9][8], acc0[8];
#pragma unroll
        for (int t = 0; t < 9; ++t) { const f32x4 w0 = *(const f32x4*)(pw + t * 1536 + c0), w1 = *(const f32x4*)(pw + t * 1536 + c0 + 4);
#pragma unroll
            for (int j = 0; j < 4; ++j) { w[t][j] = w0[j]; w[t][4 + j] = w1[j]; } }
        { const f32x4 b0 = *(const f32x4*)(pb + c0), b1 = *(const f32x4*)(pb + c0 + 4);
#pragma unroll
          for (int j = 0; j < 4; ++j) { acc0[j] = b0[j]; acc0[4 + j] = b1[j]; } }
        const u32x4 z4 = (u32x4){0u, 0u, 0u, 0u};
        if (lat) {
            const int y0 = seg * 32; const bf16_t* base = XBC + (size_t)(b * T) * 1536 + c0;
            auto ldrow = [&](int y, u32x4 (&r)[3]) {
                const bool yok = (y >= 0) && (y < 128); const bf16_t* p = base + (size_t)(y * 64 + x) * 1536;
                r[0] = (yok && x > 0) ? *(const u32x4*)(p - 1536) : z4; r[1] = yok ? *(const u32x4*)p : z4; r[2] = (yok && x < 63) ? *(const u32x4*)(p + 1536) : z4; };
            float ra[3][8], rb[3][8], rc[3][8]; u32x4 raw[3];
            ldrow(y0 - 1, raw);
#pragma unroll
            for (int d = 0; d < 3; ++d) cv_unpack(raw[d], ra[d]);
            ldrow(y0, raw);
#pragma unroll
            for (int d = 0; d < 3; ++d) cv_unpack(raw[d], rb[d]);
            ldrow(y0 + 1, raw);
            for (int yy = 0; yy < 32; ++yy) {
                const int y = y0 + yy;
#pragma unroll
                for (int d = 0; d < 3; ++d) cv_unpack(raw[d], rc[d]);
                ldrow(y + 2, raw);
                float acc[8];
#pragma unroll
                for (int j = 0; j < 8; ++j) { float s = acc0[j];
#pragma unroll
                    for (int d = 0; d < 3; ++d) s += w[d][j] * ra[d][j] + w[3 + d][j] * rb[d][j] + w[6 + d][j] * rc[d][j];
                    acc[j] = siluf_(s); }
                *(u32x4*)(XC + (size_t)(b * T + y * 64 + x) * 1536 + c0) = pack8(acc);
#pragma unroll
                for (int d = 0; d < 3; ++d)
#pragma unroll
                    for (int j = 0; j < 8; ++j) { ra[d][j] = rb[d][j]; rb[d][j] = rc[d][j]; }
            }
        } else {
            const int tt = seg * 64 + x; const bf16_t* p = XBC + (size_t)(NL + b * TC + tt) * 1536 + c0;
            const u32x4 r0 = tt > 0 ? *(const u32x4*)(p - 1536) : z4, r1 = *(const u32x4*)p, r2 = tt < TC - 1 ? *(const u32x4*)(p + 1536) : z4;
            float f0[8], f1[8], f2[8], acc[8]; unpack8(r0, f0); unpack8(r1, f1); unpack8(r2, f2);
#pragma unroll
            for (int j = 0; j < 8; ++j) acc[j] = siluf_(acc0[j] + w[3][j] * f0[j] + w[4][j] * f1[j] + w[5][j] * f2[j]);
            *(u32x4*)(XC + (size_t)(NL + b * TC + tt) * 1536 + c0) = pack8(acc);
        }
    }
}

#define MFMA16(a, b, c) __builtin_amdgcn_mfma_f32_16x16x32_bf16((a), (b), (c), 0, 0, 0)
constexpr int MP = 136;
constexpr int SP = 72;
DI float rdlane(float x, int l) { return __int_as_float(__builtin_amdgcn_readlane(__float_as_int(x), l)); }
DI bf16x8 ld_frag(const LAS bf16_t* p) { return *(const LAS bf16x8*)p; }
DI bf16x8 ld_frag2(const LAS bf16_t* p) {
    const u32x2 lo = *(const LAS u32x2*)p, hi = *(const LAS u32x2*)(p + 16); u32x4 w; w.x = lo.x; w.y = lo.y; w.z = hi.x; w.w = hi.y; return __builtin_bit_cast(bf16x8, w); }
DI bf16x8 pack_frag(const float (&p)[8]) { return __builtin_bit_cast(bf16x8, pack8(p)); }

constexpr int VP = 80;
typedef short s16x4 __attribute__((ext_vector_type(4)));
DI s16x4 ld_tr4(const LAS unsigned char* p) { return __builtin_amdgcn_ds_read_tr16_b64_v4i16((LAS s16x4*)p); }
DI bf16x8 ld_tr8(const LAS unsigned char* p, int second) { const s16x4 lo = ld_tr4(p), hi = ld_tr4(p + second); return __builtin_shufflevector(lo, hi, 0, 1, 2, 3, 4, 5, 6, 7); }
constexpr int ML_KS = 0, ML_VS = 128 * MP * 2, ML_CB = ML_VS + 128 * VP * 2, ML_F = ML_CB + 80 * MP * 2;
template <int SKIP = 0> DI void mlstm_item(const Args& a, LAS unsigned char* lds, int item, const bf16_t* QK, const bf16_t* V, const float* GD, bf16_t* HM) {
    const int tid = tid_op(), lane = tid & 63, wid = __builtin_amdgcn_readfirstlane(tid >> 6), fr = lane & 15, fq = lane >> 4;
    const int b = item >> 4, h = (item >> 2) & 3, vs = item & 3;
    LAS bf16_t* Ks = (LAS bf16_t*)(lds + ML_KS); LAS bf16_t* Vs = (LAS bf16_t*)(lds + ML_VS); LAS bf16_t* Cb = (LAS bf16_t*)(lds + ML_CB);
    LAS float* fb = (LAS float*)(lds + ML_F);
    const int J = wid < 4 ? wid : 11 - wid;
    const int jj = 16 * J + fr;
    constexpr int YP = 68, ML_YB = ML_F + 2048;
    const int orow = tid >> 3, opc = tid & 7;
    for (int i = tid; i < 128 * 16; i += 512) Vs[(i >> 4) * VP + 64 + (i & 15)] = ((i & 15) == 0) ? (bf16_t)0x3F80 : (bf16_t)0;
    const float* pgb = inp(I_MLGB);
    for (int dir = 0; dir < 2; ++dir) {
        f32x4 accC[5];
#pragma unroll
        for (int vt = 0; vt < 5; ++vt) accC[vt] = (f32x4){0.f, 0.f, 0.f, 0.f};
        for (int i = tid; i < 80 * MP; i += 512) Cb[i] = 0;
        const float gbi = pgb[dir * 8 + h], gbf = pgb[dir * 8 + 4 + h];
        const int sg = dir == 0 ? 1 : -1;
        auto r0_of = [&](int c) -> int { const bool isc = c < 2; const int cc = isc ? c : c - 2, n = isc ? TC : T, rbase = isc ? NL + b * TC : b * T; return rbase + (dir == 0 ? cc * 128 : n - 1 - cc * 128); };
        u32x4 kreg[4], vreg[2]; bf16x8 qn[4]; float graw[4] = {0.f, 0.f, 0.f, 0.f};
        const int sr = tid & 31, ch = tid >> 5;
        const int vr = tid >> 2, vc = tid & 3;
        auto issue = [&](int c) { const int r0 = r0_of(c); const size_t jrow = (size_t)(r0 + sg * jj);
#pragma unroll
            for (int i = 0; i < 4; ++i) { const size_t srow = (size_t)(r0 + sg * (4 * sr + i)); kreg[i] = *(const u32x4*)(QK + srow * 1024 + 512 + h * 128 + ch * 8); }
            { const bf16_t* pv = V + (size_t)(r0 + sg * vr) * 1024 + h * 256 + vs * 64 + vc * 16; vreg[0] = *(const u32x4*)pv; vreg[1] = *(const u32x4*)(pv + 8); }
#pragma unroll
            for (int kk = 0; kk < 4; ++kk) qn[kk] = *(const bf16x8*)(QK + jrow * 1024 + h * 128 + kk * 32 + fq * 8);
            if (wid == 0) { const float* g0 = GD + (size_t)(r0 + sg * (2 * lane)) * 48 + dir * 8 + h; const float* g1 = GD + (size_t)(r0 + sg * (2 * lane + 1)) * 48 + dir * 8 + h;
                graw[0] = g0[0]; graw[1] = g0[4]; graw[2] = g1[0]; graw[3] = g1[4]; } };
        auto gates = [&]() {
            const float ig0 = graw[0] + gbi, ig1 = graw[2] + gbi, lf0 = -softplusf_(-(graw[1] + gbf)), lf1 = -softplusf_(-(graw[3] + gbf));
            const float s = wave_incl_scan(lf0 + lf1);
            const float bend = rdlane(s, 63), b1 = s, b0 = s - lf1;
            fb[2 * lane] = b0; fb[2 * lane + 1] = b1; fb[128 + 2 * lane] = ig0 - b0; fb[128 + 2 * lane + 1] = ig1 - b1;
            fb[256 + 2 * lane] = __expf(bend - b0 + ig0); fb[256 + 2 * lane + 1] = __expf(bend - b1 + ig1);
            if (lane == 0) fb[384] = bend; };
        u32x4 oldv[2];
        auto writeout = [&](int c) {
            const int r0w = r0_of(c);
#pragma unroll
            for (int q = 0; q < 2; ++q) { const int row = orow + 64 * q; const LAS bf16_t* yb = (const LAS bf16_t*)(lds + ML_YB) + row * YP + opc * 8;
                const u32x2 lo = *(const LAS u32x2*)yb, hi = *(const LAS u32x2*)(yb + 4); u32x4 w; w.x = lo.x; w.y = lo.y; w.z = hi.x; w.w = hi.y;
                if (dir == 1) { float f[8], o[8]; unpack8(w, f); unpack8(oldv[q], o);
#pragma unroll
                    for (int j = 0; j < 8; ++j) f[j] += o[j];
                    w = pack8(f); }
                if (!(SKIP & 1)) *(u32x4*)(HM + (size_t)(r0w + sg * row) * 1024 + h * 256 + vs * 64 + opc * 8) = w; } };
        issue(0);
        if (wid == 0) gates();
        for (int c = 0; c < 66; ++c) {
            const int r0 = r0_of(c);
            lds_barrier();
            if (!(SKIP & 2)) {
#pragma unroll
                for (int i = 0; i < 4; ++i) *(LAS u32x4*)(Ks + (4 * sr + i) * MP + ch * 8) = kreg[i];
                *(LAS u32x4*)(Vs + vr * VP + vc * 16) = vreg[0]; *(LAS u32x4*)(Vs + vr * VP + vc * 16 + 8) = vreg[1]; }
            bf16x8 qf[4];
#pragma unroll
            for (int kk = 0; kk < 4; ++kk) qf[kk] = qn[kk];
            lds_barrier();
            if (c + 1 < 66) issue(c + 1);
            if (dir == 1 && !(SKIP & 1)) {
#pragma unroll
                for (int q = 0; q < 2; ++q) oldv[q] = *(const u32x4*)(HM + (size_t)(r0 + sg * (orow + 64 * q)) * 1024 + h * 256 + vs * 64 + opc * 8); }
            if (!(SKIP & 4)) {
            f32x4 as[8];
#pragma unroll
            for (int st = 0; st < 8; ++st) { as[st] = (f32x4){0.f, 0.f, 0.f, 0.f};
                if (st <= J) {
#pragma unroll
                for (int kk = 0; kk < 4; ++kk) as[st] = MFMA16(ld_frag(Ks + (16 * st + fr) * MP + kk * 32 + fq * 8), qf[kk], as[st]); } }
            const float bj = fb[jj];
            bf16x8 pf[4];
#pragma unroll
            for (int kk = 0; kk < 4; ++kk) { float p[8];
#pragma unroll
                for (int hf = 0; hf < 2; ++hf) { const int st = 2 * kk + hf, s0 = 16 * st + 4 * fq;
                    if (st < J) { const f32x4 ev = *(const LAS f32x4*)(fb + 128 + s0);
#pragma unroll
                        for (int i = 0; i < 4; ++i) p[hf * 4 + i] = as[st][i] * __expf(bj + ev[i]); }
                    else if (st == J) { const f32x4 ev = *(const LAS f32x4*)(fb + 128 + s0);
#pragma unroll
                        for (int i = 0; i < 4; ++i) p[hf * 4 + i] = (4 * fq + i <= fr) ? as[st][i] * __expf(bj + ev[i]) : 0.f; }
                    else {
#pragma unroll
                        for (int i = 0; i < 4; ++i) p[hf * 4 + i] = 0.f; } }
                pf[kk] = pack_frag(p); }
            f32x4 num[5];
#pragma unroll
            for (int vt = 0; vt < 5; ++vt) num[vt] = (f32x4){0.f, 0.f, 0.f, 0.f};
            const float eend = __expf(fb[384]);
#pragma unroll
            for (int vt = 0; vt < 5; ++vt) accC[vt] = accC[vt] * eend;
            { const int tq = fr >> 2, tp = fr & 3;
              const LAS unsigned char* vb = lds + ML_VS + (4 * fq + tq) * (VP * 2) + 8 * tp;
              const LAS unsigned char* kb = lds + ML_KS + (4 * fq + tq) * (MP * 2) + 32 * wid + 8 * tp;
#pragma unroll
              for (int kk = 0; kk < 4; ++kk) {
                  bf16x8 vf[5];
#pragma unroll
                  for (int vt = 0; vt < 5; ++vt) vf[vt] = ld_tr8(vb + kk * 32 * (VP * 2) + 32 * vt, 16 * (VP * 2));
                  const bf16x8 kr = ld_tr8(kb + kk * 32 * (MP * 2), 16 * (MP * 2));
                  const f32x4 w0 = *(const LAS f32x4*)(fb + 256 + 32 * kk + 4 * fq), w1 = *(const LAS f32x4*)(fb + 256 + 32 * kk + 16 + 4 * fq);
                  float kf[8]; unpack8(__builtin_bit_cast(u32x4, kr), kf);
#pragma unroll
                  for (int e = 0; e < 4; ++e) { kf[e] *= w0[e]; kf[4 + e] *= w1[e]; }
                  const bf16x8 kw = pack_frag(kf);
#pragma unroll
                  for (int vt = 0; vt < 5; ++vt) accC[vt] = MFMA16(kw, vf[vt], accC[vt]);
                  if (2 * kk <= J) {
#pragma unroll
                      for (int vt = 0; vt < 5; ++vt) num[vt] = MFMA16(vf[vt], pf[kk], num[vt]); } } }
            const float ebj = __expf(bj);
#pragma unroll
            for (int vt = 0; vt < 5; ++vt) { f32x4 ai = (f32x4){0.f, 0.f, 0.f, 0.f};
#pragma unroll
                for (int kk = 0; kk < 4; ++kk) ai = MFMA16(ld_frag(Cb + (16 * vt + fr) * MP + kk * 32 + fq * 8), qf[kk], ai);
                num[vt] = num[vt] + ai * ebj; }
            const float den = __shfl(num[4][0], fr);
            const float inv = frcp(fmaxf(fabsf(den), 1.f));
            { LAS bf16_t* yb = (LAS bf16_t*)(lds + ML_YB) + jj * YP + 4 * fq;
#pragma unroll
              for (int vt = 0; vt < 4; ++vt) { const f32x4 o = num[vt] * inv; u32x2 w; w.x = pkbf(o[0], o[1]); w.y = pkbf(o[2], o[3]); *(LAS u32x2*)(yb + 16 * vt) = w; } }
            }
            lds_barrier();
#pragma unroll
            for (int vt = 0; vt < 5; ++vt) { u32x2 w; w.x = pkbf(accC[vt][0], accC[vt][1]); w.y = pkbf(accC[vt][2], accC[vt][3]);
                *(LAS u32x2*)(Cb + (16 * vt + fr) * MP + 16 * wid + 4 * fq) = w; }
            writeout(c);
            if (wid == 0 && c + 1 < 66) gates();
        }
        __syncthreads();
    }
}

constexpr int SS_BM = 0, SS_XS = 64 * MP * 2, SS_HB = SS_XS + 64 * VP * 2, SS_F = SS_HB + 64 * MP * 2;
constexpr int SS_STREAM = SS_F + 1024;
template <int SKIP = 0> DI void ssd_item(const Args& a, LAS unsigned char* lds, int item, const bf16_t* XC, const float* GD, bf16_t* YS) {
    const bool st_on = !(SKIP & 1) || (a.ph_hi < 0);
    const int tid = tid_op(), lane = tid & 63, wid = __builtin_amdgcn_readfirstlane(tid >> 6), fr = lane & 15, fq = lane >> 4;
    const int b = item >> 4, hd = item & 15, g = hd >> 3, dw = wid >> 2, jw = dw ? 3 - (wid & 3) : (wid & 3);
    const int jj = 16 * jw + fr;
    constexpr int YP = 68, SS_YB = 2 * SS_STREAM;
    const int orow = tid >> 3, opc = tid & 7;
    const float* palog = inp(I_ALOG); const float* pdtb = inp(I_DTB);
    const int gd = wid & 1;
    const float acoef = -__expf(palog[gd * 16 + hd]), dtb = pdtb[gd * 16 + hd];
    f32x4 accH[2][4];
#pragma unroll
    for (int d = 0; d < 2; ++d) {
#pragma unroll
        for (int pt = 0; pt < 4; ++pt) accH[d][pt] = (f32x4){0.f, 0.f, 0.f, 0.f};
        LAS bf16_t* Hb = (LAS bf16_t*)(lds + d * SS_STREAM + SS_HB); for (int i = tid; i < 64 * MP; i += 512) Hb[i] = 0; }
    auto r0_of = [&](int c, int d) -> int { const bool isc = c < 4; const int cc = isc ? c : c - 4, n = isc ? TC : T, rbase = isc ? NL + b * TC : b * T; return rbase + (d == 0 ? cc * 64 : n - 1 - cc * 64); };
    u32x4 breg[2][2], xreg[2]; bf16x8 cn[4]; float draw = 0.f;
    const int srw = tid >> 3, spc = tid & 7;
    auto issue = [&](int c) {
#pragma unroll
        for (int d = 0; d < 2; ++d) { const int r0 = r0_of(c, d), sg = d == 0 ? 1 : -1;
            const bf16_t* pr = XC + (size_t)(r0 + sg * srw) * 1536;
            breg[d][0] = *(const u32x4*)(pr + 1024 + g * 128 + spc * 16); breg[d][1] = *(const u32x4*)(pr + 1024 + g * 128 + spc * 16 + 8); xreg[d] = *(const u32x4*)(pr + hd * 64 + spc * 8); }
        { const size_t jrow = (size_t)(r0_of(c, dw) + (dw == 0 ? 1 : -1) * jj);
#pragma unroll
          for (int kk = 0; kk < 4; ++kk) cn[kk] = *(const bf16x8*)(XC + jrow * 1536 + 1280 + g * 128 + kk * 32 + fq * 8); }
        if (wid < 2) draw = GD[(size_t)(r0_of(c, gd) + (gd == 0 ? 1 : -1) * lane) * 48 + 16 + gd * 16 + hd]; };
    auto gates = [&]() { LAS float* fs = (LAS float*)(lds + gd * SS_STREAM + SS_F);
        const float dtv = softplusf_(draw + dtb);
        const float s = wave_incl_scan(dtv * acoef);
        const float aend = rdlane(s, 63);
        fs[lane] = dtv; fs[64 + lane] = s; fs[128 + lane] = __expf(aend - s);
        if (lane == 0) fs[192] = aend; };
    u32x4 oldv[2];
    auto is_second = [&](int c) -> bool { return (c >= 68) || (c == 2) || (c == 3); };
    auto writeout = [&](int c) {
#pragma unroll
        for (int d = 0; d < 2; ++d) { const LAS bf16_t* yb = (const LAS bf16_t*)(lds + SS_YB + d * 64 * YP * 2) + orow * YP + opc * 8;
            const u32x2 lo = *(const LAS u32x2*)yb, hi = *(const LAS u32x2*)(yb + 4); u32x4 w; w.x = lo.x; w.y = lo.y; w.z = hi.x; w.w = hi.y;
            if (is_second(c)) { float f[8], o[8]; unpack8(w, f); unpack8(oldv[d], o);
#pragma unroll
                for (int j = 0; j < 8; ++j) f[j] += o[j];
                w = pack8(f); }
            if (st_on) *(u32x4*)(YS + (size_t)(r0_of(c, d) + (d == 0 ? 1 : -1) * orow) * 1024 + hd * 64 + opc * 8) = w; } };
    issue(0);
    if (wid < 2) gates();
    for (int c = 0; c < 132; ++c) {
        const bool second = is_second(c);
        const bool handoff = (c == 2) || (c == 68);
        if (handoff) __syncthreads(); else lds_barrier();
#pragma unroll
        for (int d = 0; d < 2; ++d) { LAS unsigned char* L = lds + d * SS_STREAM;
            LAS bf16_t* Bm = (LAS bf16_t*)(L + SS_BM); LAS bf16_t* Xs = (LAS bf16_t*)(L + SS_XS);
            if (!((SKIP & 2) && !st_on)) { *(LAS u32x4*)(Bm + srw * MP + spc * 16) = breg[d][0]; *(LAS u32x4*)(Bm + srw * MP + spc * 16 + 8) = breg[d][1]; *(LAS u32x4*)(Xs + srw * VP + spc * 8) = xreg[d]; } }
        bf16x8 cf[4];
#pragma unroll
        for (int kk = 0; kk < 4; ++kk) cf[kk] = cn[kk];
        lds_barrier();
        if (c + 1 < 132) issue(c + 1);
        if (second) {
#pragma unroll
            for (int d = 0; d < 2; ++d) oldv[d] = *(const u32x4*)(YS + (size_t)(r0_of(c, d) + (d == 0 ? 1 : -1) * orow) * 1024 + hd * 64 + opc * 8); }
#pragma unroll
        for (int d = 0; d < 2; ++d) { LAS unsigned char* L = lds + d * SS_STREAM;
            const LAS bf16_t* Bm = (const LAS bf16_t*)(L + SS_BM);
            const LAS bf16_t* Hb = (const LAS bf16_t*)(L + SS_HB); const LAS float* fs = (const LAS float*)(L + SS_F);
            const bool own = (d == dw) && !((SKIP & 4) && !st_on);
            bf16x8 mf[2] = {}; float acj = 0.f;
            if (own) {
            f32x4 ag[4];
#pragma unroll
            for (int st = 0; st < 4; ++st) { ag[st] = (f32x4){0.f, 0.f, 0.f, 0.f};
                if (st <= jw) {
#pragma unroll
                for (int kk = 0; kk < 4; ++kk) ag[st] = MFMA16(ld_frag(Bm + (16 * st + fr) * MP + kk * 32 + fq * 8), cf[kk], ag[st]); } }
            acj = fs[64 + jj];
#pragma unroll
            for (int kk = 0; kk < 2; ++kk) { float p[8];
#pragma unroll
                for (int hf = 0; hf < 2; ++hf) { const int st = 2 * kk + hf, s0 = 16 * st + 4 * fq;
                    if (st < jw) { const f32x4 av = *(const LAS f32x4*)(fs + 64 + s0), dv = *(const LAS f32x4*)(fs + s0);
#pragma unroll
                        for (int i = 0; i < 4; ++i) p[hf * 4 + i] = ag[st][i] * __expf(acj - av[i]) * dv[i]; }
                    else if (st == jw) { const f32x4 av = *(const LAS f32x4*)(fs + 64 + s0), dv = *(const LAS f32x4*)(fs + s0);
#pragma unroll
                        for (int i = 0; i < 4; ++i) p[hf * 4 + i] = (4 * fq + i <= fr) ? ag[st][i] * __expf(acj - av[i]) * dv[i] : 0.f; }
                    else {
#pragma unroll
                        for (int i = 0; i < 4; ++i) p[hf * 4 + i] = 0.f; } }
                mf[kk] = pack_frag(p); }
            }
            f32x4 ay[4];
#pragma unroll
            for (int pt = 0; pt < 4; ++pt) ay[pt] = (f32x4){0.f, 0.f, 0.f, 0.f};
            if (!((SKIP & 8) && !st_on)) { const float eend = __expf(fs[192]);
#pragma unroll
              for (int pt = 0; pt < 4; ++pt) accH[d][pt] = accH[d][pt] * eend;
              const int tq = fr >> 2, tp = fr & 3;
              const LAS unsigned char* xb = L + SS_XS + (4 * fq + tq) * (VP * 2) + 8 * tp;
              const LAS unsigned char* bb = L + SS_BM + (4 * fq + tq) * (MP * 2) + 32 * wid + 8 * tp;
#pragma unroll
              for (int ks = 0; ks < 2; ++ks) {
                  bf16x8 xf[4];
#pragma unroll
                  for (int pt = 0; pt < 4; ++pt) xf[pt] = ld_tr8(xb + ks * 32 * (VP * 2) + 32 * pt, 16 * (VP * 2));
                  const bf16x8 br = ld_tr8(bb + ks * 32 * (MP * 2), 16 * (MP * 2));
                  const int s0 = 32 * ks + 4 * fq;
                  const f32x4 d0 = *(const LAS f32x4*)(fs + s0), d1 = *(const LAS f32x4*)(fs + s0 + 16), e0 = *(const LAS f32x4*)(fs + 128 + s0), e1 = *(const LAS f32x4*)(fs + 128 + s0 + 16);
                  float bf[8]; unpack8(__builtin_bit_cast(u32x4, br), bf);
#pragma unroll
                  for (int e = 0; e < 4; ++e) { bf[e] *= d0[e] * e0[e]; bf[4 + e] *= d1[e] * e1[e]; }
                  const bf16x8 bw = pack_frag(bf);
#pragma unroll
                  for (int pt = 0; pt < 4; ++pt) accH[d][pt] = MFMA16(bw, xf[pt], accH[d][pt]);
                  if (own && 2 * ks <= jw) {
#pragma unroll
                      for (int pt = 0; pt < 4; ++pt) ay[pt] = MFMA16(xf[pt], mf[ks], ay[pt]); } } }
            if (own) { const float eaj = __expf(acj);
              LAS bf16_t* yb = (LAS bf16_t*)(lds + SS_YB + d * 64 * YP * 2) + jj * YP + 4 * fq;
#pragma unroll
              for (int ptile = 0; ptile < 4; ++ptile) { f32x4 ai = (f32x4){0.f, 0.f, 0.f, 0.f};
#pragma unroll
                  for (int kk = 0; kk < 4; ++kk) ai = MFMA16(ld_frag(Hb + (16 * ptile + fr) * MP + kk * 32 + fq * 8), cf[kk], ai);
                  const f32x4 o = ay[ptile] + ai * eaj;
                  u32x2 w; w.x = pkbf(o[0], o[1]); w.y = pkbf(o[2], o[3]); *(LAS u32x2*)(yb + 16 * ptile) = w; } }
        }
        lds_barrier();
#pragma unroll
        for (int d = 0; d < 2; ++d) { LAS bf16_t* Hb = (LAS bf16_t*)(lds + d * SS_STREAM + SS_HB);
#pragma unroll
            for (int pt = 0; pt < 4; ++pt) { u32x2 w; w.x = pkbf(accH[d][pt][0], accH[d][pt][1]); w.y = pkbf(accH[d][pt][2], accH[d][pt][3]);
                *(LAS u32x2*)(Hb + (16 * pt + fr) * MP + 16 * wid + 4 * fq) = w; } }
        writeout(c);
        if (wid < 2 && c + 1 < 132) gates();
    }
    __syncthreads();
}
DI void scan_phase(const Args& a, LAS unsigned char* lds, const bf16_t* QK, const bf16_t* V, const bf16_t* XC, const float* GD, bf16_t* HM, bf16_t* YS) {
#if defined(DBG_TRIVIAL_SCAN)
    const int tid = tid_op(), lane = tid & 63, wid = tid >> 6;
    for (int row = blockIdx.x * 8 + wid; row < NR; row += gridDim.x * 8) {
        for (int i = 0; i < 4; ++i) { *(u32x2*)(HM + (size_t)row * 1024 + i * 256 + lane * 4) = *(const u32x2*)(V + (size_t)row * 1024 + i * 256 + lane * 4);
                                      *(u32x2*)(YS + (size_t)row * 1024 + i * 256 + lane * 4) = *(const u32x2*)(XC + (size_t)row * 1536 + i * 256 + lane * 4); } }
#else
    for (int item = blockIdx.x; item < 256; item += gridDim.x) {
#if defined(DBG_NO_MLSTM)
        if (item < 128) { const int b = item >> 4, h = (item >> 2) & 3, vs = item & 3, tid = tid_op();
            for (int r = tid >> 3; r < T + TC; r += 64) { const size_t row = r < T ? (size_t)(b * T + r) : (size_t)(NL + b * TC + r - T); const int c = h * 256 + vs * 64 + (tid & 7) * 8;
                *(u32x4*)(HM + row * 1024 + c) = *(const u32x4*)(V + row * 1024 + c); } }
        else ssd_item(a, lds, item - 128, XC, GD, YS);
#elif defined(DBG_NO_SSD)
        if (item < 128) mlstm_item(a, lds, item, QK, V, GD, HM);
        else { const int b = (item - 128) >> 4, hd = (item - 128) & 15, tid = tid_op();
            for (int r = tid >> 3; r < T + TC; r += 64) { const size_t row = r < T ? (size_t)(b * T + r) : (size_t)(NL + b * TC + r - T); const int c = hd * 64 + (tid & 7) * 8;
                *(u32x4*)(YS + row * 1024 + c) = *(const u32x4*)(XC + row * 1536 + c); } }
#else
        if (item < 128) {
#if defined(DBG_ML_SKIP)
            mlstm_item<DBG_ML_SKIP>(a, lds, item, QK, V, GD, HM); __syncthreads();
#endif
            mlstm_item(a, lds, item, QK, V, GD, HM);
#if defined(DBG_DUP_ML)
            __syncthreads(); mlstm_item(a, lds, item, QK, V, GD, HM);
#endif
        } else {
#if defined(DBG_SSD_SKIP)
            ssd_item<DBG_SSD_SKIP>(a, lds, item - 128, XC, GD, YS); __syncthreads();
#endif
            ssd_item(a, lds, item - 128, XC, GD, YS);
#if defined(DBG_DUP_SSD)
            __syncthreads(); ssd_item(a, lds, item - 128, XC, GD, YS);
#endif
        }
#endif
        __syncthreads();
    }
#endif
}

struct PmRow { u32x2 hm[4], o[4], ys[4], z[4], xs[4]; };
DI void pm_load(PmRow& d, int row, int lane, const bf16_t* HM, const bf16_t* YS, const bf16_t* XC, const bf16_t* OZ) {
    ld_row_raw(HM + (size_t)row * 1024, lane, d.hm); ld_row_raw(OZ + (size_t)row * 2048, lane, d.o); ld_row_raw(YS + (size_t)row * 1024, lane, d.ys);
    ld_row_raw(OZ + (size_t)row * 2048 + 1024, lane, d.z); ld_row_raw(XC + (size_t)row * 1536, lane, d.xs);
}
DI void post_mix_phase(const Args& a, const bf16_t* HM, const bf16_t* YS, const bf16_t* XC, bf16_t* OZ, unsigned char* OZ8) {
    const int tid_ = tid_op(), lane = tid_ & 63, wid = tid_ >> 6;
    const float* pmlng = inp(I_MLNG); const float* pssd = inp(I_SSD); const float* pssng = inp(I_SSNG);
    const int stride = gridDim.x * 8;
    int row = blockIdx.x * 8 + wid;
    PmRow cur;
    if (row < NR) pm_load(cur, row, lane, HM, YS, XC, OZ);
    for (; row < NR; row += stride) {
        PmRow nxt = cur; const int nr = row + stride;
        if (nr < NR) pm_load(nxt, nr, lane, HM, YS, XC, OZ);
        f32x4 hm[4], o[4], r[4], ys[4], z[4], xs[4], u[4]; float sq[4];
        cvt_row(cur.hm, hm); cvt_row(cur.o, o); cvt_row(cur.ys, ys); cvt_row(cur.z, z); cvt_row(cur.xs, xs);
#pragma unroll
        for (int i = 0; i < 4; ++i) { const float ms = wave_sum(hm[i][0] * hm[i][0] + hm[i][1] * hm[i][1] + hm[i][2] * hm[i][2] + hm[i][3] * hm[i][3]) * (1.f / 256.f);
            const float rs = rsqrtf(ms + RMS_EPS); const f32x4 g = *(const f32x4*)(pmlng + i * 256 + lane * 4);
#pragma unroll
            for (int j = 0; j < 4; ++j) r[i][j] = hm[i][j] * rs * g[j] * sigmoidf_(o[i][j]); }
        if (MK_F8_OUT0) st_row_f8(OZ8 + (size_t)row * 2048, lane, r); else st_row_bf16(OZ + (size_t)row * 2048, lane, r);
#pragma unroll
        for (int i = 0; i < 4; ++i) { const float dk = pssd[i * 4 + (lane >> 4)];
#pragma unroll
            for (int j = 0; j < 4; ++j) u[i][j] = (ys[i][j] + dk * xs[i][j]) * siluf_(z[i][j]);
            sq[i] = wave_sum(u[i][0] * u[i][0] + u[i][1] * u[i][1] + u[i][2] * u[i][2] + u[i][3] * u[i][3]); }
#pragma unroll
        for (int i = 0; i < 4; ++i) { const float rs = rsqrtf((sq[i & 2] + sq[(i & 2) + 1]) * (1.f / 512.f) + RMS_EPS); const f32x4 g = *(const f32x4*)(pssng + i * 256 + lane * 4);
            u[i] = u[i] * rs * g; }
        if (MK_F8_OUT0) st_row_f8(OZ8 + (size_t)row * 2048 + 1024, lane, u); else st_row_bf16(OZ + (size_t)row * 2048 + 1024, lane, u);
        cur = nxt;
    }
}

DI void post_attn_phase(const Args& a, LAS unsigned char* lds, int layer, int nrows, const bf16_t* OL, unsigned char* H2, const bf16_t* XBin, bf16_t* XBout) {
    LAS float* rw = (LAS float*)lds;
    const int tid = tid_op(), lane = tid & 63, wid = tid >> 6;
    { const float* pr = inp(I_ROUTER) + (size_t)layer * 1024 * 16; for (int i = tid; i < 1024 * 16; i += 512) rw[(i & 15) * 1024 + (i >> 4)] = pr[i]; }
    __syncthreads();
    const float* ng = inp(I_NORMG) + (size_t)layer * 4 * 1024; const float* px = inp(I_X); const float* pctx = inp(I_CTX);
    float* aff = (float*)(a.ws + WS_AFF); int* slot = (int*)(a.ws + WS_SLOT); float* ctxs = (float*)(a.ws + WS_CTXS);
    const int stride = gridDim.x * 8;
    int row = blockIdx.x * 8 + wid;
    f32x4 x[4]; u32x2 oraw[4];
    auto ldx = [&](int r, f32x4 (&d)[4]) { if (layer == 0) ld_row_f32(r < NL ? px + (size_t)r * 1024 : pctx + (size_t)(r - NL) * 1024, lane, d); else ld_row_bf16(XBin + (size_t)r * 1024, lane, d); };
    if (row < nrows) { ldx(row, x); ld_row_raw(OL + (size_t)row * 1024, lane, oraw); }
    for (; row < nrows; row += stride) {
        const int s = row_mod_s(row), nr = row + stride;
        f32x4 xn[4], o[4], h[4]; u32x2 on[4];
#pragma unroll
        for (int i = 0; i < 4; ++i) { xn[i] = x[i]; on[i] = oraw[i]; }
        if (nr < nrows) { ldx(nr, xn); ld_row_raw(OL + (size_t)nr * 1024, lane, on); }
        cvt_row(oraw, o);
        const float rs = rsqrtf(wave_sum(sumsq4(o)) * (1.f / 1024.f) + RMS_EPS);
        const float* gm = modp(a, layer, s, 2);
#pragma unroll
        for (int i = 0; i < 4; ++i) { const int c = i * 256 + lane * 4; const f32x4 g = *(const f32x4*)(ng + 1024 + c), gt = *(const f32x4*)(gm + c);
            x[i] = x[i] + gt * (o[i] * rs * g); }
        if (row < NL) st_row_bf16(XBout + (size_t)row * 1024, lane, x); else {
#pragma unroll
            for (int i = 0; i < 4; ++i) *(f32x4*)(ctxs + (size_t)(row - NL) * 1024 + i * 256 + lane * 4) = x[i]; }
        norm_mod(x, ng + 2048, modp(a, layer, s, 3), modp(a, layer, s, 4), lane, h);
        { unsigned char* hp = H2 + (size_t)row * 1024;
#pragma unroll
          for (int i = 0; i < 4; ++i) *(unsigned*)(hp + i * 256 + lane * 4) = pk_fp8x4(h[i][0] * F8_HID, h[i][1] * F8_HID, h[i][2] * F8_HID, h[i][3] * F8_HID); }
        float lg[16];
#pragma unroll
        for (int e = 0; e < 16; ++e) lg[e] = 0.f;
#pragma unroll
        for (int e = 0; e < 16; ++e) {
#pragma unroll
            for (int i = 0; i < 4; ++i) { const f32x4 w = *(const LAS f32x4*)(rw + e * 1024 + i * 256 + lane * 4); lg[e] += (h[i][0] * w[0] + h[i][1] * w[1]) + (h[i][2] * w[2] + h[i][3] * w[3]); }
            if ((e & 3) == 3) asm volatile("" ::: "memory"); }
        float l8[8], l4[4], l2[2], l1;
        { const bool hi = (lane & 32) != 0;
#pragma unroll
          for (int i = 0; i < 8; ++i) { const float keep = hi ? lg[8 + i] : lg[i], send = hi ? lg[i] : lg[8 + i]; l8[i] = keep + __shfl_xor(send, 32); } }
        { const bool hi = (lane & 16) != 0;
#pragma unroll
          for (int i = 0; i < 4; ++i) { const float keep = hi ? l8[4 + i] : l8[i], send = hi ? l8[i] : l8[4 + i]; l4[i] = keep + __shfl_xor(send, 16); } }
        { const bool hi = (lane & 8) != 0;
#pragma unroll
          for (int i = 0; i < 2; ++i) { const float keep = hi ? l4[2 + i] : l4[i], send = hi ? l4[i] : l4[2 + i]; l2[i] = keep + __shfl_xor(send, 8); } }
        { const bool hi = (lane & 4) != 0; const float keep = hi ? l2[1] : l2[0], send = hi ? l2[0] : l2[1]; l1 = keep + __shfl_xor(send, 4); }
        l1 += __shfl_xor(l1, 2); l1 += __shfl_xor(l1, 1);
        const int ex = ((lane >> 5) & 1) * 8 + ((lane >> 4) & 1) * 4 + ((lane >> 3) & 1) * 2 + ((lane >> 2) & 1);
        float mx = l1;
#pragma unroll
        for (int o = 4; o <= 32; o <<= 1) mx = fmaxf(mx, __shfl_xor(mx, o));
        const float pe = __expf(l1 - mx); float sum = pe;
#pragma unroll
        for (int o = 4; o <= 32; o <<= 1) sum += __shfl_xor(sum, o);
        if ((lane & 3) == 0) { aff[(size_t)row * 16 + ex] = pe / sum; slot[(size_t)row * 16 + ex] = -1; }
#pragma unroll
        for (int i = 0; i < 4; ++i) { x[i] = xn[i]; oraw[i] = on[i]; }
    }
    __syncthreads();
}

DI void topk_item(const Args& a, LAS unsigned char* lds, int item, int rpe, const unsigned char* H2, unsigned char* XG) {
    LAS unsigned* keys = (LAS unsigned*)lds;
    LAS unsigned* hist = keys + 8192;
    LAS unsigned* wsum = hist + 256;
    LAS unsigned* misc = wsum + 8;
    LAS int* sel = (LAS int*)(misc + 8);
    const int tid = tid_op(), lane = tid & 63, wid = tid >> 6;
    const bool lat = item < 128; const int it = lat ? item : item - 128, b = it >> 4, e = it & 15;
    const int n = lat ? T : TC, cap = lat ? 1024 : 32, rbase = lat ? b * T : NL + b * TC;
    const float* aff = (const float*)(a.ws + WS_AFF); int* slot = (int*)(a.ws + WS_SLOT); float* gate = (float*)(a.ws + WS_GATE);
    for (int i = tid; i < n; i += 512) keys[i] = __float_as_uint(aff[(size_t)(rbase + i) * 16 + e]);
    unsigned prefix = 0u, mask = 0u, need = (unsigned)cap;
    for (int pass = 0; pass < 4; ++pass) {
        const int shift = 24 - 8 * pass;
        if (tid < 256) hist[tid] = 0u;
        __syncthreads();
        for (int i = tid; i < n; i += 512) { const unsigned k = keys[i]; if ((k & mask) == prefix) __hip_atomic_fetch_add(hist + ((k >> shift) & 255u), 1u, __ATOMIC_RELAXED, __HIP_MEMORY_SCOPE_WORKGROUP); }
        __syncthreads();
        if (wid == 0) {
            const u32x4 hc = *(const LAS u32x4*)(hist + 4 * lane); const unsigned tot = hc.x + hc.y + hc.z + hc.w;
            unsigned suf = tot;
#pragma unroll
            for (int o = 1; o < 64; o <<= 1) { const unsigned t = __shfl_down(suf, o); if (lane + o < 64) suf += t; }
            const unsigned long long bal = __ballot(suf >= need); const int ls = 63 - __builtin_clzll(bal);
            if (lane == ls) { unsigned nd = need - (suf - tot); int bin;
                if (hc.w >= nd) bin = 3; else { nd -= hc.w; if (hc.z >= nd) bin = 2; else { nd -= hc.z; if (hc.y >= nd) bin = 1; else { nd -= hc.y; bin = 0; } } }
                misc[0] = (unsigned)(4 * lane + bin); misc[1] = nd; } }
        __syncthreads();
        prefix |= misc[0] << shift; mask |= 0xffu << shift; need = misc[1];
        __syncthreads();
    }
    const int per = lat ? 16 : 1, i0 = tid * per; const bool act = i0 < n;
    unsigned cnt = 0u;
    if (act) for (int j = 0; j < per; ++j) { const unsigned k = keys[i0 + j]; cnt += (k > prefix ? 1u : 0u) + (k == prefix ? 0x10000u : 0u); }
    unsigned inc = cnt;
#pragma unroll
    for (int o = 1; o < 64; o <<= 1) { const unsigned t = __shfl_up(inc, o); if (lane >= o) inc += t; }
    if (lane == 63) wsum[wid] = inc;
    __syncthreads();
    unsigned base = 0u;
    for (int w = 0; w < wid; ++w) base += wsum[w];
    unsigned ex = base + inc - cnt;
    if (act) for (int j = 0; j < per; ++j) { const unsigned k = keys[i0 + j]; const unsigned gtb = ex & 0xffffu, eqb = ex >> 16;
        const bool take = (k > prefix) || (k == prefix && eqb < need);
        if (take) { const int s = (int)(gtb + (eqb < need ? eqb : need)); const int tok = i0 + j, erow = lat ? b * 1024 + s : 8192 + b * 32 + s;
            sel[s] = tok; gate[(size_t)e * rpe + erow] = __uint_as_float(k); slot[(size_t)(rbase + tok) * 16 + e] = erow; }
        ex += (k > prefix ? 1u : 0u) + (k == prefix ? 0x10000u : 0u); }
    __syncthreads();
    const int sub = tid >> 6, c16 = tid & 63;
    for (int r0 = sub; r0 < cap; r0 += 32) {
        u32x4 v[4];
#pragma unroll
        for (int q = 0; q < 4; ++q) { const int r = r0 + 8 * q; if (r < cap) v[q] = *(const u32x4*)(H2 + (size_t)(rbase + sel[r]) * 1024 + c16 * 16); }
#pragma unroll
        for (int q = 0; q < 4; ++q) { const int r = r0 + 8 * q; if (r < cap) { const int erow = lat ? b * 1024 + r : 8192 + b * 32 + r; *(u32x4*)(XG + ((size_t)e * rpe + erow) * 1024 + c16 * 16) = v[q]; } }
    }
    __syncthreads();
}

DI void combine_phase(const Args& a, int layer, int nrows, int rpe, const bf16_t* Y, bf16_t* HS, bf16_t* XB) {
    const int tid_ = tid_op(), lane = tid_ & 63, wid = tid_ >> 6;
    const int* slot = (const int*)(a.ws + WS_SLOT); float* ctxs = (float*)(a.ws + WS_CTXS);
    const float* ng0 = inp(I_NORMG); const float* ng = ng0 + (size_t)layer * 4 * 1024;
    const int stride = gridDim.x * 8;
    int row = blockIdx.x * 8 + wid;
    auto ldx = [&](int r, f32x4 (&d)[4]) { if (r < NL) ld_row_bf16(XB + (size_t)r * 1024, lane, d); else ld_row_f32(ctxs + (size_t)(r - NL) * 1024, lane, d); };
    int sl = -1; f32x4 x[4];
    if (row < nrows) { sl = slot[(size_t)row * 16 + (lane & 15)]; ldx(row, x); }
    for (; row < nrows; row += stride) {
        const int s = row_mod_s(row), nr = row + stride;
        f32x4 m[4];
#pragma unroll
        for (int i = 0; i < 4; ++i) m[i] = (f32x4){0.f, 0.f, 0.f, 0.f};
#pragma unroll
        for (int e = 0; e < 16; ++e) { const int se = __builtin_amdgcn_readlane(sl, e);
            if (se >= 0) { f32x4 y[4]; ld_row_bf16(Y + ((size_t)e * rpe + se) * 1024, lane, y);
#pragma unroll
                for (int i = 0; i < 4; ++i) m[i] = m[i] + y[i]; } }
        int sln = sl; f32x4 xn[4];
#pragma unroll
        for (int i = 0; i < 4; ++i) xn[i] = x[i];
        if (nr < nrows) { sln = slot[(size_t)nr * 16 + (lane & 15)]; ldx(nr, xn); }
        const float rs = rsqrtf(wave_sum(sumsq4(m)) * (1.f / 1024.f) + RMS_EPS);
        const float* gm = modp(a, layer, s, 5);
#pragma unroll
        for (int i = 0; i < 4; ++i) { const int c = i * 256 + lane * 4; const f32x4 g = *(const f32x4*)(ng + 3072 + c), gt = *(const f32x4*)(gm + c);
            x[i] = x[i] + gt * (m[i] * rs * g); }
        if (layer == 1) {
#pragma unroll
            for (int i = 0; i < 4; ++i) *(f32x4*)(a.out + (size_t)row * 1024 + i * 256 + lane * 4) = x[i]; }
        else if (row < NL) st_row_bf16(XB + (size_t)row * 1024, lane, x);
        else {
#pragma unroll
            for (int i = 0; i < 4; ++i) *(f32x4*)(ctxs + (size_t)(row - NL) * 1024 + i * 256 + lane * 4) = x[i]; }
        if (layer == 0) { f32x4 h[4]; norm_mod(x, ng0 + 4096, modp(a, 1, s, 0), modp(a, 1, s, 1), lane, h);
#pragma unroll
            for (int i = 0; i < 4; ++i) { u32x2 w; w.x = pkbf(h[i][0], h[i][1]); w.y = pkbf(h[i][2], h[i][3]); *(u32x2*)(HS + (size_t)row * 2048 + i * 256 + lane * 4) = w; } }
        sl = sln;
#pragma unroll
        for (int i = 0; i < 4; ++i) x[i] = xn[i];
    }
}
DI void mix_phase(bf16_t* HS, bf16_t* XM) {
    const int tid_ = tid_op(), lane = tid_ & 63, wid = tid_ >> 6;
    const float* mu = inp(I_MU);
    f32x4 mr[4], mk[4], mv[4];
#pragma unroll
    for (int i = 0; i < 4; ++i) { const int c = i * 256 + lane * 4; mr[i] = *(const f32x4*)(mu + c); mk[i] = *(const f32x4*)(mu + 2 * 1024 + c); mv[i] = *(const f32x4*)(mu + 3 * 1024 + c); }
    for (int row = blockIdx.x * 8 + wid; row < NR; row += gridDim.x * 8) {
        const int t = row < NL ? (row & (T - 1)) : ((row - NL) & (TC - 1)), n = row < NL ? T : TC;
        const bool first = t == 0, last = t == n - 1;
        u32x2 p[4], q[4], hh[4];
#pragma unroll
        for (int i = 0; i < 4; ++i) { const int c = i * 256 + lane * 4; p[i] = (u32x2){0u, 0u}; q[i] = (u32x2){0u, 0u};
            if (!first) p[i] = *(const u32x2*)(HS + (size_t)(row - 1) * 2048 + c);
            if (!last) q[i] = *(const u32x2*)(HS + (size_t)(row + 1) * 2048 + c);
            hh[i] = *(const u32x2*)(HS + (size_t)row * 2048 + c); }
#pragma unroll
        for (int i = 0; i < 4; ++i) { const int c = i * 256 + lane * 4;
            const f32x4 h = (f32x4){bflo(hh[i].x), bfhi(hh[i].x), bflo(hh[i].y), bfhi(hh[i].y)};
            const f32x4 sh = (f32x4){0.5f * (bflo(p[i].x) + bflo(q[i].x)), 0.5f * (bfhi(p[i].x) + bfhi(q[i].x)), 0.5f * (bflo(p[i].y) + bflo(q[i].y)), 0.5f * (bfhi(p[i].y) + bfhi(q[i].y))};
            const f32x4 xx = sh - h, xr = h + xx * mr[i], xk = h + xx * mk[i], xv = h + xx * mv[i];
            u32x2 w; w.x = pkbf(sh[0], sh[1]); w.y = pkbf(sh[2], sh[3]); *(u32x2*)(HS + (size_t)row * 2048 + 1024 + c) = w;
            if (MK_F8_RKV) { unsigned char* xb = (unsigned char*)XM + (size_t)row * 1024 + c;
                *(unsigned*)xb = pk_fp8x4(xr[0] * F8_ACT, xr[1] * F8_ACT, xr[2] * F8_ACT, xr[3] * F8_ACT);
                *(unsigned*)(xb + USZ) = pk_fp8x4(xk[0] * F8_ACT, xk[1] * F8_ACT, xk[2] * F8_ACT, xk[3] * F8_ACT);
                *(unsigned*)(xb + 2 * USZ) = pk_fp8x4(xv[0] * F8_ACT, xv[1] * F8_ACT, xv[2] * F8_ACT, xv[3] * F8_ACT); }
            else {
            w.x = pkbf(xr[0], xr[1]); w.y = pkbf(xr[2], xr[3]); *(u32x2*)(XM + (size_t)row * 1024 + c) = w;
            w.x = pkbf(xk[0], xk[1]); w.y = pkbf(xk[2], xk[3]); *(u32x2*)(XM + (USZ / 2) + (size_t)row * 1024 + c) = w;
            w.x = pkbf(xv[0], xv[1]); w.y = pkbf(xv[2], xv[3]); *(u32x2*)(XM + 2 * (USZ / 2) + (size_t)row * 1024 + c) = w; } }
    }
}

struct EpiRw1 {
    static constexpr bool PERM = true; static constexpr bool SPLIT = MK_SPLIT; static constexpr int NST = 16; DI bool counted(const Unit& u) const { return true; }
    bf16_t *L1, *L2;
    DI void operator()(const f32x4 (&acc)[2][2][4][2], const Unit& u, int wr, int wc, int fr, int fq) const { half<0>(acc, u, wr, wc, fr, fq); half<1>(acc, u, wr, wc, fr, fq); }
    template <int ai> DI void half(const f32x4 (&acc)[2][2][4][2], const Unit& u, int wr, int wc, int fr, int fq) const {
        const int row0 = u.pm * 256 + wr * 64 + fr, pn = u.pn + 12, cl = wc * 32 + 8 * fq;
        {
#pragma unroll
            for (int m = 0; m < 4; ++m) { const size_t row = (size_t)(row0 + ai * 128 + m * 16);
#pragma unroll
                for (int bj = 0; bj < 2; ++bj) { f32x4 v0 = acc[ai][bj][m][0], v1 = acc[ai][bj][m][1]; bf16_t* dst;
                    if (pn == 12) { dst = L1 + row * 256 + bj * 128 + cl;
                        if (bj == 0) {
#pragma unroll
                            for (int j = 0; j < 4; ++j) { v0[j] = tanhf_(v0[j]); v1[j] = tanhf_(v1[j]); } } }
                    else { dst = L2 + row * 256 + bj * 128 + cl;
#pragma unroll
                        for (int j = 0; j < 4; ++j) { v0[j] = sigmoidf_(v0[j]); v1[j] = sigmoidf_(v1[j]); } }
                    *(u32x4*)dst = pack_acc(v0, v1); } }
        }
    }
};
struct EpiRw2 {
    static constexpr bool PERM = true; static constexpr bool SPLIT = false; static constexpr int NST = 16; DI bool counted(const Unit& u) const { return true; }
    bf16_t* LWA; const float* w0; const float* a0;
    DI void operator()(const f32x4 (&acc)[2][2][4][2], const Unit& u, int wr, int wc, int fr, int fq) const {
        const int row0 = u.pm * 256 + wr * 64 + fr, pn = u.pn;
        const float sc = pn < 8 ? -0.60653065971263342f : 1.f;
#pragma unroll
        for (int bj = 0; bj < 2; ++bj) { const int c = pn * 256 + bj * 128 + wc * 32 + 8 * fq;
            const float* bp = pn < 8 ? w0 + c : a0 + (c - 2048);
            const f32x4 b0 = *(const f32x4*)bp, b1 = *(const f32x4*)(bp + 4);
#pragma unroll
            for (int ai = 0; ai < 2; ++ai)
#pragma unroll
                for (int m = 0; m < 4; ++m) { f32x4 v0 = acc[ai][bj][m][0] + b0, v1 = acc[ai][bj][m][1] + b1;
#pragma unroll
                    for (int j = 0; j < 4; ++j) { v0[j] = sc * sigmoidf_(v0[j]); v1[j] = sc * sigmoidf_(v1[j]); }
                    *(u32x4*)(LWA + (size_t)(row0 + ai * 128 + m * 16) * 3072 + c) = pack_acc(v0, v1); } }
    }
};

DI float grp16_sum(float v) { v += __shfl_xor(v, 1); v += __shfl_xor(v, 2); v += __shfl_xor(v, 4); v += __shfl_xor(v, 8); return v; }

constexpr int RC_AT = 0, RC_RT = 2304, RC_NAK = 4608, RC_TIN = 5120, RC_MBR = 5632, RC_MKR = 6144, RC_BT = 6656, RC_KT = 9216, RC_VT = 11776, RC_GAM = 14336, RC_BN = 14592, RC_KN = 16896, RC_SLOT = 19200;
template <int N> DI float ror_add(float x) { const int y = __builtin_amdgcn_update_dpp(0, __float_as_int(x), 0x120 + N, 0xf, 0xf, false); return x + __int_as_float(y); }
DI float grp16_allsum(float x) { x = ror_add<8>(x); x = ror_add<4>(x); x = ror_add<2>(x); x = ror_add<1>(x); return x; }
DI bf16x8 mk_frag(const u32x2 lo, const u32x2 hi) { u32x4 w; w.x = lo.x; w.y = lo.y; w.z = hi.x; w.w = hi.y; return __builtin_bit_cast(bf16x8, w); }
DI float rdl(float x, int l) { return __int_as_float(__builtin_amdgcn_readlane(__float_as_int(x), l)); }
DI void rwkv_scan_item(LAS unsigned char* lds, int item, const bf16_t* Rm, const bf16_t* Km, const bf16_t* Vm, bf16_t* LWA, int mode) {
    const bool dry = mode != 0;
    const int tid = tid_op(), lane = tid & 63, wid = __builtin_amdgcn_readfirstlane(tid >> 6), fr = lane & 15, fq = lane >> 4;
    const int b = item >> 5, h = (item >> 1) & 15, dir = item & 1;
    auto row_of = [&](int p) -> size_t { return p < TC ? (size_t)(NL + b * TC + (dir == 0 ? p : TC - 1 - p)) : (size_t)(b * T + (dir == 0 ? p - TC : T - 1 - (p - TC))); };
    constexpr int NGRP = (TC + T) / 64;
    const u32x2 z2 = (u32x2){0u, 0u};
    LAS unsigned* acnt = (LAS unsigned*)(lds + 8 * RC_SLOT);
    if (tid == 0) *acnt = 0u;
    if (wid >= 4) {
        const int j = wid - 4, pt = lane & 15, cq = lane >> 4;
        float kkw[16], kaw[16];
        { const float* pkk = inp(I_KK) + h * 64 + 16 * cq; const float* pka = inp(I_KA) + h * 64 + 16 * cq;
#pragma unroll
          for (int i = 0; i < 16; i += 4) { const f32x4 a4 = *(const f32x4*)(pkk + i), b4 = *(const f32x4*)(pka + i);
#pragma unroll
              for (int q = 0; q < 4; ++q) { kkw[i + q] = a4[q]; kaw[i + q] = b4[q]; } } }
        u32x4 raw[5][2];
        auto issue = [&](int g) { const size_t row = row_of(16 * (4 * g + j) + pt); const size_t ro = row * 1024 + h * 64 + 16 * cq; const bf16_t* pl = LWA + row * 3072 + h * 64 + 16 * cq;
#pragma unroll
            for (int q = 0; q < 2; ++q) { raw[0][q] = *(const u32x4*)(Rm + ro + 8 * q); raw[1][q] = *(const u32x4*)(Km + ro + 8 * q); raw[2][q] = *(const u32x4*)(Vm + ro + 8 * q);
                                          raw[3][q] = *(const u32x4*)(pl + dir * 1024 + 8 * q); raw[4][q] = *(const u32x4*)(pl + 2048 + 8 * q); } };
        auto prep = [&](int g) {
            LAS unsigned char* sl = lds + (((g & 1) * 4 + j) * RC_SLOT);
            LAS bf16_t* At = (LAS bf16_t*)(sl + RC_AT); LAS bf16_t* Rt = (LAS bf16_t*)(sl + RC_RT); LAS bf16_t* BT = (LAS bf16_t*)(sl + RC_BT); LAS bf16_t* KT = (LAS bf16_t*)(sl + RC_KT); LAS bf16_t* VT = (LAS bf16_t*)(sl + RC_VT);
            LAS bf16_t* Bn = (LAS bf16_t*)(sl + RC_BN); LAS bf16_t* Kn = (LAS bf16_t*)(sl + RC_KN);
            float fr_[16], fk[16], fl[16], fa[16]; u32x4 vraw[2] = {raw[2][0], raw[2][1]};
            unpack8(raw[0][0], *(float(*)[8])&fr_[0]); unpack8(raw[0][1], *(float(*)[8])&fr_[8]); unpack8(raw[1][0], *(float(*)[8])&fk[0]); unpack8(raw[1][1], *(float(*)[8])&fk[8]);
            unpack8(raw[3][0], *(float(*)[8])&fl[0]); unpack8(raw[3][1], *(float(*)[8])&fl[8]); unpack8(raw[4][0], *(float(*)[8])&fa[0]); unpack8(raw[4][1], *(float(*)[8])&fa[8]);
            if (g + 1 < NGRP) issue(g + 1);
            float kk[16], ss = 0.f;
#pragma unroll
            for (int i = 0; i < 16; ++i) { kk[i] = fk[i] * kkw[i]; ss += kk[i] * kk[i]; }
            ss += __shfl_xor(ss, 16); ss += __shfl_xor(ss, 32);
            const float rn = rsqrtf(ss + 1e-12f);
            float at[16], rt[16], bt[16], kt[16], cc[16], ec[16];
#pragma unroll
            for (int i = 0; i < 16; ++i) cc[i] = fl[i] + __int_as_float(__builtin_amdgcn_update_dpp(0, __float_as_int(fl[i]), 0x111, 0xf, 0xf, true));
#pragma unroll
            for (int i = 0; i < 16; ++i) cc[i] += __int_as_float(__builtin_amdgcn_update_dpp(0, __float_as_int(cc[i]), 0x112, 0xf, 0xf, true));
#pragma unroll
            for (int i = 0; i < 16; ++i) cc[i] += __int_as_float(__builtin_amdgcn_update_dpp(0, __float_as_int(cc[i]), 0x114, 0xf, 0xf, true));
#pragma unroll
            for (int i = 0; i < 16; ++i) cc[i] += __int_as_float(__builtin_amdgcn_update_dpp(0, __float_as_int(cc[i]), 0x118, 0xf, 0xf, true));
#pragma unroll
            for (int i = 0; i < 16; ++i) ec[i] = __expf(cc[i]);
#pragma unroll
            for (int i = 0; i < 16; ++i) {
                const float einv = __expf(-cc[i]);
                float eprev = __int_as_float(__builtin_amdgcn_update_dpp(0, __float_as_int(ec[i]), 0x111, 0xf, 0xf, true)); eprev = pt == 0 ? 1.f : eprev;
                const float kn = kk[i] * rn, kp = fk[i] * ((fa[i] - 1.f) * kaw[i] + 1.f);
                at[i] = -kn * eprev; rt[i] = fr_[i] * ec[i]; bt[i] = kn * fa[i] * einv; kt[i] = kp * einv; }
            if (pt == 15) {
#pragma unroll
                for (int i = 0; i < 16; i += 4) *(LAS f32x4*)(sl + RC_GAM + (16 * cq + i) * 4) = (f32x4){ec[i], ec[i + 1], ec[i + 2], ec[i + 3]}; }
            { u32x4 w0, w1;
#define RC_PK16(src) w0.x = pkbf(src[0], src[1]); w0.y = pkbf(src[2], src[3]); w0.z = pkbf(src[4], src[5]); w0.w = pkbf(src[6], src[7]); w1.x = pkbf(src[8], src[9]); w1.y = pkbf(src[10], src[11]); w1.z = pkbf(src[12], src[13]); w1.w = pkbf(src[14], src[15]);
              RC_PK16(at) *(LAS u32x4*)(At + pt * 72 + 16 * cq) = w0; *(LAS u32x4*)(At + pt * 72 + 16 * cq + 8) = w1;
              RC_PK16(rt) *(LAS u32x4*)(Rt + pt * 72 + 16 * cq) = w0; *(LAS u32x4*)(Rt + pt * 72 + 16 * cq + 8) = w1;
              RC_PK16(bt) *(LAS u32x4*)(Bn + pt * 72 + 16 * cq) = w0; *(LAS u32x4*)(Bn + pt * 72 + 16 * cq + 8) = w1;
              { const unsigned wv[8] = {w0.x, w0.y, w0.z, w0.w, w1.x, w1.y, w1.z, w1.w};
#pragma unroll
                for (int q = 0; q < 8; ++q) { BT[(16 * cq + 2 * q) * 20 + pt] = (bf16_t)(wv[q] & 0xffffu); BT[(16 * cq + 2 * q + 1) * 20 + pt] = (bf16_t)(wv[q] >> 16); } }
              RC_PK16(kt) *(LAS u32x4*)(Kn + pt * 72 + 16 * cq) = w0; *(LAS u32x4*)(Kn + pt * 72 + 16 * cq + 8) = w1;
              { const unsigned wv[8] = {w0.x, w0.y, w0.z, w0.w, w1.x, w1.y, w1.z, w1.w};
#pragma unroll
                for (int q = 0; q < 8; ++q) { KT[(16 * cq + 2 * q) * 20 + pt] = (bf16_t)(wv[q] & 0xffffu); KT[(16 * cq + 2 * q + 1) * 20 + pt] = (bf16_t)(wv[q] >> 16); } }
              { const unsigned wv[8] = {vraw[0].x, vraw[0].y, vraw[0].z, vraw[0].w, vraw[1].x, vraw[1].y, vraw[1].z, vraw[1].w};
#pragma unroll
                for (int q = 0; q < 8; ++q) { VT[(16 * cq + 2 * q) * 20 + pt] = (bf16_t)(wv[q] & 0xffffu); VT[(16 * cq + 2 * q + 1) * 20 + pt] = (bf16_t)(wv[q] >> 16); } }
#undef RC_PK16
            }
        };
        issue(0);
        prep(0);
        lds_barrier();
        for (int g = 0; g < NGRP; ++g) { if (g + 1 < NGRP && mode != 3) prep(g + 1); lds_barrier();   }
    } else {
        f32x4 st[4];
#pragma unroll
        for (int kt = 0; kt < 4; ++kt) st[kt] = (f32x4){0.f, 0.f, 0.f, 0.f};
        lds_barrier();
        for (int g = 0; g < NGRP; ++g) {
            if (mode != 2) {
                LAS unsigned char* sl = lds + (((g & 1) * 4 + wid) * RC_SLOT);
                const LAS bf16_t* At = (const LAS bf16_t*)(sl + RC_AT); const LAS bf16_t* Rt = (const LAS bf16_t*)(sl + RC_RT); LAS bf16_t* Bn = (LAS bf16_t*)(sl + RC_BN); const LAS bf16_t* Kn = (const LAS bf16_t*)(sl + RC_KN);
            f32x4 nab = (f32x4){0.f, 0.f, 0.f, 0.f}, nak = nab, mbr = nab, mkr = nab;
#pragma unroll
            for (int s2 = 0; s2 < 2; ++s2) { const bf16x8 fb_ = ld_frag(Bn + fr * 72 + 32 * s2 + 8 * fq), fk_ = ld_frag(Kn + fr * 72 + 32 * s2 + 8 * fq), fa_ = ld_frag(At + fr * 72 + 32 * s2 + 8 * fq), fr2 = ld_frag(Rt + fr * 72 + 32 * s2 + 8 * fq);
                nab = MFMA16(fb_, fa_, nab); nak = MFMA16(fk_, fa_, nak); mbr = MFMA16(fb_, fr2, mbr); mkr = MFMA16(fk_, fr2, mkr); }
#pragma unroll
            for (int jj = 0; jj < 4; ++jj) { const int i = 4 * fq + jj; if (!(i < fr)) { nab[jj] = 0.f; nak[jj] = 0.f; } if (!(i <= fr)) { mbr[jj] = 0.f; mkr[jj] = 0.f; } }
            { u32x2 w; w.x = pkbf(nak[0], nak[1]); w.y = pkbf(nak[2], nak[3]); *(LAS u32x2*)(sl + RC_NAK + fr * 32 + 8 * fq) = w;
              w.x = pkbf(mbr[0], mbr[1]); w.y = pkbf(mbr[2], mbr[3]); *(LAS u32x2*)(sl + RC_MBR + fr * 32 + 8 * fq) = w;
              w.x = pkbf(mkr[0], mkr[1]); w.y = pkbf(mkr[2], mkr[3]); *(LAS u32x2*)(sl + RC_MKR + fr * 32 + 8 * fq) = w; }
            LAS float* nf = (LAS float*)Bn;
            *(LAS f32x4*)(nf + fr * 16 + 4 * fq) = nab;
            float rw_[16];
#pragma unroll
            for (int t = 0; t < 16; ++t) { float acc0 = (fr == t) ? 1.f : 0.f, acc1 = 0.f;
#pragma unroll
                for (int i4 = 0; i4 < (t + 3) / 4; ++i4) { const f32x4 cf = *(const LAS f32x4*)(nf + t * 16 + 4 * i4);
#pragma unroll
                    for (int jj = 0; jj < 4; ++jj) { const int i = 4 * i4 + jj; if (i < t) { if (jj & 1) acc1 += cf[jj] * rw_[i]; else acc0 += cf[jj] * rw_[i]; } } }
                rw_[t] = acc0 + acc1; }
            if (lane < 16) {
#pragma unroll
                for (int t = 0; t < 16; t += 2) {   ((LAS bf16_t*)(sl + RC_TIN))[t * 16 + lane] = f2bf(rw_[t]); ((LAS bf16_t*)(sl + RC_TIN))[(t + 1) * 16 + lane] = f2bf(rw_[t + 1]); } }
            }
            asm volatile("s_waitcnt lgkmcnt(0)" ::: "memory");
            if (lane == 0) __hip_atomic_fetch_add(acnt, 1u, __ATOMIC_RELAXED, __HIP_MEMORY_SCOPE_WORKGROUP);
            while (__hip_atomic_load(acnt, __ATOMIC_RELAXED, __HIP_MEMORY_SCOPE_WORKGROUP) < 4u * (unsigned)(g + 1)) __builtin_amdgcn_s_sleep(1);
            asm volatile("" ::: "memory");
#pragma unroll 1
            for (int cc = 0; cc < (mode == 2 ? 0 : 4); ++cc) {
                const int c = 4 * g + cc; const LAS unsigned char* sl = lds + (((g & 1) * 4 + cc) * RC_SLOT);
                const LAS bf16_t* At = (const LAS bf16_t*)(sl + RC_AT); const LAS bf16_t* Rt = (const LAS bf16_t*)(sl + RC_RT);
                bf16x8 sb[2];
#pragma unroll
                for (int s2 = 0; s2 < 2; ++s2) { u32x4 w; w.x = pkbf(st[2 * s2][0], st[2 * s2][1]); w.y = pkbf(st[2 * s2][2], st[2 * s2][3]); w.z = pkbf(st[2 * s2 + 1][0], st[2 * s2 + 1][1]); w.w = pkbf(st[2 * s2 + 1][2], st[2 * s2 + 1][3]); sb[s2] = __builtin_bit_cast(bf16x8, w); }
                const u32x2 vv = *(const LAS u32x2*)(sl + RC_VT + (16 * wid + fr) * 40 + 8 * fq);
                const f32x4 zero4 = (f32x4){0.f, 0.f, 0.f, 0.f};
                f32x4 x = MFMA16(ld_frag2(At + fr * 72 + 4 * fq), sb[0], zero4);
                x = MFMA16(ld_frag2(At + fr * 72 + 32 + 4 * fq), sb[1], x);
                x = MFMA16(mk_frag(z2, *(const LAS u32x2*)(sl + RC_NAK + fr * 32 + 8 * fq)), mk_frag(z2, vv), x);
                u32x2 xb; xb.x = pkbf(x[0], x[1]); xb.y = pkbf(x[2], x[3]);
                const f32x4 u = MFMA16(mk_frag(*(const LAS u32x2*)(sl + RC_TIN + fr * 32 + 8 * fq), z2), mk_frag(xb, z2), zero4);
                u32x2 ub; ub.x = pkbf(u[0], u[1]); ub.y = pkbf(u[2], u[3]);
                const bf16x8 uv = mk_frag(ub, vv);
                f32x4 y = MFMA16(ld_frag2(Rt + fr * 72 + 4 * fq), sb[0], zero4);
                y = MFMA16(ld_frag2(Rt + fr * 72 + 32 + 4 * fq), sb[1], y);
                y = MFMA16(mk_frag(*(const LAS u32x2*)(sl + RC_MBR + fr * 32 + 8 * fq), *(const LAS u32x2*)(sl + RC_MKR + fr * 32 + 8 * fq)), uv, y);
#pragma unroll
                for (int kt = 0; kt < 4; ++kt) { const int k = 16 * kt + fr;
                    st[kt] = MFMA16(mk_frag(*(const LAS u32x2*)(sl + RC_BT + k * 40 + 8 * fq), *(const LAS u32x2*)(sl + RC_KT + k * 40 + 8 * fq)), uv, st[kt]);
                    const f32x4 gm = *(const LAS f32x4*)(sl + RC_GAM + (16 * kt + 4 * fq) * 4); st[kt] = st[kt] * gm; }
                if (!dry) {
                    bf16_t* yp = LWA + row_of(16 * c) * 3072 + dir * 1024 + h * 64 + 16 * wid + fr + (dir == 0 ? 1 : -1) * (4 * fq) * 3072;
#pragma unroll
                    for (int i = 0; i < 4; ++i) yp[(dir == 0 ? i : -i) * 3072] = f2bf(y[i]); }
            }
            lds_barrier();
        }
    }
}

struct RpRow { u32x2 yf[4], yb[4], r[4], k[4], v[4], g[4], av[4]; };
DI void rp_load(RpRow& d, int row, int lane, const bf16_t* Rm, const bf16_t* Km, const bf16_t* Vm, const bf16_t* LWA, const bf16_t* G) {
    ld_row_raw(LWA + (size_t)row * 3072, lane, d.yf); ld_row_raw(LWA + (size_t)row * 3072 + 1024, lane, d.yb); ld_row_raw(LWA + (size_t)row * 3072 + 2048, lane, d.av);
    ld_row_raw(Rm + (size_t)row * 1024, lane, d.r); ld_row_raw(Km + (size_t)row * 1024, lane, d.k); ld_row_raw(Vm + (size_t)row * 1024, lane, d.v);
    ld_row_raw(G + (size_t)row * 1024, lane, d.g);
}
DI void rw_post_phase(const Args& a, const bf16_t* Rm, const bf16_t* Km, const bf16_t* Vm, bf16_t* LWA, const bf16_t* G) {
    const int tid_ = tid_op(), lane = tid_ & 63, wid = tid_ >> 6;
    const float* plg = inp(I_LNG); const float* plb = inp(I_LNB); const float* prk = inp(I_RK); const float* pka = inp(I_KA);
    const int stride = gridDim.x * 8;
    int row = blockIdx.x * 8 + wid;
    RpRow cur;
    if (row < NL) rp_load(cur, row, lane, Rm, Km, Vm, LWA, G);
    for (; row < NL; row += stride) {
        RpRow nxt = cur; const int nr = row + stride;
        if (nr < NL) rp_load(nxt, nr, lane, Rm, Km, Vm, LWA, G);
        f32x4 yf[4], yb[4], r[4], k[4], v[4], g[4], av[4], z[4];
        cvt_row(cur.yf, yf); cvt_row(cur.yb, yb); cvt_row(cur.r, r); cvt_row(cur.k, k); cvt_row(cur.v, v); cvt_row(cur.g, g); cvt_row(cur.av, av);
#pragma unroll
        for (int i = 0; i < 4; ++i) { const int c = i * 256 + lane * 4; const f32x4 y = yf[i] + yb[i];
            const f32x4 kaw = *(const f32x4*)(pka + c); const f32x4 kp = k[i] * ((av[i] - 1.f) * kaw + 1.f);
            const float mean = grp16_sum((y[0] + y[1]) + (y[2] + y[3])) * (1.f / 64.f); const f32x4 d = y - mean;
            const float var = grp16_sum((d[0] * d[0] + d[1] * d[1]) + (d[2] * d[2] + d[3] * d[3])) * (1.f / 64.f);
            const float rs = rsqrtf(var + 64e-5f);
            const f32x4 lg = *(const f32x4*)(plg + c), lb = *(const f32x4*)(plb + c), rk = *(const f32x4*)(prk + c);
            const f32x4 rkk = r[i] * kp * rk; const float rks = grp16_sum((rkk[0] + rkk[1]) + (rkk[2] + rkk[3]));
            z[i] = (d * rs * lg + lb + v[i] * rks) * g[i]; }
        if (MK_F8_OUT1) st_row_f8((unsigned char*)(LWA + (size_t)row * 3072 + 2048), lane, z);
        else st_row_bf16(LWA + (size_t)row * 3072 + 2048, lane, z);
        cur = nxt;
    }
}
#ifndef MK_ONE_LAUNCH
#define MK_ONE_LAUNCH 1
#endif
#ifndef MK_NPH
#define MK_NPH 25
#endif
constexpr int NPH = 25;

__global__ void __launch_bounds__(512, 2) mk_fwd(Args a) {
    extern __shared__ __attribute__((aligned(16))) unsigned char lds_raw[];
    LAS unsigned char* lds = (LAS unsigned char*)lds_raw;
    const int lo = a.ph_lo, hi = a.ph_hi;
    if (threadIdx.x < 4) ((LAS unsigned*)(lds + LDS_BARW))[threadIdx.x] = 0u;
    __syncthreads();
    XcdBarrier bar; bar.bar = (unsigned*)(a.ws + WS_CTL); bar.x = 0; bar.st = nullptr;
    if (hi - lo > 1) bar = xcd_barrier_post((unsigned*)(a.ws + WS_CTL), (volatile LAS unsigned*)(lds + LDS_BARW));
#ifndef MK_PHMASK
#define MK_PHMASK 0xffffffffu
#endif
#ifndef MK_RWMODE
#define MK_RWMODE 1
#endif
#ifndef MK_DUPMASK
#define MK_DUPMASK 0u
#endif
#define PH(k) if (((MK_PHMASK >> (k)) & 1u) && lo <= (k) && (k) < hi) for (int _r = 0; _r < 1 + (int)((MK_DUPMASK >> (k)) & 1u); ++_r)
#ifndef MK_ALIGN_SWIGLU
#define MK_ALIGN_SWIGLU true
#endif
#ifndef MK_ALIGN_RW2
#define MK_ALIGN_RW2 true
#endif
#ifndef MK_GEMMDRY
#define MK_GEMMDRY 0
#endif
#define GDRY(k) (MK_GEMMDRY && ((MK_DUPMASK >> (k)) & 1u) && _r == 0 && lo == 0)
#define SEAM(k) do { if (lo <= (k) && (k) + 1 < hi) xcd_barrier(bar); } while (0)
    unsigned char* ws = a.ws;
    bf16_t* const S0 = (bf16_t*)(ws + slot_off(0)); bf16_t* const S1 = (bf16_t*)(ws + slot_off(1)); bf16_t* const S2 = (bf16_t*)(ws + slot_off(2));
    bf16_t* const S3 = (bf16_t*)(ws + slot_off(3)); bf16_t* const S4 = (bf16_t*)(ws + slot_off(4)); bf16_t* const S5 = (bf16_t*)(ws + slot_off(5)); bf16_t* const S6 = (bf16_t*)(ws + slot_off(6));
    float* const GD = (float*)(ws + WS_GD); bf16_t* const XC = (bf16_t*)a.out; bf16_t* const XB = (bf16_t*)a.out;
    unsigned char* const EW1 = (unsigned char*)a.out + ((size_t)128 << 20);
    const int G = gridDim.x, bx = blockIdx.x;
    unsigned char* const EW0U = (unsigned char*)a.out + ((size_t)198 << 20); unsigned char* const EW0D = (unsigned char*)S4;
#ifndef MK_CVT4
#define MK_CVT4 70
#endif
#ifndef MK_CVT13
#define MK_CVT13 8
#endif
#ifndef MK_G6K
#define MK_G6K 128
#endif
#ifndef MK_LORA1_S6
#define MK_LORA1_S6 0
#endif
    bf16_t* const LORA1P = MK_LORA1_S6 ? S6 : (bf16_t*)(ws + WS_LORA1);

    PH(0) { p0a_phase(a, lds); } SEAM(0);
    PH(1) { p0b_phase(a, S0); } SEAM(1);
    PH(2) { pg8::Gemm g{S0, (const bf16_t*)(ws + WS_WIN), 1024, 1024}; pg8::StaticOrder S; S.init(NR, 5888, G, bx);
            EpiProj E{ws, GD}; pg8::gemm_phase(lds, g, S, E, GDRY(2)); } SEAM(2);
    PH(3) { conv_phase(a, lds, S2, XC); } SEAM(3);
    PH(4) { scan_phase(a, lds, S1, S4, XC, GD, S0, S2);
            if (bx >= 128) expert_cvt_items(a, lds, 0, EW0U, MK_CVT4, EW0D, 1); } SEAM(4);
    PH(5) { post_mix_phase(a, S0, S2, XC, S5, (unsigned char*)S3); } SEAM(5);
    PH(6) { pg8::StaticOrder S; S.init(NR, 1024, G, bx); EpiPlain E{S1, 1024};
            if (MK_F8_OUT0) { pg8::Gemm g{S3, (const bf16_t*)(ws + WS_WOUT), 1024, 1024, F8_ACT_SH}; pg8::gemm_phase<EpiPlain, pg8::StaticOrder, true, true, true>(lds, g, S, E); }
            else { pg8::Gemm g{S5, (const bf16_t*)(ws + WS_WOUT), 2048, 2048}; pg8::gemm_phase(lds, g, S, E); }
            if (bx >= (NR / 256 * 4) % G) expert_cvt_items(a, lds, 0, EW0U, 12, EW0D); } SEAM(6);
    PH(7) { post_attn_phase(a, lds, 0, NR, S1, (unsigned char*)S0, nullptr, XB); } SEAM(7);
    PH(8) { for (int item = bx; item < 256; item += G) topk_item(a, lds, item, 8448, (const unsigned char*)S0, (unsigned char*)S5);
            expert_cvt_items(a, lds, 0, EW0U, 1 << 30, EW0D); } SEAM(8);
    PH(9) { pg8::Gemm g{S5, (const bf16_t*)EW0U, 512, 512, F8_HID_SH}; pg8::GroupOrder S; S.init(33, 11, G, bx);
            EpiSwiglu E{(unsigned char*)S0}; pg8::gemm_phase<EpiSwiglu, pg8::GroupOrder, MK_ALIGN_SWIGLU, true, true>(lds, g, S, E); } SEAM(9);
    PH(10) { pg8::Gemm g{S0, (const bf16_t*)EW0D, FFP / 2, FFP / 2, F8_HID_SH}; pg8::GroupOrder S; S.init(33, 4, G, bx);
             EpiGate E{S5, (const float*)(ws + WS_GATE)}; pg8::gemm_phase<EpiGate, pg8::GroupOrder, true, true, true>(lds, g, S, E);
             if (bx >= (NE * 33 * 4) % G) expert_cvt_items(a, lds, 1, EW1, 10); } SEAM(10);
    PH(11) { combine_phase(a, 0, NR, 8448, S5, S0, XB); } SEAM(11);
    PH(12) { mix_phase(S0, S2); } SEAM(12);
    PH(13) { { pg8::Gemm g{S0, (const bf16_t*)(ws + WS_WRW) + (size_t)3072 * 2048, 2048, 2048}; pg8::StaticOrder S; S.init(NR, 512, G, bx);
               EpiRw1 E{LORA1P, (bf16_t*)(ws + WS_LORA2)}; pg8::gemm_phase(lds, g, S, E); }
             { pg8::SkipOrder S; S.init(NR, 1024, G, bx, 16); EpiPlainG E{S5};
               if (MK_F8_RKV) { pg8::Gemm g{S2, (const bf16_t*)(ws + WS_WRW), 512, 512, F8_ACT_SH, 2048, USZ}; pg8::gemm_phase<EpiPlainG, pg8::SkipOrder, true, true, true>(lds, g, S, E); }
               else { pg8::Gemm g{S2, (const bf16_t*)(ws + WS_WRW), 1024, 1024, 0, 2048, USZ}; pg8::gemm_phase(lds, g, S, E); } }
             if (bx >= 96) expert_cvt_items(a, lds, 1, EW1, MK_CVT13); } SEAM(13);
    PH(14) { pg8::StaticOrder S; S.init(NR, 2048, G, bx); EpiPlainG E{S0};
             if (MK_F8_RKV) { pg8::Gemm g{S3, (const bf16_t*)(ws + WS_WRW) + (size_t)1024 * 2048, 512, 512, F8_ACT_SH, 2048, USZ}; pg8::gemm_phase<EpiPlainG, pg8::StaticOrder, true, true, true>(lds, g, S, E); }
             else { pg8::Gemm g{S3, (const bf16_t*)(ws + WS_WRW) + (size_t)1024 * 2048, 1024, 1024, 0, 2048, USZ}; pg8::gemm_phase(lds, g, S, E); }
             if (bx >= (NR / 256 * 8) % G) expert_cvt_items(a, lds, 1, EW1, 7); } SEAM(14);
    PH(15) { pg8::Gemm g{LORA1P, (const bf16_t*)(ws + WS_W2A), 256, MK_G6K, 0, 256, MK_G6K == 128 ? 128 : 0, MK_G6K == 128 ? 128 : 0}; pg8::StaticOrder S; S.init(NR, 3072, G, bx);
             EpiRw2 E{S2, inp(I_W0), inp(I_A0)}; pg8::gemm_phase<EpiRw2, pg8::StaticOrder, MK_ALIGN_RW2>(lds, g, S, E); } SEAM(15);
    PH(16) { for (int item = bx; item < 256; item += G) { rwkv_scan_item(lds, item, S5, S0, S1, S2, (((MK_DUPMASK >> 16) & 1u) && _r == 0) ? MK_RWMODE : 0); __syncthreads(); } } SEAM(16);
    PH(17) { pg8::Gemm g{(const bf16_t*)(ws + WS_LORA2), (const bf16_t*)(ws + WS_G2), 256, 256}; pg8::StaticOrder S; S.init(NL, 1024, G, bx);
             EpiPlain E{S6, 1024}; pg8::gemm_phase(lds, g, S, E); } SEAM(17);
    PH(18) { rw_post_phase(a, S5, S0, S1, S2, S6); } SEAM(18);
    PH(19) { pg8::StaticOrder S; S.init(NL, 1024, G, bx); EpiPlain E{S6, 1024};
             if (MK_F8_OUT1) { pg8::Gemm g{S2 + 2048, (const bf16_t*)(ws + WS_WO), 3072, 512, F8_ACT_SH}; pg8::gemm_phase<EpiPlain, pg8::StaticOrder, true, true, true>(lds, g, S, E); }
             else { pg8::Gemm g{S2 + 2048, (const bf16_t*)(ws + WS_WO), 3072, 1024}; pg8::gemm_phase(lds, g, S, E); } } SEAM(19);
    PH(20) { post_attn_phase(a, lds, 1, NL, S6, (unsigned char*)S0, XB, S3); } SEAM(20);
    PH(21) { for (int item = bx; item < 128; item += G) topk_item(a, lds, item, 8192, (const unsigned char*)S0, (unsigned char*)S5);
             expert_cvt_items(a, lds, 1, EW1); } SEAM(21);
    PH(22) { pg8::Gemm g{S5, (const bf16_t*)EW1, 512, 512, F8_HID_SH}; pg8::GroupOrder S; S.init(32, 11, G, bx);
             EpiSwiglu E{(unsigned char*)S0}; pg8::gemm_phase<EpiSwiglu, pg8::GroupOrder, MK_ALIGN_SWIGLU, true, true>(lds, g, S, E); } SEAM(22);
    PH(23) { pg8::Gemm g{S0, (const bf16_t*)(EW1 + W13_BYTES), FFP / 2, FFP / 2, F8_HID_SH}; pg8::GroupOrder S; S.init(32, 4, G, bx);
             EpiGate E{S5, (const float*)(ws + WS_GATE)}; pg8::gemm_phase<EpiGate, pg8::GroupOrder, true, true, true>(lds, g, S, E); } SEAM(23);
    PH(24) { combine_phase(a, 1, NL, 8192, S5, S0, S3); }
#undef PH
#undef SEAM
}

extern "C" void kernel_launch(void* const* d_in, const int* in_sizes, int n_in, void* d_out, int out_size, void* d_ws, size_t ws_size, hipStream_t stream) {
    static int grid = 0;
    if (grid == 0) {
        if (n_in != N_IN || out_size != NL * D || ws_size < WS_NEED) { grid = -1; return; }
        int dev = 0, cus = 0;
        if (hipGetDevice(&dev) != hipSuccess || hipDeviceGetAttribute(&cus, hipDeviceAttributeMultiprocessorCount, dev) != hipSuccess) { grid = -1; return; }
        if (hipFuncSetAttribute((const void*)mk_fwd, hipFuncAttributeMaxDynamicSharedMemorySize, LDS_BYTES) != hipSuccess) { grid = -1; return; }
        int per_cu = 0;
        (void)hipOccupancyMaxActiveBlocksPerMultiprocessor(&per_cu, (const void*)mk_fwd, 512, LDS_BYTES);
        (void)hipGetLastError();
        grid = cus;
    }
    if (grid < 0) return;
    (void)hipMemsetAsync((char*)d_ws + WS_CTL, 0, 65536, stream);
    Args a{};
    for (int i = 0; i < N_IN; ++i) a.in[i] = (const float*)d_in[i];
    a.out = (float*)d_out; a.ws = (unsigned char*)d_ws;
#if MK_ONE_LAUNCH
    a.ph_lo = 0; a.ph_hi = MK_NPH;
    hipLaunchKernelGGL(mk_fwd, dim3(grid), dim3(512), LDS_BYTES, stream, a);
#else
    for (int p = 0; p < MK_NPH; ++p) { a.ph_lo = p; a.ph_hi = p + 1; hipLaunchKernelGGL(mk_fwd, dim3(grid), dim3(512), LDS_BYTES, stream, a); }
#endif
}
```

```cpp
#define MK_ONE_LAUNCH 1
#define MK_NPH 25
#include <hip/hip_runtime.h>
#include <stdint.h>

#define DI __device__ __forceinline__
#define LAS __attribute__((address_space(3)))
typedef unsigned short bf16_t;
typedef short bf16x8 __attribute__((ext_vector_type(8)));
typedef short s16x4 __attribute__((ext_vector_type(4)));
typedef float f32x4 __attribute__((ext_vector_type(4)));
typedef float f32x2 __attribute__((ext_vector_type(2)));
typedef unsigned u32x4 __attribute__((ext_vector_type(4)));
typedef unsigned u32x2 __attribute__((ext_vector_type(2)));

constexpr int NB = 8, T = 8192, TC = 256, D = 1024;
constexpr int NL = NB * T;
constexpr int NCX = NB * TC;
constexpr int NR = NL + NCX;
constexpr int NE = 16, FF = 1408;
constexpr float RMS_EPS = 1e-6f;

constexpr size_t MiB = (size_t)1 << 20;
constexpr size_t WS_CTL = 0;
constexpr size_t WS_MOD = 1 * MiB;
constexpr size_t WS_AFF = 2 * MiB;
constexpr size_t WS_SLOT = 7 * MiB;
constexpr size_t WS_IDX = 12 * MiB;
constexpr size_t WS_GATE = 13 * MiB;
constexpr size_t WS_CTXS = 14 * MiB;
constexpr size_t WS_WIN = 22 * MiB;
constexpr size_t WS_WOUT = 34 * MiB;
constexpr size_t WS_BON = 2 * MiB;
constexpr size_t WS_LORA1 = 2 * MiB;
constexpr size_t WS_WRW = 38 * MiB;
constexpr size_t WS_WO = 52 * MiB;
constexpr size_t WS_W2A = 54 * MiB;
constexpr size_t WS_G2 = 56 * MiB;
constexpr size_t WS_GD = 57 * MiB;
constexpr size_t WS_LORA2 = 57 * MiB;
constexpr size_t WS_SLOTS = 100 * MiB;
constexpr size_t USZ = (size_t)NR * 1024 * 2;
DI constexpr size_t slot_off(int i) { return WS_SLOTS + (size_t)i * USZ; }
constexpr size_t WS_NEED = WS_SLOTS + 7 * USZ;

DI int tid_op() { int t = (int)threadIdx.x; asm volatile("" : "+v"(t)); return t; }
DI void lds_barrier() { asm volatile("s_waitcnt lgkmcnt(0)" ::: "memory"); __builtin_amdgcn_s_barrier(); asm volatile("" ::: "memory"); }
DI float bflo(unsigned w) { return __uint_as_float(w << 16); }
DI float bfhi(unsigned w) { return __uint_as_float(w & 0xffff0000u); }
DI float bf2f(bf16_t x) { return __uint_as_float(((unsigned)x) << 16); }
typedef __bf16 bf16v2_t __attribute__((ext_vector_type(2)));
DI unsigned pkbf(float lo, float hi) { const f32x2 v = {lo, hi}; const bf16v2_t b = __builtin_convertvector(v, bf16v2_t); return __builtin_bit_cast(unsigned, b); }
DI bf16_t f2bf(float x) { return (bf16_t)(pkbf(x, 0.f) & 0xffffu); }
DI float frcp(float x) { return __builtin_amdgcn_rcpf(x); }
DI float sigmoidf_(float x) { return frcp(1.f + __expf(-x)); }
DI float siluf_(float x) { return x * sigmoidf_(x); }
DI float softplusf_(float x) { return fmaxf(x, 0.f) + __logf(1.f + __expf(-fabsf(x))); }
DI float tanhf_(float x) { return 1.f - 2.f * frcp(1.f + __expf(2.f * x)); }
typedef unsigned u32x2_t __attribute__((ext_vector_type(2)));
template <int N> DI float dpp_ror(float x) { return __int_as_float(__builtin_amdgcn_update_dpp(0, __float_as_int(x), 0x120 + N, 0xf, 0xf, false)); }
DI float row16_sum(float v) { v += dpp_ror<8>(v); v += dpp_ror<4>(v); v += dpp_ror<2>(v); v += dpp_ror<1>(v); return v; }
DI float row16_max(float v) { v = fmaxf(v, dpp_ror<8>(v)); v = fmaxf(v, dpp_ror<4>(v)); v = fmaxf(v, dpp_ror<2>(v)); v = fmaxf(v, dpp_ror<1>(v)); return v; }
DI float xrow_sum(float v) { u32x2_t r = __builtin_amdgcn_permlane16_swap(__float_as_uint(v), __float_as_uint(v), false, false); v = __uint_as_float(r[0]) + __uint_as_float(r[1]);
                             r = __builtin_amdgcn_permlane32_swap(__float_as_uint(v), __float_as_uint(v), false, false); return __uint_as_float(r[0]) + __uint_as_float(r[1]); }
DI float xrow_max(float v) { u32x2_t r = __builtin_amdgcn_permlane16_swap(__float_as_uint(v), __float_as_uint(v), false, false); v = fmaxf(__uint_as_float(r[0]), __uint_as_float(r[1]));
                             r = __builtin_amdgcn_permlane32_swap(__float_as_uint(v), __float_as_uint(v), false, false); return fmaxf(__uint_as_float(r[0]), __uint_as_float(r[1])); }
DI float wave_sum(float v) { return xrow_sum(row16_sum(v)); }
template <int CTRL, int RMASK> DI float dpp_addz(float x) { return x + __int_as_float(__builtin_amdgcn_update_dpp(0, __float_as_int(x), CTRL, RMASK, 0xf, true)); }
DI float wave_incl_scan(float v) {
    v = dpp_addz<0x111, 0xf>(v); v = dpp_addz<0x112, 0xf>(v); v = dpp_addz<0x114, 0xf>(v); v = dpp_addz<0x118, 0xf>(v);
    v = dpp_addz<0x142, 0xa>(v); v = dpp_addz<0x143, 0xc>(v); return v; }
DI float clamp_f8(float x) { return fminf(fmaxf(x, -440.f), 440.f); }
DI unsigned pk_fp8x4(float a, float b, float c, float d) { int w = __builtin_amdgcn_cvt_pk_fp8_f32(clamp_f8(a), clamp_f8(b), 0, false); w = __builtin_amdgcn_cvt_pk_fp8_f32(clamp_f8(c), clamp_f8(d), w, true); return (unsigned)w; }
DI void unpack8(const u32x4 w, float (&f)[8]) { f[0] = bflo(w.x); f[1] = bfhi(w.x); f[2] = bflo(w.y); f[3] = bfhi(w.y); f[4] = bflo(w.z); f[5] = bfhi(w.z); f[6] = bflo(w.w); f[7] = bfhi(w.w); }
DI u32x4 pack8(const float (&f)[8]) { u32x4 w; w.x = pkbf(f[0], f[1]); w.y = pkbf(f[2], f[3]); w.z = pkbf(f[4], f[5]); w.w = pkbf(f[6], f[7]); return w; }

#define XB_TMO      128
#define XB_XCNT(j)  (256  + 64 * (j))
#define XB_XSUB(j)  (1280 + 64 * (j))
#define XB_XGEN(j)  (2304 + 64 * (j))
#define XB_TOP      3328
#define XB_TOPGEN   3392
#define XCD_BAR_WORDS 3456
#define XB_SPIN_CAP (1u << 18)
__device__ __forceinline__ unsigned xb_ld(unsigned* p)              { return __hip_atomic_load(p, __ATOMIC_RELAXED, __HIP_MEMORY_SCOPE_AGENT); }
__device__ __forceinline__ unsigned xb_add(unsigned* p, unsigned v) { return __hip_atomic_fetch_add(p, v, __ATOMIC_RELAXED, __HIP_MEMORY_SCOPE_AGENT); }
__device__ __forceinline__ unsigned xb_xcc_id() { return (unsigned)__builtin_amdgcn_s_getreg((3 << 11) | 20) & 0xFu; }
#define XB_SPIN(cond, bar) do { unsigned _sp = 0; while (cond) { __builtin_amdgcn_s_sleep(1); \
    if ((++_sp & 255u) == 0u) { if (xb_ld(&(bar)[XB_TMO])) break; if (_sp > XB_SPIN_CAP) { atomicAdd(&(bar)[XB_TMO], 1u); break; } } } } while (0)
struct XcdBarrier { unsigned* bar; unsigned x; volatile LAS unsigned* st; };
__device__ __forceinline__ XcdBarrier xcd_barrier_post(unsigned* bar, volatile LAS unsigned* st) {
    XcdBarrier b; b.bar = bar; b.x = xb_xcc_id(); b.st = st;
    if (threadIdx.x == 0) (void)xb_add(&bar[XB_XCNT(b.x)], 1u);
    return b;
}
__device__ __forceinline__ void xcd_barrier_complete(unsigned* bar, unsigned x, unsigned& nloc, unsigned& nx) {
    const unsigned G = gridDim.x * gridDim.y * gridDim.z;
    unsigned sum, cnt, mine, sp = 0u;
    for (;;) {
        sum = 0u; cnt = 0u; mine = 0u;
#pragma unroll
        for (unsigned j = 0; j < 16; ++j) { const unsigned c = xb_ld(&bar[XB_XCNT(j)]); sum += c; cnt += (c > 0u) ? 1u : 0u; mine = (j == x) ? c : mine; }
        if (sum == G) break;
        __builtin_amdgcn_s_sleep(1);
        if ((++sp & 255u) == 0u) { if (xb_ld(&bar[XB_TMO])) break; if (sp > XB_SPIN_CAP) { atomicAdd(&bar[XB_TMO], 1u); break; } }
    }
    nloc = mine > 0u ? mine : 1u; nx = cnt > 0u ? cnt : 1u;
}
__device__ __forceinline__ void xcd_barrier(const XcdBarrier& b) {
    asm volatile("s_waitcnt vmcnt(0)" ::: "memory");
    __syncthreads();
    if (threadIdx.x == 0) {
        unsigned* bar = b.bar;
        __builtin_amdgcn_s_waitcnt(0);
        unsigned nloc = b.st[0], nx = b.st[1];
        if (nloc == 0u) { xcd_barrier_complete(bar, b.x, nloc, nx); b.st[0] = nloc; b.st[1] = nx; }
        const unsigned old = xb_add(&bar[XB_XSUB(b.x)], 1u);
        const unsigned gen = old / nloc;
        if (old + 1u == (gen + 1u) * nloc) {
            __builtin_amdgcn_fence(__ATOMIC_RELEASE, "agent");
            asm volatile("s_waitcnt vmcnt(0)" ::: "memory");
            const unsigned og = xb_add(&bar[XB_TOP], 1u);
            const unsigned tg = og / nx;
            if (og + 1u == (tg + 1u) * nx) xb_add(&bar[XB_TOPGEN], 1u);
            else XB_SPIN(xb_ld(&bar[XB_TOPGEN]) == tg, bar);
            __builtin_amdgcn_fence(__ATOMIC_ACQUIRE, "agent");
            xb_add(&bar[XB_XGEN(b.x)], 1u);
            asm volatile("s_waitcnt vmcnt(0)" ::: "memory");
        } else {
            XB_SPIN(xb_ld(&bar[XB_XGEN(b.x)]) == gen, bar);
            __builtin_amdgcn_fence(__ATOMIC_ACQUIRE, "agent");
            asm volatile("s_waitcnt vmcnt(0)" ::: "memory");
        }
    }
    __syncthreads();
}

#ifndef MK_SPLIT
#define MK_SPLIT false
#endif
#ifndef MK_SPLIT_SWIGLU
#define MK_SPLIT_SWIGLU true
#endif
__device__ __forceinline__ void sub_barrier(unsigned* cnt, unsigned n) {
    asm volatile("s_waitcnt vmcnt(0)" ::: "memory");
    __syncthreads();
    if (threadIdx.x == 0) {
        __builtin_amdgcn_fence(__ATOMIC_RELEASE, "agent");
        asm volatile("s_waitcnt vmcnt(0)" ::: "memory");
        (void)xb_add(cnt, 1u);
        unsigned sp = 0u;
        while (xb_ld(cnt) < n) { __builtin_amdgcn_s_sleep(1); if (++sp > (1u << 24)) break; }
        __builtin_amdgcn_fence(__ATOMIC_ACQUIRE, "agent");
        asm volatile("s_waitcnt vmcnt(0)" ::: "memory");
    }
    __syncthreads();
}
namespace pg8 {
constexpr int BM = 256, BK = 64, HALF = 128, HTB = HALF * BK * 2, STAGE_BYTES = 8 * HTB, NXCD = 8, WGM = 8;
__host__ __device__ __forceinline__ int lds_byte(int r, int c) { const int st = (r >> 4) * 2 + (c >> 5), rr = r & 15, cc = c & 31, ob = rr * 64 + cc * 2; return st * 1024 + (ob ^ (((ob >> 9) & 1) << 5)); }
__host__ __device__ __forceinline__ void stage_rc(int b, int& R, int& C) { const int st = b / 1024, sb = b % 1024, swz = sb ^ (((sb >> 9) & 1) << 5); R = (st >> 1) * 16 + swz / 64; C = (st & 1) * 32 + (swz % 64) / 2; }
__host__ __device__ __forceinline__ int perm32(int rho) { const int n = rho >> 4, i = rho & 15; return 8 * (i >> 2) + 4 * n + (i & 3); }
struct Unit { int pm, pn; };
struct Gemm { const bf16_t* A; const bf16_t* Bt; int lda, K; int ash = 0; int ldb = 0; size_t agrp = 0, bgrp = 0; };

struct StaticOrder {
    int nM, nN, nwg, G, c;
    __device__ void init(int M, int N, int G_, int c_) { nM = M / BM; nN = N / BM; nwg = nM * nN; G = G_; c = c_; }
    __device__ bool next(int i, Unit& u) const {
        const long L = (long)i * G + c; if (L >= nwg) return false;
        int wgid = (int)L; { const int q = nwg / NXCD, r = nwg % NXCD, xcd = wgid % NXCD, off = wgid / NXCD; wgid = (xcd < r ? xcd * (q + 1) : r * (q + 1) + (xcd - r) * q) + off; }
        const int nig = WGM * nN, gid = wgid / nig, fm = gid * WGM, gsz = (nM - fm) < WGM ? (nM - fm) : WGM;
        u.pm = fm + ((wgid % nig) % gsz); u.pn = (wgid % nig) / gsz; return true;
    }
};
struct SkipOrder {
    int nM, nN, nwg, G, c, nskip;
    __device__ void init(int M, int N, int G_, int c_, int nskip_) { nM = M / BM; nN = N / BM; nwg = nM * nN; G = G_; c = c_; nskip = nskip_; }
    __device__ bool next(int i, Unit& u) const {
        long L; if (i == 0) L = c; else { if (c < nskip) return false; L = G + (long)(i - 1) * (G - nskip) + (c - nskip); }
        if (L >= nwg) return false;
        int wgid = (int)L; { const int q = nwg / NXCD, r = nwg % NXCD, xcd = wgid % NXCD, off = wgid / NXCD; wgid = (xcd < r ? xcd * (q + 1) : r * (q + 1) + (xcd - r) * q) + off; }
        const int nig = WGM * nN, gid = wgid / nig, fm = gid * WGM, gsz = (nM - fm) < WGM ? (nM - fm) : WGM;
        u.pm = fm + ((wgid % nig) % gsz); u.pn = (wgid % nig) / gsz; return true;
    }
};
struct GroupOrder {
    int tpe, npe, nwg, G, c;
    __device__ void init(int tpe_, int npe_, int G_, int c_) { tpe = tpe_; npe = npe_; nwg = NE * tpe_ * npe_; G = G_; c = c_; }
    __device__ bool next(int i, Unit& u) const {
        const long L = (long)i * G + c; if (L >= nwg) return false;
        const int per = tpe * npe, e = (int)L / per, r = (int)L % per;
        u.pm = e * tpe + r % tpe; u.pn = e * npe + r / tpe; return true;
    }
};

typedef int i32x4_t __attribute__((ext_vector_type(4)));
typedef int i32x8_t __attribute__((ext_vector_type(8)));
template <class Epi, class Sched, bool ALIGN_EPI_ = true, bool SP2 = true, bool F8 = false>
__device__ __forceinline__ void gemm_phase(LAS unsigned char* lds, const Gemm g, const Sched& S, const Epi& E, const bool dry = false) {
#ifndef MK_ALIGN_EPI
#define MK_ALIGN_EPI 1
#endif
    constexpr bool ALIGN_EPI = ALIGN_EPI_ && MK_ALIGN_EPI;
    const int tid = tid_op(), wid = __builtin_amdgcn_readfirstlane(tid >> 6), lane = tid & 63, wr = wid >> 2, wc = wid & 3, fr = lane & 15, fq = lane >> 4;
    int K = g.K, lda = g.lda, ldb = g.ldb ? g.ldb : g.K; asm volatile("" : "+s"(K), "+s"(lda), "+s"(ldb));
    const int nt = K / BK;
    unsigned voffA[2], voffB[2];
#pragma unroll
    for (int i = 0; i < 2; ++i) { int R, C; stage_rc(tid * 16 + i * 8192, R, C); const int Rb = Epi::PERM ? ((R & ~31) + perm32(R & 31)) : R;
        voffA[i] = (unsigned)(R * lda + C) * 2u; voffB[i] = (unsigned)(Rb * ldb + C) * 2u; }
    const size_t kstep = (size_t)(BK * 2);
    const size_t hstepA = (size_t)HALF * lda * 2, hstepB = (size_t)HALF * ldb * 2;
    const size_t tstepA = 2 * hstepA, tstepB = 2 * hstepB;
    const unsigned ldsw = (unsigned)wid * 1024u, ldsb = (unsigned)(size_t)lds + ldsw;
    const int aoff = lds_byte(wr * 64 + fr, fq * 8), boff = lds_byte(wc * 32 + fr, fq * 8);
#define PG8_SA(b, h) (((b) * 2 + (h)) * HTB)
#define PG8_SB(b, h) ((4 + (b) * 2 + (h)) * HTB)
#define PG8_STAGE(bufoff, gbase, voff) do { _Pragma("unroll") for (int _i = 0; _i < 2; ++_i) \
        asm volatile("s_mov_b32 m0, %2\n\ts_nop 0\n\tglobal_load_lds_dwordx4 %0, %1" :: "v"((voff)[_i]), "s"((const char*)(gbase)), "s"(ldsb + (unsigned)((bufoff) + _i * 8192)) : "memory", "m0"); } while (0)
#define PG8_RD(off) (*(const LAS i32x4_t*)(lds + (off)))
#define PG8_LDA(dst, b, h) do { _Pragma("unroll") for (int m = 0; m < 4; ++m) { if constexpr (F8) dst##8[m] = __builtin_shufflevector(PG8_RD(PG8_SA(b, h) + aoff + m * 2048), PG8_RD(PG8_SA(b, h) + aoff + m * 2048 + 1024), 0, 1, 2, 3, 4, 5, 6, 7); \
        else { _Pragma("unroll") for (int k = 0; k < 2; ++k) dst[m][k] = *(const LAS bf16x8*)(lds + PG8_SA(b, h) + aoff + m * 2048 + k * 1024); } } } while (0)
#define PG8_LDB(dst, b, h) do { _Pragma("unroll") for (int n = 0; n < 2; ++n) { if constexpr (F8) dst##8[n] = __builtin_shufflevector(PG8_RD(PG8_SB(b, h) + boff + n * 2048), PG8_RD(PG8_SB(b, h) + boff + n * 2048 + 1024), 0, 1, 2, 3, 4, 5, 6, 7); \
        else { _Pragma("unroll") for (int k = 0; k < 2; ++k) dst[n][k] = *(const LAS bf16x8*)(lds + PG8_SB(b, h) + boff + n * 2048 + k * 1024); } } } while (0)
#define PG8_MMA(ai, bj, At, Bt) do { __builtin_amdgcn_s_setprio(1); _Pragma("unroll") for (int m = 0; m < 4; ++m) _Pragma("unroll") for (int n = 0; n < 2; ++n) { \
        if constexpr (F8) asm volatile("v_mfma_scale_f32_16x16x128_f8f6f4 %0, %1, %2, %0, %3, %4 op_sel_hi:[0,0,0]" : "+v"(acc[ai][bj][m][n]) : "v"(Bt##8[n]), "v"(At##8[m]), "v"(sc_w), "v"(sc_1)); \
        else { _Pragma("unroll") for (int k = 0; k < 2; ++k) acc[ai][bj][m][n] = __builtin_amdgcn_mfma_f32_16x16x32_bf16(Bt[n][k], At[m][k], acc[ai][bj][m][n], 0, 0, 0); } } __builtin_amdgcn_s_setprio(0); } while (0)
#define PG8_WAIT_V(n) asm volatile("s_waitcnt vmcnt(" #n ")" ::: "memory")
#define PG8_WAIT_VE(n) do { if (fe) asm volatile("s_waitcnt vmcnt(%0)" :: "n"(n) : "memory"); else PG8_WAIT_V(8); } while (0)
#define PG8_WAIT_L(n) asm volatile("s_waitcnt lgkmcnt(" #n ")" ::: "memory")
#define PG8_BAR __builtin_amdgcn_s_barrier()
#define PG8_SCHED __builtin_amdgcn_sched_barrier(0)
    constexpr int W12 = 8 + Epi::NST, W3 = 8 + (Epi::SPLIT ? Epi::NST / 2 : Epi::NST);
    Unit cur, nxt; int ui = 0; bool est = false;
    if (!S.next(0, cur)) return;
    f32x4 acc[2][2][4][2];
#pragma unroll
    for (int a = 0; a < 2; ++a)
#pragma unroll
        for (int b = 0; b < 2; ++b)
#pragma unroll
            for (int m = 0; m < 4; ++m)
#pragma unroll
                for (int n = 0; n < 2; ++n) acc[a][b][m][n] = (f32x4){0.f, 0.f, 0.f, 0.f};
    bf16x8 At[4][2], B0[2][2], B1[2][2];
    i32x8_t At8[4], B08[2], B18[2];
    const int sc_w = 0x7A7A7A7A, sc_1 = (0x7F - g.ash) * 0x01010101;
#ifndef MK_GEMMFOLD
#define MK_GEMMFOLD 0
#endif
#define PG8_PM(x) ((MK_GEMMFOLD && dry) ? ((x) & 7) : (x))
    const char* cA = (const char*)g.A + (size_t)PG8_PM(cur.pm) * tstepA + (size_t)(cur.pn >> 2) * g.agrp; const char* cB = (const char*)g.Bt + (size_t)cur.pn * tstepB + (size_t)(cur.pn >> 2) * g.bgrp;
    if constexpr (SP2) {
        PG8_STAGE(PG8_SB(0, 0), cB, voffB); PG8_STAGE(PG8_SB(0, 1), cB + hstepB, voffB); PG8_STAGE(PG8_SA(0, 0), cA, voffA); PG8_STAGE(PG8_SA(0, 1), cA + hstepA, voffA);
        if (wr == 1) PG8_BAR;
        PG8_WAIT_V(2); PG8_BAR;
        PG8_STAGE(PG8_SB(1, 0), cB + kstep, voffB); PG8_STAGE(PG8_SA(1, 0), cA + kstep, voffA); PG8_STAGE(PG8_SB(1, 1), cB + hstepB + kstep, voffB); PG8_STAGE(PG8_SA(1, 1), cA + hstepA + kstep, voffA);
        PG8_WAIT_V(8); PG8_BAR;
    } else {
        PG8_STAGE(PG8_SB(0, 0), cB, voffB); PG8_STAGE(PG8_SA(0, 0), cA, voffA); PG8_STAGE(PG8_SB(0, 1), cB + hstepB, voffB); PG8_STAGE(PG8_SA(0, 1), cA + hstepA, voffA);
        if (wr == 1) PG8_BAR;
        PG8_WAIT_V(4); PG8_BAR;
        PG8_STAGE(PG8_SB(1, 0), cB + kstep, voffB); PG8_STAGE(PG8_SA(1, 0), cA + kstep, voffA); PG8_STAGE(PG8_SB(1, 1), cB + hstepB + kstep, voffB);
        PG8_WAIT_V(6); PG8_BAR;
    }
    for (;;) {
        bool has_next = false; const char* nA = cA; const char* nB = cB;
        if constexpr (!SP2) { has_next = S.next(ui + 1, nxt); if (has_next) { nA = (const char*)g.A + (size_t)PG8_PM(nxt.pm) * tstepA + (size_t)(nxt.pn >> 2) * g.agrp; nB = (const char*)g.Bt + (size_t)nxt.pn * tstepB + (size_t)(nxt.pn >> 2) * g.bgrp; } }
        for (int t = 0; t < nt; t += 2) {
            const bool last = (t == nt - 2);
            [[maybe_unused]] const char* a1 = cA + (size_t)(t + 1) * kstep;
            const bool fe = (t == 0) && est;
            if constexpr (SP2) {
            PG8_LDB(B0, 0, 0); PG8_LDB(B1, 0, 1); PG8_SCHED; PG8_LDA(At, 0, 0);
            PG8_WAIT_VE(W12); PG8_WAIT_L(0); PG8_BAR; PG8_MMA(0, 0, At, B0); PG8_MMA(0, 1, At, B1); PG8_BAR; PG8_SCHED;
            if (t == 0) { has_next = S.next(ui + 1, nxt); if (has_next) { nA = (const char*)g.A + (size_t)PG8_PM(nxt.pm) * tstepA + (size_t)(nxt.pn >> 2) * g.agrp; nB = (const char*)g.Bt + (size_t)nxt.pn * tstepB + (size_t)(nxt.pn >> 2) * g.bgrp; } }
            const char* a2 = last ? nA : cA + (size_t)(t + 2) * kstep; const char* b2 = last ? nB : cB + (size_t)(t + 2) * kstep;
            const char* a3 = a2 + kstep; const char* b3 = b2 + kstep;
            PG8_LDA(At, 0, 1); PG8_STAGE(PG8_SB(0, 0), b2, voffB); PG8_STAGE(PG8_SB(0, 1), b2 + hstepB, voffB); PG8_STAGE(PG8_SA(0, 0), a2, voffA);
            PG8_WAIT_VE(W12); PG8_WAIT_L(0); PG8_BAR; PG8_MMA(1, 0, At, B0); PG8_MMA(1, 1, At, B1); PG8_BAR; PG8_SCHED;
            PG8_LDB(B0, 1, 0); PG8_LDB(B1, 1, 1); PG8_SCHED; PG8_LDA(At, 1, 0); PG8_STAGE(PG8_SA(0, 1), a2 + hstepA, voffA);
            PG8_WAIT_VE(W3); PG8_WAIT_L(0); PG8_BAR; PG8_MMA(0, 0, At, B0); PG8_MMA(0, 1, At, B1); PG8_BAR; PG8_SCHED;
            PG8_LDA(At, 1, 1); PG8_STAGE(PG8_SB(1, 0), b3, voffB); PG8_STAGE(PG8_SB(1, 1), b3 + hstepB, voffB); PG8_STAGE(PG8_SA(1, 0), a3, voffA);
            PG8_WAIT_V(8);
            if constexpr (Epi::SPLIT) { if (last && !dry) { const int te = tid_op(), we = __builtin_amdgcn_readfirstlane(te >> 6), le = te & 63; E.template half<0>(acc, cur, we >> 2, we & 3, le & 15, le >> 4); } }
            PG8_WAIT_L(0); PG8_BAR; PG8_MMA(1, 0, At, B0); PG8_MMA(1, 1, At, B1); PG8_BAR; PG8_SCHED;
            PG8_STAGE(PG8_SA(1, 1), a3 + hstepA, voffA);
            } else {
            const char* a2 = last ? nA : cA + (size_t)(t + 2) * kstep; const char* b2 = last ? nB : cB + (size_t)(t + 2) * kstep;
            const char* a3 = a2 + kstep; const char* b3 = b2 + kstep;
            PG8_LDB(B0, 0, 0); PG8_SCHED; PG8_LDA(At, 0, 0); PG8_STAGE(PG8_SA(1, 1), a1 + hstepA, voffA);
            PG8_WAIT_L(8); PG8_BAR; PG8_WAIT_L(0); PG8_MMA(0, 0, At, B0); PG8_BAR; PG8_SCHED;
            PG8_LDB(B1, 0, 1); PG8_STAGE(PG8_SB(0, 0), b2, voffB);
            PG8_BAR; PG8_WAIT_L(0); PG8_MMA(0, 1, At, B1); PG8_BAR;
            PG8_LDA(At, 0, 1); PG8_STAGE(PG8_SA(0, 0), a2, voffA);
            PG8_BAR; PG8_WAIT_L(0); PG8_MMA(1, 0, At, B0); PG8_BAR; PG8_SCHED;
            PG8_STAGE(PG8_SB(0, 1), b2 + hstepB, voffB);
            PG8_WAIT_V(6); PG8_BAR; PG8_MMA(1, 1, At, B1); PG8_BAR;
            PG8_LDB(B0, 1, 0); PG8_SCHED; PG8_LDA(At, 1, 0); PG8_STAGE(PG8_SA(0, 1), a2 + hstepA, voffA);
            PG8_WAIT_L(8); PG8_BAR; PG8_WAIT_L(0); PG8_MMA(0, 0, At, B0); PG8_BAR; PG8_SCHED;
            PG8_LDB(B1, 1, 1); PG8_STAGE(PG8_SB(1, 0), b3, voffB);
            PG8_BAR; PG8_WAIT_L(0); PG8_MMA(0, 1, At, B1); PG8_BAR;
            PG8_LDA(At, 1, 1); PG8_STAGE(PG8_SA(1, 0), a3, voffA);
            PG8_BAR; PG8_WAIT_L(0); PG8_MMA(1, 0, At, B0); PG8_BAR; PG8_SCHED;
            PG8_STAGE(PG8_SB(1, 1), b3 + hstepB, voffB);
            PG8_WAIT_V(6); PG8_BAR; PG8_MMA(1, 1, At, B1); PG8_BAR;
            }
        }
        if constexpr (ALIGN_EPI) { if (wr == 0) PG8_BAR; }
        if constexpr (F8) asm volatile("s_nop 15\n\ts_nop 15" ::: "memory");
        if (!dry) { const int te = tid_op(), we = __builtin_amdgcn_readfirstlane(te >> 6), le = te & 63;
            if constexpr (Epi::SPLIT) E.template half<1>(acc, cur, we >> 2, we & 3, le & 15, le >> 4); else E(acc, cur, we >> 2, we & 3, le & 15, le >> 4); }
        est = !dry && E.counted(cur);
        if (!has_next) break;
#pragma unroll
        for (int a = 0; a < 2; ++a)
#pragma unroll
            for (int b = 0; b < 2; ++b)
#pragma unroll
                for (int m = 0; m < 4; ++m)
#pragma unroll
                    for (int n = 0; n < 2; ++n) acc[a][b][m][n] = (f32x4){0.f, 0.f, 0.f, 0.f};
        cur = nxt; cA = nA; cB = nB; ++ui;
        if constexpr (ALIGN_EPI) { if (wr == 1) PG8_BAR; }
    }
    PG8_WAIT_V(0);
    if constexpr (!ALIGN_EPI) { if (wr == 0) PG8_BAR; }
    PG8_BAR;
#undef PG8_SA
#undef PG8_SB
#undef PG8_STAGE
#undef PG8_LDA
#undef PG8_LDB
#undef PG8_MMA
#undef PG8_RD
#undef PG8_WAIT_V
#undef PG8_WAIT_VE
#undef PG8_WAIT_L
#undef PG8_BAR
#undef PG8_SCHED
}
}
#ifndef MK_F8_RKV
#define MK_F8_RKV 1
#endif
#ifndef MK_F8_OUT0
#define MK_F8_OUT0 1
#endif
#ifndef MK_F8_OUT1
#define MK_F8_OUT1 1
#endif
enum { I_X = 0, I_C, I_CTX, I_CCTX, I_ADAW, I_ADAB, I_NORMG, I_ROUTER, I_W1, I_W3, I_W2, I_ABIN, I_ABOUT, I_MLGB, I_MLNG, I_CONVW, I_CONVB, I_DTB, I_ALOG, I_SSD, I_SSNG,
       I_MU, I_WR, I_WK, I_WV, I_WO, I_W0, I_RW1, I_RW2, I_A0, I_A1, I_A2, I_G1, I_G2, I_KK, I_KA, I_RK, I_LNG, I_LNB, N_IN };
struct Args { const float* in[N_IN]; float* out; unsigned char* ws; int ph_lo, ph_hi; };
DI const float* inp(int i) { return ((const float* const volatile __attribute__((address_space(4)))*)__builtin_amdgcn_kernarg_segment_ptr())[i]; }

constexpr int LDS_BYTES = 163840;
constexpr int LDS_BARW = 163824;

DI const float* modp(const Args& a, int layer, int s, int n) { return (const float*)(a.ws + WS_MOD) + ((size_t)(layer * 9 + s) * 6 + n) * 1024; }
DI int row_mod_s(int row) { return row < NL ? (row >> 13) : 8; }

constexpr int CVT_KT = 256;
template <class F> DI void cvt_tile(LAS bf16_t* tl, bf16_t* dst, int ldk, int n0, int k0, F f) {
    const int tid = tid_op();
    float v[CVT_KT / 8];
#pragma unroll
    for (int p = 0; p < CVT_KT / 8; ++p) { const int kl = p * 8 + (tid >> 6), nl = tid & 63; v[p] = f(k0 + kl, n0 + nl); }
#pragma unroll
    for (int p = 0; p < CVT_KT / 8; ++p) { const int kl = p * 8 + (tid >> 6), nl = tid & 63; tl[nl * (CVT_KT + 8) + kl] = f2bf(v[p]); }
    __syncthreads();
#pragma unroll
    for (int q = 0; q < CVT_KT / 64; ++q) { const int nl = tid >> 3, kc = (tid & 7) + 8 * q; const u32x4 w = *(const LAS u32x4*)(tl + nl * (CVT_KT + 8) + kc * 8); *(u32x4*)(dst + (size_t)(n0 + nl) * ldk + k0 + kc * 8) = w; }
    __syncthreads();
}

DI void cvt_tile_f8(LAS unsigned char* tl, const float* src, int ld, int c0, int k0, unsigned char* dst, int ldk, int n0, bool zero) {
    const int tid = tid_op(), f4 = tid & 15, kq = tid >> 4;
    if (!zero) {
        f32x4 v[4];
#pragma unroll
        for (int j = 0; j < 4; ++j) v[j] = *(const f32x4*)(src + (size_t)(k0 + kq + 32 * j) * ld + c0 + 4 * f4);
#pragma unroll
        for (int j = 0; j < 4; ++j)
#pragma unroll
            for (int i = 0; i < 4; ++i) tl[(4 * f4 + i) * 144 + kq + 32 * j] = (unsigned char)(pk_fp8x4(v[j][i] * 32.f, 0.f, 0.f, 0.f) & 0xffu);
    }
    __syncthreads();
    { const int nl = tid >> 3, pc = tid & 7; u32x4 w = (u32x4){0u, 0u, 0u, 0u}; if (!zero) w = *(const LAS u32x4*)(tl + nl * 144 + pc * 16);
      *(u32x4*)(dst + (size_t)(n0 + nl) * ldk + k0 + pc * 16) = w; }
    __syncthreads();
}
constexpr int IT_MOD = 192;
constexpr int IT_WIN = 92 * (1024 / CVT_KT), IT_WOUT = MK_F8_OUT0 ? 16 * 16 : 16 * (2048 / CVT_KT), IT_WRW = MK_F8_RKV ? 48 * 8 + 8 * (2048 / CVT_KT) : 56 * (2048 / CVT_KT), IT_WO = MK_F8_OUT1 ? 16 * 8 : 16 * (1024 / CVT_KT), IT_W2A = 48 * (256 / CVT_KT), IT_G2 = 16 * (256 / CVT_KT);
constexpr int IT_P0A = IT_MOD + IT_WIN + IT_WOUT + IT_WRW + IT_WO + IT_W2A + IT_G2;

DI void mod_item(const Args& a, LAS unsigned char* lds, int item) {
    LAS float* sc = (LAS float*)lds;
    LAS float* red = sc + 9 * 1024;
    const int tid = tid_op(), l = item / 96, cg = item % 96;
    const float* pc = inp(I_C); const float* pcc = inp(I_CCTX); const float* padab = inp(I_ADAB);
    for (int i = tid; i < 9 * 1024; i += 512) { const int s = i >> 10, k = i & 1023; const float c = (s < 8) ? pc[s * 1024 + k] : pcc[k]; sc[i] = siluf_(c); }
    __syncthreads();
    const int col = tid & 63, ks = tid >> 6;
    float acc[9];
#pragma unroll
    for (int s = 0; s < 9; ++s) acc[s] = 0.f;
    const float* w = inp(I_ADAW) + (size_t)l * 1024 * 6144 + cg * 64 + col;
    for (int kb = 0; kb < 128; kb += 32) { float wv[32];
#pragma unroll
        for (int j = 0; j < 32; ++j) wv[j] = w[(size_t)(ks * 128 + kb + j) * 6144];
#pragma unroll
        for (int j = 0; j < 32; ++j) { const int k = ks * 128 + kb + j;
#pragma unroll
            for (int s = 0; s < 9; ++s) acc[s] += sc[s * 1024 + k] * wv[j]; } }
#pragma unroll
    for (int s = 0; s < 9; ++s) red[(ks * 9 + s) * 64 + col] = acc[s];
    __syncthreads();
    for (int i = tid; i < 9 * 64; i += 512) { const int s = i >> 6, c = i & 63; float v = padab[l * 6144 + cg * 64 + c];
#pragma unroll
        for (int k2 = 0; k2 < 8; ++k2) v += red[(k2 * 9 + s) * 64 + c];
        ((float*)(a.ws + WS_MOD))[(size_t)(l * 9 + s) * 6144 + cg * 64 + c] = v; }
    __syncthreads();
}

DI void p0a_phase(const Args& a, LAS unsigned char* lds) {
    LAS bf16_t* tl = (LAS bf16_t*)lds;
    for (int item = blockIdx.x; item < IT_P0A; item += gridDim.x) {
        int it = item;
        if (it < IT_MOD) { mod_item(a, lds, it); continue; }
        it -= IT_MOD;
        if (it < IT_WIN) { const int n0 = (it % 92) * 64, k0 = (it / 92) * CVT_KT; const float* src = inp(I_ABIN);
            cvt_tile(tl, (bf16_t*)(a.ws + WS_WIN), 1024, n0, k0, [&](int k, int n) -> float {
                if (n >= 5680) return 0.f;
                const int col = n < 3072 ? n : (n < 5632 ? n + 16 : (n < 5648 ? n - 2560 : n));
                const float v = src[(size_t)k * 5680 + col];
                return (n >= 512 && n < 1024) ? v * 0.08838834764831845f : v; });
            continue; }
        it -= IT_WIN;
        if (it < IT_WOUT) { const float* src = inp(I_ABOUT);
            if (MK_F8_OUT0) { const int n0 = (it % 16) * 64, k0 = (it / 16) * 128; cvt_tile_f8(lds, src, 1024, n0, k0, a.ws + WS_WOUT, 2048, n0, false); }
            else { const int n0 = (it % 16) * 64, k0 = (it / 16) * CVT_KT;
            cvt_tile(tl, (bf16_t*)(a.ws + WS_WOUT), 2048, n0, k0, [&](int k, int n) -> float { return src[(size_t)k * 1024 + n]; }); }
            continue; }
        it -= IT_WOUT;
        if (MK_F8_RKV && it < 48 * 8) {
            const int nt_ = it % 48, k0 = (it / 48) * 128, grp = nt_ >> 4, n0 = (nt_ & 15) * 64; const float* src = grp == 0 ? inp(I_WR) : (grp == 1 ? inp(I_WK) : inp(I_WV));
            cvt_tile_f8(lds, src, 1024, n0, k0, a.ws + WS_WRW + (size_t)grp * 1024 * 4096, 4096, n0, false); continue; }
        if (it < IT_WRW) { const int itl = MK_F8_RKV ? it - 48 * 8 : it, ntl = MK_F8_RKV ? 8 : 56; const int n0 = (MK_F8_RKV ? 3072 : 0) + (itl % ntl) * 64, k0 = (itl / ntl) * CVT_KT; const float* mu = inp(I_MU);
            const float *wr = inp(I_WR), *wk = inp(I_WK), *wv = inp(I_WV), *w1 = inp(I_RW1), *a1 = inp(I_A1), *g1 = inp(I_G1);
            cvt_tile(tl, (bf16_t*)(a.ws + WS_WRW), 2048, n0, k0, [&](int k, int n) -> float {
                const int kk = k & 1023; float w; int mi;
                if (n < 1024) { w = wr[(size_t)kk * 1024 + n]; mi = 0; }
                else if (n < 2048) { w = wk[(size_t)kk * 1024 + n - 1024]; mi = 2; }
                else if (n < 3072) { w = wv[(size_t)kk * 1024 + n - 2048]; mi = 3; }
                else if (n < 3136) { w = w1[(size_t)kk * 64 + n - 3072]; mi = 1; }
                else if (n < 3200) { w = w1[(size_t)(1024 + kk) * 64 + n - 3136]; mi = 1; }
                else if (n < 3264) { w = a1[(size_t)kk * 64 + n - 3200]; mi = 4; }
                else if (n < 3328) return 0.f;
                else if (n < 3488) { w = g1[(size_t)kk * 160 + n - 3328]; mi = 5; }
                else return 0.f;
                if (n < 3072) return k < 1024 ? w : 0.f;
                const float m = mu[mi * 1024 + kk];
                return w * (k >= 1024 ? m : 1.f - m); });
            continue; }
        it -= IT_WRW;
        if (it < IT_WO) { const float* src = inp(I_WO);
            if (MK_F8_OUT1) { const int n0 = (it % 16) * 64, k0 = (it / 16) * 128; cvt_tile_f8(lds, src, 1024, n0, k0, a.ws + WS_WO, 1024, n0, false); }
            else { const int n0 = (it % 16) * 64, k0 = (it / 16) * CVT_KT;
            cvt_tile(tl, (bf16_t*)(a.ws + WS_WO), 1024, n0, k0, [&](int k, int n) -> float { return src[(size_t)k * 1024 + n]; }); }
            continue; }
        it -= IT_WO;
        if (it < IT_W2A) { const int n0 = (it % 48) * 64, k0 = (it / 48) * CVT_KT; const float *w2 = inp(I_RW2), *a2 = inp(I_A2);
            cvt_tile(tl, (bf16_t*)(a.ws + WS_W2A), 256, n0, k0, [&](int k, int n) -> float {
                if (n < 1024) return k < 64 ? w2[(size_t)k * 1024 + n] : 0.f;
                if (n < 2048) return (k >= 64 && k < 128) ? w2[(size_t)k * 1024 + n - 1024] : 0.f;
                return (k >= 128 && k < 192) ? a2[(size_t)(k - 128) * 1024 + n - 2048] : 0.f; });
            continue; }
        it -= IT_W2A;
        { const int n0 = (it % 16) * 64, k0 = (it / 16) * CVT_KT; const float* g2 = inp(I_G2);
            cvt_tile(tl, (bf16_t*)(a.ws + WS_G2), 256, n0, k0, [&](int k, int n) -> float { return k < 160 ? g2[(size_t)k * 1024 + n] : 0.f; }); }
    }
}

constexpr int IT_W13 = 16 * 44 * 8, IT_W2E = 16 * 16 * 12;
constexpr size_t W13_BYTES = (size_t)16 * 2816 * 1024;
constexpr int FFP = 1536;
DI void expert_cvt_items(const Args& a, LAS unsigned char* lds, int layer, unsigned char* dst, int max_tiles = 1 << 30, unsigned char* dst2 = nullptr, int parts = 3) {
    const float* pw1 = inp(I_W1); const float* pw3 = inp(I_W3); const float* pw2 = inp(I_W2);
    unsigned* q = (unsigned*)(a.ws + WS_CTL + 32768) + 64 * layer;
    LAS unsigned* slot = (LAS unsigned*)(lds + 16384);
    int n = 0;
    if (parts & 1) for (; n < max_tiles; ++n) {
        if (threadIdx.x == 0) *slot = __hip_atomic_fetch_add(q, 1u, __ATOMIC_RELAXED, __HIP_MEMORY_SCOPE_AGENT);
        __syncthreads();
        const int item = (int)*slot;
        __syncthreads();
        if (item >= IT_W13) break;
        const int e = item / 352, r = item % 352, nt = r % 44, k0 = (r / 44) * 128;
        const int tile = nt >> 2, half = (nt >> 1) & 1, c0 = tile * 128 + (nt & 1) * 64;
        const float* src = (half ? pw3 : pw1) + (size_t)(layer * 16 + e) * 1024 * 1408;
        cvt_tile_f8(lds, src, 1408, c0, k0, dst + (size_t)e * 2816 * 1024, 1024, nt * 64, false);
    }
    if (parts & 2) for (; n < max_tiles; ++n) {
        if (threadIdx.x == 0) *slot = __hip_atomic_fetch_add(q + 1, 1u, __ATOMIC_RELAXED, __HIP_MEMORY_SCOPE_AGENT);
        __syncthreads();
        const int it = (int)*slot;
        __syncthreads();
        if (it >= IT_W2E) break;
        const int e = it / 192, r = it % 192, nt = r % 16, kt = r / 16;
        const float* src = pw2 + (size_t)(layer * 16 + e) * 1408 * 1024;
        cvt_tile_f8(lds, src, 1024, nt * 64, kt * 128, (dst2 ? dst2 : dst + W13_BYTES) + (size_t)e * 1024 * FFP, FFP, nt * 64, kt == 11);
    }
}

DI void ld_row_f32(const float* p, int lane, f32x4 (&v)[4]) {
#pragma unroll
    for (int i = 0; i < 4; ++i) v[i] = *(const f32x4*)(p + i * 256 + lane * 4);
}
DI void ld_row_bf16(const bf16_t* p, int lane, f32x4 (&v)[4]) {
#pragma unroll
    for (int i = 0; i < 4; ++i) { const u32x2 w = *(const u32x2*)(p + i * 256 + lane * 4); v[i] = (f32x4){bflo(w.x), bfhi(w.x), bflo(w.y), bfhi(w.y)}; }
}
DI void ld_row_raw(const bf16_t* p, int lane, u32x2 (&v)[4]) {
#pragma unroll
    for (int i = 0; i < 4; ++i) v[i] = *(const u32x2*)(p + i * 256 + lane * 4);
}
DI void cvt_row(const u32x2 (&w)[4], f32x4 (&v)[4]) {
#pragma unroll
    for (int i = 0; i < 4; ++i) v[i] = (f32x4){bflo(w[i].x), bfhi(w[i].x), bflo(w[i].y), bfhi(w[i].y)};
}
DI void st_row_bf16(bf16_t* p, int lane, const f32x4 (&v)[4]) {
#pragma unroll
    for (int i = 0; i < 4; ++i) { u32x2 w; w.x = pkbf(v[i][0], v[i][1]); w.y = pkbf(v[i][2], v[i][3]); *(u32x2*)(p + i * 256 + lane * 4) = w; }
}
constexpr float F8_ACT = 8.f; constexpr int F8_ACT_SH = 3;
constexpr float F8_HID = 4.f; constexpr int F8_HID_SH = 2;
DI void st_row_f8(unsigned char* p, int lane, const f32x4 (&v)[4]) {
#pragma unroll
    for (int i = 0; i < 4; ++i) *(unsigned*)(p + i * 256 + lane * 4) = pk_fp8x4(v[i][0] * F8_ACT, v[i][1] * F8_ACT, v[i][2] * F8_ACT, v[i][3] * F8_ACT);
}
DI float sumsq4(const f32x4 (&v)[4]) { float s = 0.f;
#pragma unroll
    for (int i = 0; i < 4; ++i) s += (v[i][0] * v[i][0] + v[i][1] * v[i][1]) + (v[i][2] * v[i][2] + v[i][3] * v[i][3]);
    return s; }
DI void norm_mod(const f32x4 (&x)[4], const float* g, const float* shift, const float* scale, int lane, f32x4 (&h)[4]) {
    const float r = rsqrtf(wave_sum(sumsq4(x)) * (1.f / 1024.f) + RMS_EPS);
#pragma unroll
    for (int i = 0; i < 4; ++i) { const int c = i * 256 + lane * 4; const f32x4 gv = *(const f32x4*)(g + c), sh = *(const f32x4*)(shift + c), sc = *(const f32x4*)(scale + c);
        h[i] = x[i] * r * gv * (sc + 1.f) + sh; }
}

DI void p0b_phase(const Args& a, bf16_t* hbuf) {
    const int tid_ = tid_op(), lane = tid_ & 63, wid = tid_ >> 6;
    const float* px = inp(I_X); const float* pctx = inp(I_CTX); const float* png = inp(I_NORMG);
    const int stride = gridDim.x * 8;
    int row = blockIdx.x * 8 + wid;
    f32x4 x[4];
    if (row < NR) ld_row_f32(row < NL ? px + (size_t)row * 1024 : pctx + (size_t)(row - NL) * 1024, lane, x);
    for (; row < NR; row += stride) {
        f32x4 xn[4], h[4]; const int nr = row + stride;
#pragma unroll
        for (int i = 0; i < 4; ++i) xn[i] = x[i];
        if (nr < NR) ld_row_f32(nr < NL ? px + (size_t)nr * 1024 : pctx + (size_t)(nr - NL) * 1024, lane, xn);
        const int s = row_mod_s(row);
        norm_mod(x, png, modp(a, 0, s, 0), modp(a, 0, s, 1), lane, h);
        st_row_bf16(hbuf + (size_t)row * 1024, lane, h);
#pragma unroll
        for (int i = 0; i < 4; ++i) x[i] = xn[i];
    }
}

typedef pg8::Unit Unit;
DI u32x4 pack_acc(const f32x4 v0, const f32x4 v1) { u32x4 w; w.x = pkbf(v0[0], v0[1]); w.y = pkbf(v0[2], v0[3]); w.z = pkbf(v1[0], v1[1]); w.w = pkbf(v1[2], v1[3]); return w; }

struct EpiProj {
    static constexpr bool PERM = true; static constexpr bool SPLIT = MK_SPLIT; static constexpr int NST = 16; DI bool counted(const Unit& u) const { return u.pn < 22; }
    unsigned char* ws; float* GD;
    template <int ai> DI void half(const f32x4 (&acc)[2][2][4][2], const Unit& u, int wr, int wc, int fr, int fq) const {
        const int row0 = u.pm * 256 + wr * 64 + fr, pn = u.pn;
        if (pn < 22) {
            const int slot = pn < 4 ? 1 : pn < 8 ? 4 : pn < 16 ? 5 : 2, first = pn < 4 ? 0 : pn < 8 ? 4 : pn < 16 ? 8 : 16, ldc = pn < 8 ? 1024 : pn < 16 ? 2048 : 1536;
            bf16_t* base = (bf16_t*)(ws + slot_off(slot));
            const int col0 = (pn - first) * 256 + wc * 32 + 8 * fq;
#pragma unroll
            for (int m = 0; m < 4; ++m) { bf16_t* rowp = base + (size_t)(row0 + ai * 128 + m * 16) * ldc + col0;
#pragma unroll
                for (int bj = 0; bj < 2; ++bj) *(u32x4*)(rowp + bj * 128) = pack_acc(acc[ai][bj][m][0], acc[ai][bj][m][1]); }
        } else if (wc * 32 + 8 * fq < 48) {
            const int c0 = wc * 32 + 8 * fq;
#pragma unroll
            for (int m = 0; m < 4; ++m) { float* rowp = GD + (size_t)(row0 + ai * 128 + m * 16) * 48 + c0;
                *(f32x4*)(rowp) = acc[ai][0][m][0]; *(f32x4*)(rowp + 4) = acc[ai][0][m][1]; }
        }
    }
    DI void operator()(const f32x4 (&acc)[2][2][4][2], const Unit& u, int wr, int wc, int fr, int fq) const { half<0>(acc, u, wr, wc, fr, fq); half<1>(acc, u, wr, wc, fr, fq); }
};
struct EpiPlain {
    static constexpr bool PERM = true; static constexpr bool SPLIT = MK_SPLIT; static constexpr int NST = 16; DI bool counted(const Unit& u) const { return true; }
    bf16_t* O; int ldc;
    template <int ai> DI void half(const f32x4 (&acc)[2][2][4][2], const Unit& u, int wr, int wc, int fr, int fq) const {
        const int row0 = u.pm * 256 + wr * 64 + fr, col0 = u.pn * 256 + wc * 32 + 8 * fq;
#pragma unroll
        for (int m = 0; m < 4; ++m) { bf16_t* rowp = O + (size_t)(row0 + ai * 128 + m * 16) * ldc + col0;
#pragma unroll
            for (int bj = 0; bj < 2; ++bj) *(u32x4*)(rowp + bj * 128) = pack_acc(acc[ai][bj][m][0], acc[ai][bj][m][1]); }
    }
    DI void operator()(const f32x4 (&acc)[2][2][4][2], const Unit& u, int wr, int wc, int fr, int fq) const { half<0>(acc, u, wr, wc, fr, fq); half<1>(acc, u, wr, wc, fr, fq); }
};
struct EpiPlainG {
    static constexpr bool PERM = true; static constexpr bool SPLIT = MK_SPLIT; static constexpr int NST = 16; DI bool counted(const Unit& u) const { return true; }
    bf16_t* O;
    template <int ai> DI void half(const f32x4 (&acc)[2][2][4][2], const Unit& u, int wr, int wc, int fr, int fq) const {
        const int row0 = u.pm * 256 + wr * 64 + fr, col0 = (u.pn & 3) * 256 + wc * 32 + 8 * fq;
        bf16_t* base = O + (size_t)(u.pn >> 2) * (USZ / 2);
#pragma unroll
        for (int m = 0; m < 4; ++m) { bf16_t* rowp = base + (size_t)(row0 + ai * 128 + m * 16) * 1024 + col0;
#pragma unroll
            for (int bj = 0; bj < 2; ++bj) *(u32x4*)(rowp + bj * 128) = pack_acc(acc[ai][bj][m][0], acc[ai][bj][m][1]); }
    }
    DI void operator()(const f32x4 (&acc)[2][2][4][2], const Unit& u, int wr, int wc, int fr, int fq) const { half<0>(acc, u, wr, wc, fr, fq); half<1>(acc, u, wr, wc, fr, fq); }
};
struct EpiSwiglu {
    static constexpr bool PERM = true; static constexpr bool SPLIT = MK_SPLIT_SWIGLU; static constexpr int NST = 8; DI bool counted(const Unit& u) const { return true; }
    unsigned char* HID;
    DI void operator()(const f32x4 (&acc)[2][2][4][2], const Unit& u, int wr, int wc, int fr, int fq) const { half<0>(acc, u, wr, wc, fr, fq); half<1>(acc, u, wr, wc, fr, fq); }
    template <int ai> DI void half(const f32x4 (&acc)[2][2][4][2], const Unit& u, int wr, int wc, int fr, int fq) const {
        const int row0 = u.pm * 256 + wr * 64 + fr, t = u.pn % 11, col0 = t * 128 + wc * 32 + 8 * fq;
        {
#pragma unroll
            for (int m = 0; m < 4; ++m) { f32x4 h0, h1;
#pragma unroll
                for (int j = 0; j < 4; ++j) { h0[j] = siluf_(acc[ai][0][m][0][j]) * acc[ai][1][m][0][j] * F8_HID; h1[j] = siluf_(acc[ai][0][m][1][j]) * acc[ai][1][m][1][j] * F8_HID; }
                unsigned char* rp = HID + (size_t)(row0 + ai * 128 + m * 16) * FFP + col0;
                u32x2 w; w.x = pk_fp8x4(h0[0], h0[1], h0[2], h0[3]); w.y = pk_fp8x4(h1[0], h1[1], h1[2], h1[3]); *(u32x2*)rp = w;
                if (t == 10) *(u32x2*)(rp + 128) = (u32x2){0u, 0u}; }
        }
    }
};
struct EpiGate {
    static constexpr bool PERM = true; static constexpr bool SPLIT = false; static constexpr int NST = 16; DI bool counted(const Unit& u) const { return true; }
    bf16_t* Y; const float* gate;
    DI void operator()(const f32x4 (&acc)[2][2][4][2], const Unit& u, int wr, int wc, int fr, int fq) const {
        const int row0 = u.pm * 256 + wr * 64 + fr, col0 = (u.pn & 3) * 256 + wc * 32 + 8 * fq;
#pragma unroll
        for (int ai = 0; ai < 2; ++ai)
#pragma unroll
            for (int m = 0; m < 4; ++m) { const int row = row0 + ai * 128 + m * 16; const float gv = gate[row]; bf16_t* rowp = Y + (size_t)row * 1024 + col0;
#pragma unroll
                for (int bj = 0; bj < 2; ++bj) *(u32x4*)(rowp + bj * 128) = pack_acc(acc[ai][bj][m][0] * gv, acc[ai][bj][m][1] * gv); }
    }
};
DI void cv_unpack(const u32x4 w, float (&f)[8]) { unpack8(w, f); }
typedef float f32x2_c __attribute__((ext_vector_type(2)));
DI void conv_phase(const Args& a, LAS unsigned char* lds, const bf16_t* XBC, bf16_t* XC, int first_blk = 0) {
    const int tid = tid_op(), ch = tid & 7, x = tid >> 3;
    const float* pw = inp(I_CONVW); const float* pb = inp(I_CONVB);
    for (int item = (int)blockIdx.x - first_blk; item < 768 + 768; item += (int)gridDim.x - first_blk) {
        const bool lat = item < 768; const int it = lat ? item : item - 768, seg = it & 3, cg = (it >> 2) % 24, b = (it >> 2) / 24, c0 = (cg * 8 + ch) * 8;
        float w[9][8], acc0[8];
#pragma unroll
        for (int t = 0; t < 9; ++t) { const f32x4 w0 = *(const f32x4*)(pw + t * 1536 + c0), w1 = *(const f32x4*)(pw + t * 1536 + c0 + 4);
#pragma unroll
            for (int j = 0; j < 4; ++j) { w[t][j] = w0[j]; w[t][4 + j] = w1[j]; } }
        { const f32x4 b0 = *(const f32x4*)(pb + c0), b1 = *(const f32x4*)(pb + c0 + 4);
#pragma unroll
          for (int j = 0; j < 4; ++j) { acc0[j] = b0[j]; acc0[4 + j] = b1[j]; } }
        const u32x4 z4 = (u32x4){0u, 0u, 0u, 0u};
        if (lat) {
            const int y0 = seg * 32; const bf16_t* base = XBC + (size_t)(b * T) * 1536 + c0;
            auto ldrow = [&](int y, u32x4 (&r)[3]) {
                const bool yok = (y >= 0) && (y < 128); const bf16_t* p = base + (size_t)(y * 64 + x) * 1536;
                r[0] = (yok && x > 0) ? *(const u32x4*)(p - 1536) : z4; r[1] = yok ? *(const u32x4*)p : z4; r[2] = (yok && x < 63) ? *(const u32x4*)(p + 1536) : z4; };
            float ra[3][8], rb[3][8], rc[3][8]; u32x4 raw[3];
            ldrow(y0 - 1, raw);
#pragma unroll
            for (int d = 0; d < 3; ++d) cv_unpack(raw[d], ra[d]);
            ldrow(y0, raw);
#pragma unroll
            for (int d = 0; d < 3; ++d) cv_unpack(raw[d], rb[d]);
            ldrow(y0 + 1, raw);
            for (int yy = 0; yy < 32; ++yy) {
                const int y = y0 + yy;
#pragma unroll
                for (int d = 0; d < 3; ++d) cv_unpack(raw[d], rc[d]);
                ldrow(y + 2, raw);
                float acc[8];
#pragma unroll
                for (int j = 0; j < 8; ++j) { float s = acc0[j];
#pragma unroll
                    for (int d = 0; d < 3; ++d) s += w[d][j] * ra[d][j] + w[3 + d][j] * rb[d][j] + w[6 + d][j] * rc[d][j];
                    acc[j] = siluf_(s); }
                *(u32x4*)(XC + (size_t)(b * T + y * 64 + x) * 1536 + c0) = pack8(acc);
#pragma unroll
                for (int d = 0; d < 3; ++d)
#pragma unroll
                    for (int j = 0; j < 8; ++j) { ra[d][j] = rb[d][j]; rb[d][j] = rc[d][j]; }
            }
        } else {
            const int tt = seg * 64 + x; const bf16_t* p = XBC + (size_t)(NL + b * TC + tt) * 1536 + c0;
            const u32x4 r0 = tt > 0 ? *(const u32x4*)(p - 1536) : z4, r1 = *(const u32x4*)p, r2 = tt < TC - 1 ? *(const u32x4*)(p + 1536) : z4;
            float f0[8], f1[8], f2[8], acc[8]; unpack8(r0, f0); unpack8(r1, f1); unpack8(r2, f2);
#pragma unroll
            for (int j = 0; j < 8; ++j) acc[j] = siluf_(acc0[j] + w[3][j] * f0[j] + w[4][j] * f1[j] + w[5][j] * f2[j]);
            *(u32x4*)(XC + (size_t)(NL + b * TC + tt) * 1536 + c0) = pack8(acc);
        }
    }
}

#define MFMA16(a, b, c) __builtin_amdgcn_mfma_f32_16x16x32_bf16((a), (b), (c), 0, 0, 0)
constexpr int MP = 136;
constexpr int SP = 72;
DI float rdlane(float x, int l) { return __int_as_float(__builtin_amdgcn_readlane(__float_as_int(x), l)); }
DI bf16x8 ld_frag(const LAS bf16_t* p) { return *(const LAS bf16x8*)p; }
DI bf16x8 ld_frag2(const LAS bf16_t* p) {
    const u32x2 lo = *(const LAS u32x2*)p, hi = *(const LAS u32x2*)(p + 16); u32x4 w; w.x = lo.x; w.y = lo.y; w.z = hi.x; w.w = hi.y; return __builtin_bit_cast(bf16x8, w); }
DI bf16x8 pack_frag(const float (&p)[8]) { return __builtin_bit_cast(bf16x8, pack8(p)); }

constexpr int VP = 80;
typedef short s16x4 __attribute__((ext_vector_type(4)));
DI s16x4 ld_tr4(const LAS unsigned char* p) { return __builtin_amdgcn_ds_read_tr16_b64_v4i16((LAS s16x4*)p); }
DI bf16x8 ld_tr8(const LAS unsigned char* p, int second) { const s16x4 lo = ld_tr4(p), hi = ld_tr4(p + second); return __builtin_shufflevector(lo, hi, 0, 1, 2, 3, 4, 5, 6, 7); }
constexpr int ML_KS = 0, ML_VS = 128 * MP * 2, ML_CB = ML_VS + 128 * VP * 2, ML_F = ML_CB + 80 * MP * 2;
template <int SKIP = 0> DI void mlstm_item(const Args& a, LAS unsigned char* lds, int item, const bf16_t* QK, const bf16_t* V, const float* GD, bf16_t* HM) {
    const int tid = tid_op(), lane = tid & 63, wid = __builtin_amdgcn_readfirstlane(tid >> 6), fr = lane & 15, fq = lane >> 4;
    const int b = item >> 4, h = (item >> 2) & 3, vs = item & 3;
    LAS bf16_t* Ks = (LAS bf16_t*)(lds + ML_KS); LAS bf16_t* Vs = (LAS bf16_t*)(lds + ML_VS); LAS bf16_t* Cb = (LAS bf16_t*)(lds + ML_CB);
    LAS float* fb = (LAS float*)(lds + ML_F);
    const int J = wid < 4 ? wid : 11 - wid;
    const int jj = 16 * J + fr;
    constexpr int YP = 68, ML_YB = ML_F + 2048;
    const int orow = tid >> 3, opc = tid & 7;
    for (int i = tid; i < 128 * 16; i += 512) Vs[(i >> 4) * VP + 64 + (i & 15)] = ((i & 15) == 0) ? (bf16_t)0x3F80 : (bf16_t)0;
    const float* pgb = inp(I_MLGB);
    for (int dir = 0; dir < 2; ++dir) {
        f32x4 accC[5];
#pragma unroll
        for (int vt = 0; vt < 5; ++vt) accC[vt] = (f32x4){0.f, 0.f, 0.f, 0.f};
        for (int i = tid; i < 80 * MP; i += 512) Cb[i] = 0;
        const float gbi = pgb[dir * 8 + h], gbf = pgb[dir * 8 + 4 + h];
        const int sg = dir == 0 ? 1 : -1;
        auto r0_of = [&](int c) -> int { const bool isc = c < 2; const int cc = isc ? c : c - 2, n = isc ? TC : T, rbase = isc ? NL + b * TC : b * T; return rbase + (dir == 0 ? cc * 128 : n - 1 - cc * 128); };
        u32x4 kreg[4], vreg[2]; bf16x8 qn[4]; float graw[4] = {0.f, 0.f, 0.f, 0.f};
        const int sr = tid & 31, ch = tid >> 5;
        const int vr = tid >> 2, vc = tid & 3;
        auto issue = [&](int c) { const int r0 = r0_of(c); const size_t jrow = (size_t)(r0 + sg * jj);
#pragma unroll
            for (int i = 0; i < 4; ++i) { const size_t srow = (size_t)(r0 + sg * (4 * sr + i)); kreg[i] = *(const u32x4*)(QK + srow * 1024 + 512 + h * 128 + ch * 8); }
            { const bf16_t* pv = V + (size_t)(r0 + sg * vr) * 1024 + h * 256 + vs * 64 + vc * 16; vreg[0] = *(const u32x4*)pv; vreg[1] = *(const u32x4*)(pv + 8); }
#pragma unroll
            for (int kk = 0; kk < 4; ++kk) qn[kk] = *(const bf16x8*)(QK + jrow * 1024 + h * 128 + kk * 32 + fq * 8);
            if (wid == 0) { const float* g0 = GD + (size_t)(r0 + sg * (2 * lane)) * 48 + dir * 8 + h; const float* g1 = GD + (size_t)(r0 + sg * (2 * lane + 1)) * 48 + dir * 8 + h;
                graw[0] = g0[0]; graw[1] = g0[4]; graw[2] = g1[0]; graw[3] = g1[4]; } };
        auto gates = [&]() {
            const float ig0 = graw[0] + gbi, ig1 = graw[2] + gbi, lf0 = -softplusf_(-(graw[1] + gbf)), lf1 = -softplusf_(-(graw[3] + gbf));
            const float s = wave_incl_scan(lf0 + lf1);
            const float bend = rdlane(s, 63), b1 = s, b0 = s - lf1;
            constexpr float L2E = 1.4426950408889634f;
            fb[2 * lane] = b0 * L2E; fb[2 * lane + 1] = b1 * L2E; fb[128 + 2 * lane] = (ig0 - b0) * L2E; fb[128 + 2 * lane + 1] = (ig1 - b1) * L2E;
            fb[256 + 2 * lane] = __expf(bend - b0 + ig0); fb[256 + 2 * lane + 1] = __expf(bend - b1 + ig1);
            if (lane == 0) fb[384] = bend * L2E; };
        u32x4 oldv[2];
        auto writeout = [&](int c) {
            const int r0w = r0_of(c);
#pragma unroll
            for (int q = 0; q < 2; ++q) { const int row = orow + 64 * q; const LAS bf16_t* yb = (const LAS bf16_t*)(lds + ML_YB) + row * YP + opc * 8;
                const u32x2 lo = *(const LAS u32x2*)yb, hi = *(const LAS u32x2*)(yb + 4); u32x4 w; w.x = lo.x; w.y = lo.y; w.z = hi.x; w.w = hi.y;
                if (dir == 1) { float f[8], o[8]; unpack8(w, f); unpack8(oldv[q], o);
#pragma unroll
                    for (int j = 0; j < 8; ++j) f[j] += o[j];
                    w = pack8(f); }
                if (!(SKIP & 1)) *(u32x4*)(HM + (size_t)(r0w + sg * row) * 1024 + h * 256 + vs * 64 + opc * 8) = w; } };
        issue(0);
        if (wid == 0) gates();
        for (int c = 0; c < 66; ++c) {
            const int r0 = r0_of(c);
            lds_barrier();
            if (!(SKIP & 2)) {
#pragma unroll
                for (int i = 0; i < 4; ++i) *(LAS u32x4*)(Ks + (4 * sr + i) * MP + ch * 8) = kreg[i];
                *(LAS u32x4*)(Vs + vr * VP + vc * 16) = vreg[0]; *(LAS u32x4*)(Vs + vr * VP + vc * 16 + 8) = vreg[1]; }
            bf16x8 qf[4];
#pragma unroll
            for (int kk = 0; kk < 4; ++kk) qf[kk] = qn[kk];
            lds_barrier();
            if (c + 1 < 66) issue(c + 1);
            if (dir == 1 && !(SKIP & 1)) {
#pragma unroll
                for (int q = 0; q < 2; ++q) oldv[q] = *(const u32x4*)(HM + (size_t)(r0 + sg * (orow + 64 * q)) * 1024 + h * 256 + vs * 64 + opc * 8); }
            if (!(SKIP & 4)) {
            f32x4 as[8];
#pragma unroll
            for (int st = 0; st < 8; ++st) as[st] = (f32x4){0.f, 0.f, 0.f, 0.f};
#pragma unroll
            for (int sp = 0; sp < 8; sp += 2) {
                if (sp + 1 <= J) { bf16x8 kfr[2][4];
#pragma unroll
                    for (int u = 0; u < 2; ++u)
#pragma unroll
                        for (int kk = 0; kk < 4; ++kk) kfr[u][kk] = ld_frag(Ks + (16 * (sp + u) + fr) * MP + kk * 32 + fq * 8);
                    __builtin_amdgcn_sched_barrier(0);
#pragma unroll
                    for (int kk = 0; kk < 4; ++kk)
#pragma unroll
                        for (int u = 0; u < 2; ++u) as[sp + u] = MFMA16(kfr[u][kk], qf[kk], as[sp + u]); }
                else if (sp <= J) { bf16x8 kfr[4];
#pragma unroll
                    for (int kk = 0; kk < 4; ++kk) kfr[kk] = ld_frag(Ks + (16 * sp + fr) * MP + kk * 32 + fq * 8);
                    __builtin_amdgcn_sched_barrier(0);
#pragma unroll
                    for (int kk = 0; kk < 4; ++kk) as[sp] = MFMA16(kfr[kk], qf[kk], as[sp]); } }
            const float bj = fb[jj];
            bf16x8 pf[4];
#pragma unroll
            for (int kk = 0; kk < 4; ++kk) { float p[8];
#pragma unroll
                for (int hf = 0; hf < 2; ++hf) { const int st = 2 * kk + hf, s0 = 16 * st + 4 * fq;
                    if (st < J) { const f32x4 ev = *(const LAS f32x4*)(fb + 128 + s0);
#pragma unroll
                        for (int i = 0; i < 4; ++i) p[hf * 4 + i] = as[st][i] * __builtin_amdgcn_exp2f(bj + ev[i]); }
                    else if (st == J) { const f32x4 ev = *(const LAS f32x4*)(fb + 128 + s0);
#pragma unroll
                        for (int i = 0; i < 4; ++i) p[hf * 4 + i] = (4 * fq + i <= fr) ? as[st][i] * __builtin_amdgcn_exp2f(bj + ev[i]) : 0.f; }
                    else {
#pragma unroll
                        for (int i = 0; i < 4; ++i) p[hf * 4 + i] = 0.f; } }
                pf[kk] = pack_frag(p); }
            f32x4 num[5];
#pragma unroll
            for (int vt = 0; vt < 5; ++vt) num[vt] = (f32x4){0.f, 0.f, 0.f, 0.f};
            const float eend = __builtin_amdgcn_exp2f(fb[384]);
#pragma unroll
            for (int vt = 0; vt < 5; ++vt) accC[vt] = accC[vt] * eend;
            { const int tq = fr >> 2, tp = fr & 3;
              const LAS unsigned char* vb = lds + ML_VS + (4 * fq + tq) * (VP * 2) + 8 * tp;
              const LAS unsigned char* kb = lds + ML_KS + (4 * fq + tq) * (MP * 2) + 32 * wid + 8 * tp;
#pragma unroll
              for (int kk = 0; kk < 4; ++kk) {
                  bf16x8 vf[5];
#pragma unroll
                  for (int vt = 0; vt < 5; ++vt) vf[vt] = ld_tr8(vb + kk * 32 * (VP * 2) + 32 * vt, 16 * (VP * 2));
                  const bf16x8 kr = ld_tr8(kb + kk * 32 * (MP * 2), 16 * (MP * 2));
                  const f32x4 w0 = *(const LAS f32x4*)(fb + 256 + 32 * kk + 4 * fq), w1 = *(const LAS f32x4*)(fb + 256 + 32 * kk + 16 + 4 * fq);
                  float kf[8]; unpack8(__builtin_bit_cast(u32x4, kr), kf);
#pragma unroll
                  for (int e = 0; e < 4; ++e) { kf[e] *= w0[e]; kf[4 + e] *= w1[e]; }
                  const bf16x8 kw = pack_frag(kf);
#pragma unroll
                  for (int vt = 0; vt < 5; ++vt) accC[vt] = MFMA16(kw, vf[vt], accC[vt]);
                  if (2 * kk <= J) {
#pragma unroll
                      for (int vt = 0; vt < 5; ++vt) num[vt] = MFMA16(vf[vt], pf[kk], num[vt]); } } }
            const float ebj = __builtin_amdgcn_exp2f(bj);
#pragma unroll
            for (int v0 = 0; v0 < 5; v0 += 2) {
                bf16x8 cfr[2][4];
#pragma unroll
                for (int u = 0; u < 2; ++u) if (v0 + u < 5) {
#pragma unroll
                    for (int kk = 0; kk < 4; ++kk) cfr[u][kk] = ld_frag(Cb + (16 * (v0 + u) + fr) * MP + kk * 32 + fq * 8); }
                __builtin_amdgcn_sched_barrier(0);
                f32x4 ai[2] = {(f32x4){0.f, 0.f, 0.f, 0.f}, (f32x4){0.f, 0.f, 0.f, 0.f}};
#pragma unroll
                for (int kk = 0; kk < 4; ++kk)
#pragma unroll
                    for (int u = 0; u < 2; ++u) if (v0 + u < 5) ai[u] = MFMA16(cfr[u][kk], qf[kk], ai[u]);
#pragma unroll
                for (int u = 0; u < 2; ++u) if (v0 + u < 5) num[v0 + u] = num[v0 + u] + ai[u] * ebj; }
            const float den = __shfl(num[4][0], fr);
            const float inv = frcp(fmaxf(fabsf(den), 1.f));
            { LAS bf16_t* yb = (LAS bf16_t*)(lds + ML_YB) + jj * YP + 4 * fq;
#pragma unroll
              for (int vt = 0; vt < 4; ++vt) { const f32x4 o = num[vt] * inv; u32x2 w; w.x = pkbf(o[0], o[1]); w.y = pkbf(o[2], o[3]); *(LAS u32x2*)(yb + 16 * vt) = w; } }
            }
            lds_barrier();
#pragma unroll
            for (int vt = 0; vt < 5; ++vt) { u32x2 w; w.x = pkbf(accC[vt][0], accC[vt][1]); w.y = pkbf(accC[vt][2], accC[vt][3]);
                *(LAS u32x2*)(Cb + (16 * vt + fr) * MP + 16 * wid + 4 * fq) = w; }
            writeout(c);
            if (wid == 0 && c + 1 < 66) gates();
        }
        __syncthreads();
    }
}

constexpr int SS_BM = 0, SS_XS = 64 * MP * 2, SS_HB = SS_XS + 64 * VP * 2, SS_F = SS_HB + 64 * MP * 2;
constexpr int SS_STREAM = SS_F + 1024;
template <int SKIP = 0> DI void ssd_item(const Args& a, LAS unsigned char* lds, int item, const bf16_t* XC, const float* GD, bf16_t* YS) {
    const bool st_on = !(SKIP & 1) || (a.ph_hi < 0);
    const int tid = tid_op(), lane = tid & 63, wid = __builtin_amdgcn_readfirstlane(tid >> 6), fr = lane & 15, fq = lane >> 4;
    const int b = item >> 4, hd = item & 15, g = hd >> 3, dw = wid >> 2, jw = dw ? 3 - (wid & 3) : (wid & 3);
    const int jj = 16 * jw + fr;
    constexpr int YP = 68, SS_YB = 2 * SS_STREAM;
    const int orow = tid >> 3, opc = tid & 7;
    const float* palog = inp(I_ALOG); const float* pdtb = inp(I_DTB); const float dskip = inp(I_SSD)[hd];
    const int gd = wid & 1;
    const float acoef = -__expf(palog[gd * 16 + hd]), dtb = pdtb[gd * 16 + hd];
    f32x4 accH[2][4];
#pragma unroll
    for (int d = 0; d < 2; ++d) {
#pragma unroll
        for (int pt = 0; pt < 4; ++pt) accH[d][pt] = (f32x4){0.f, 0.f, 0.f, 0.f};
        LAS bf16_t* Hb = (LAS bf16_t*)(lds + d * SS_STREAM + SS_HB); for (int i = tid; i < 64 * MP; i += 512) Hb[i] = 0; }
    auto r0_of = [&](int c, int d) -> int { const bool isc = c < 4; const int cc = isc ? c : c - 4, n = isc ? TC : T, rbase = isc ? NL + b * TC : b * T; return rbase + (d == 0 ? cc * 64 : n - 1 - cc * 64); };
    u32x4 breg[2][2], xreg[2]; bf16x8 cn[4]; float draw = 0.f;
    const int srw = tid >> 3, spc = tid & 7;
    auto issue = [&](int c) {
#pragma unroll
        for (int d = 0; d < 2; ++d) { const int r0 = r0_of(c, d), sg = d == 0 ? 1 : -1;
            const bf16_t* pr = XC + (size_t)(r0 + sg * srw) * 1536;
            breg[d][0] = *(const u32x4*)(pr + 1024 + g * 128 + spc * 16); breg[d][1] = *(const u32x4*)(pr + 1024 + g * 128 + spc * 16 + 8); xreg[d] = *(const u32x4*)(pr + hd * 64 + spc * 8); }
        { const size_t jrow = (size_t)(r0_of(c, dw) + (dw == 0 ? 1 : -1) * jj);
#pragma unroll
          for (int kk = 0; kk < 4; ++kk) cn[kk] = *(const bf16x8*)(XC + jrow * 1536 + 1280 + g * 128 + kk * 32 + fq * 8); }
        if (wid < 2) draw = GD[(size_t)(r0_of(c, gd) + (gd == 0 ? 1 : -1) * lane) * 48 + 16 + gd * 16 + hd]; };
    auto gates = [&]() { LAS float* fs = (LAS float*)(lds + gd * SS_STREAM + SS_F);
        const float dtv = softplusf_(draw + dtb);
        const float s = wave_incl_scan(dtv * acoef);
        const float aend = rdlane(s, 63);
        fs[lane] = dtv; fs[64 + lane] = s * 1.4426950408889634f; fs[128 + lane] = __expf(aend - s);
        if (lane == 0) fs[192] = aend * 1.4426950408889634f; };
    u32x4 oldv[2];
    auto is_second = [&](int c) -> bool { return (c >= 68) || (c == 2) || (c == 3); };
    auto writeout = [&](int c) {
#pragma unroll
        for (int d = 0; d < 2; ++d) { const LAS bf16_t* yb = (const LAS bf16_t*)(lds + SS_YB + d * 64 * YP * 2) + orow * YP + opc * 8;
            const u32x2 lo = *(const LAS u32x2*)yb, hi = *(const LAS u32x2*)(yb + 4); u32x4 w; w.x = lo.x; w.y = lo.y; w.z = hi.x; w.w = hi.y;
            if (is_second(c)) { float f[8], o[8]; unpack8(w, f); unpack8(oldv[d], o);
#pragma unroll
                for (int j = 0; j < 8; ++j) f[j] += o[j];
                w = pack8(f); }
            if (st_on) *(u32x4*)(YS + (size_t)(r0_of(c, d) + (d == 0 ? 1 : -1) * orow) * 1024 + hd * 64 + opc * 8) = w; } };
    issue(0);
    if (wid < 2) gates();
    for (int c = 0; c < 132; ++c) {
        const bool second = is_second(c);
        const bool handoff = (c == 2) || (c == 68);
        if (handoff) __syncthreads(); else lds_barrier();
#pragma unroll
        for (int d = 0; d < 2; ++d) { LAS unsigned char* L = lds + d * SS_STREAM;
            LAS bf16_t* Bm = (LAS bf16_t*)(L + SS_BM); LAS bf16_t* Xs = (LAS bf16_t*)(L + SS_XS);
            if (!((SKIP & 2) && !st_on)) { *(LAS u32x4*)(Bm + srw * MP + spc * 16) = breg[d][0]; *(LAS u32x4*)(Bm + srw * MP + spc * 16 + 8) = breg[d][1]; *(LAS u32x4*)(Xs + srw * VP + spc * 8) = xreg[d]; } }
        bf16x8 cf[4];
#pragma unroll
        for (int kk = 0; kk < 4; ++kk) cf[kk] = cn[kk];
        lds_barrier();
        if (c + 1 < 132) issue(c + 1);
        if (second) {
#pragma unroll
            for (int d = 0; d < 2; ++d) oldv[d] = *(const u32x4*)(YS + (size_t)(r0_of(c, d) + (d == 0 ? 1 : -1) * orow) * 1024 + hd * 64 + opc * 8); }
#pragma unroll
        for (int d = 0; d < 2; ++d) { LAS unsigned char* L = lds + d * SS_STREAM;
            const LAS bf16_t* Bm = (const LAS bf16_t*)(L + SS_BM);
            const LAS bf16_t* Hb = (const LAS bf16_t*)(L + SS_HB); const LAS float* fs = (const LAS float*)(L + SS_F);
            const bool own = (d == dw) && !((SKIP & 4) && !st_on);
            bf16x8 mf[2] = {}; float acj = 0.f;
            if (own) {
            f32x4 ag[4];
#pragma unroll
            for (int st = 0; st < 4; ++st) ag[st] = (f32x4){0.f, 0.f, 0.f, 0.f};
#pragma unroll
            for (int sp = 0; sp < 4; sp += 2) {
                if (sp + 1 <= jw) { bf16x8 bfr[2][4];
#pragma unroll
                    for (int u = 0; u < 2; ++u)
#pragma unroll
                        for (int kk = 0; kk < 4; ++kk) bfr[u][kk] = ld_frag(Bm + (16 * (sp + u) + fr) * MP + kk * 32 + fq * 8);
                    __builtin_amdgcn_sched_barrier(0);
#pragma unroll
                    for (int kk = 0; kk < 4; ++kk)
#pragma unroll
                        for (int u = 0; u < 2; ++u) ag[sp + u] = MFMA16(bfr[u][kk], cf[kk], ag[sp + u]); }
                else if (sp <= jw) { bf16x8 bfr[4];
#pragma unroll
                    for (int kk = 0; kk < 4; ++kk) bfr[kk] = ld_frag(Bm + (16 * sp + fr) * MP + kk * 32 + fq * 8);
                    __builtin_amdgcn_sched_barrier(0);
#pragma unroll
                    for (int kk = 0; kk < 4; ++kk) ag[sp] = MFMA16(bfr[kk], cf[kk], ag[sp]); } }
            acj = fs[64 + jj];
#pragma unroll
            for (int kk = 0; kk < 2; ++kk) { float p[8];
#pragma unroll
                for (int hf = 0; hf < 2; ++hf) { const int st = 2 * kk + hf, s0 = 16 * st + 4 * fq;
                    if (st < jw) { const f32x4 av = *(const LAS f32x4*)(fs + 64 + s0), dv = *(const LAS f32x4*)(fs + s0);
#pragma unroll
                        for (int i = 0; i < 4; ++i) p[hf * 4 + i] = ag[st][i] * __builtin_amdgcn_exp2f(acj - av[i]) * dv[i]; }
                    else if (st == jw) { const f32x4 av = *(const LAS f32x4*)(fs + 64 + s0), dv = *(const LAS f32x4*)(fs + s0);
#pragma unroll
                        for (int i = 0; i < 4; ++i) p[hf * 4 + i] = (4 * fq + i <= fr) ? ag[st][i] * __builtin_amdgcn_exp2f(acj - av[i]) * dv[i] : 0.f; }
                    else {
#pragma unroll
                        for (int i = 0; i < 4; ++i) p[hf * 4 + i] = 0.f; } }
                mf[kk] = pack_frag(p); }
            }
            f32x4 ay[4];
#pragma unroll
            for (int pt = 0; pt < 4; ++pt) ay[pt] = (f32x4){0.f, 0.f, 0.f, 0.f};
            if (!((SKIP & 8) && !st_on)) { const float eend = __builtin_amdgcn_exp2f(fs[192]);
#pragma unroll
              for (int pt = 0; pt < 4; ++pt) accH[d][pt] = accH[d][pt] * eend;
              const int tq = fr >> 2, tp = fr & 3;
              const LAS unsigned char* xb = L + SS_XS + (4 * fq + tq) * (VP * 2) + 8 * tp;
              const LAS unsigned char* bb = L + SS_BM + (4 * fq + tq) * (MP * 2) + 32 * wid + 8 * tp;
#pragma unroll
              for (int ks = 0; ks < 2; ++ks) {
                  bf16x8 xf[4];
#pragma unroll
                  for (int pt = 0; pt < 4; ++pt) xf[pt] = ld_tr8(xb + ks * 32 * (VP * 2) + 32 * pt, 16 * (VP * 2));
                  const bf16x8 br = ld_tr8(bb + ks * 32 * (MP * 2), 16 * (MP * 2));
                  const int s0 = 32 * ks + 4 * fq;
                  const f32x4 d0 = *(const LAS f32x4*)(fs + s0), d1 = *(const LAS f32x4*)(fs + s0 + 16), e0 = *(const LAS f32x4*)(fs + 128 + s0), e1 = *(const LAS f32x4*)(fs + 128 + s0 + 16);
                  float bf[8]; unpack8(__builtin_bit_cast(u32x4, br), bf);
#pragma unroll
                  for (int e = 0; e < 4; ++e) { bf[e] *= d0[e] * e0[e]; bf[4 + e] *= d1[e] * e1[e]; }
                  const bf16x8 bw = pack_frag(bf);
#pragma unroll
                  for (int pt = 0; pt < 4; ++pt) accH[d][pt] = MFMA16(bw, xf[pt], accH[d][pt]);
                  if (own && 2 * ks <= jw) {
#pragma unroll
                      for (int pt = 0; pt < 4; ++pt) ay[pt] = MFMA16(xf[pt], mf[ks], ay[pt]); } } }
            if (own) { const float eaj = __builtin_amdgcn_exp2f(acj);
              const float dsk = (d == 0) ? dskip : 0.f;
              const LAS bf16_t* xrow = (const LAS bf16_t*)(L + SS_XS) + jj * VP + 4 * fq;
              LAS bf16_t* yb = (LAS bf16_t*)(lds + SS_YB + d * 64 * YP * 2) + jj * YP + 4 * fq;
              u32x2 wout[4];
#pragma unroll
              for (int p0 = 0; p0 < 4; p0 += 2) {
                  bf16x8 hfr[2][4]; u32x2 xr2[2];
#pragma unroll
                  for (int u = 0; u < 2; ++u) {
#pragma unroll
                      for (int kk = 0; kk < 4; ++kk) hfr[u][kk] = ld_frag(Hb + (16 * (p0 + u) + fr) * MP + kk * 32 + fq * 8);
                      xr2[u] = *(const LAS u32x2*)(xrow + 16 * (p0 + u)); }
                  __builtin_amdgcn_sched_barrier(0);
                  f32x4 ai[2] = {(f32x4){0.f, 0.f, 0.f, 0.f}, (f32x4){0.f, 0.f, 0.f, 0.f}};
#pragma unroll
                  for (int kk = 0; kk < 4; ++kk)
#pragma unroll
                      for (int u = 0; u < 2; ++u) ai[u] = MFMA16(hfr[u][kk], cf[kk], ai[u]);
#pragma unroll
                  for (int u = 0; u < 2; ++u) { const f32x4 o = ay[p0 + u] + ai[u] * eaj + (f32x4){bflo(xr2[u].x), bfhi(xr2[u].x), bflo(xr2[u].y), bfhi(xr2[u].y)} * dsk;
                      wout[p0 + u].x = pkbf(o[0], o[1]); wout[p0 + u].y = pkbf(o[2], o[3]); } }
#pragma unroll
              for (int ptile = 0; ptile < 4; ++ptile) *(LAS u32x2*)(yb + 16 * ptile) = wout[ptile]; }
        }
        lds_barrier();
#pragma unroll
        for (int d = 0; d < 2; ++d) { LAS bf16_t* Hb = (LAS bf16_t*)(lds + d * SS_STREAM + SS_HB);
#pragma unroll
            for (int pt = 0; pt < 4; ++pt) { u32x2 w; w.x = pkbf(accH[d][pt][0], accH[d][pt][1]); w.y = pkbf(accH[d][pt][2], accH[d][pt][3]);
                *(LAS u32x2*)(Hb + (16 * pt + fr) * MP + 16 * wid + 4 * fq) = w; } }
        writeout(c);
        if (wid < 2 && c + 1 < 132) gates();
    }
    __syncthreads();
}
DI void scan_phase(const Args& a, LAS unsigned char* lds, const bf16_t* QK, const bf16_t* V, const bf16_t* XC, const float* GD, bf16_t* HM, bf16_t* YS) {
#if defined(DBG_TRIVIAL_SCAN)
    const int tid = tid_op(), lane = tid & 63, wid = tid >> 6;
    for (int row = blockIdx.x * 8 + wid; row < NR; row += gridDim.x * 8) {
        for (int i = 0; i < 4; ++i) { *(u32x2*)(HM + (size_t)row * 1024 + i * 256 + lane * 4) = *(const u32x2*)(V + (size_t)row * 1024 + i * 256 + lane * 4);
                                      *(u32x2*)(YS + (size_t)row * 1024 + i * 256 + lane * 4) = *(const u32x2*)(XC + (size_t)row * 1536 + i * 256 + lane * 4); } }
#else
    for (int item = blockIdx.x; item < 256; item += gridDim.x) {
#if defined(DBG_NO_MLSTM)
        if (item < 128) { const int b = item >> 4, h = (item >> 2) & 3, vs = item & 3, tid = tid_op();
            for (int r = tid >> 3; r < T + TC; r += 64) { const size_t row = r < T ? (size_t)(b * T + r) : (size_t)(NL + b * TC + r - T); const int c = h * 256 + vs * 64 + (tid & 7) * 8;
                *(u32x4*)(HM + row * 1024 + c) = *(const u32x4*)(V + row * 1024 + c); } }
        else ssd_item(a, lds, item - 128, XC, GD, YS);
#elif defined(DBG_NO_SSD)
        if (item < 128) mlstm_item(a, lds, item, QK, V, GD, HM);
        else { const int b = (item - 128) >> 4, hd = (item - 128) & 15, tid = tid_op();
            for (int r = tid >> 3; r < T + TC; r += 64) { const size_t row = r < T ? (size_t)(b * T + r) : (size_t)(NL + b * TC + r - T); const int c = hd * 64 + (tid & 7) * 8;
                *(u32x4*)(YS + row * 1024 + c) = *(const u32x4*)(XC + row * 1536 + c); } }
#else
        if (item < 128) {
#if defined(DBG_ML_SKIP)
            mlstm_item<DBG_ML_SKIP>(a, lds, item, QK, V, GD, HM); __syncthreads();
#endif
            mlstm_item(a, lds, item, QK, V, GD, HM);
#if defined(DBG_DUP_ML)
            __syncthreads(); mlstm_item(a, lds, item, QK, V, GD, HM);
#endif
        } else {
#if defined(DBG_SSD_SKIP)
            ssd_item<DBG_SSD_SKIP>(a, lds, item - 128, XC, GD, YS); __syncthreads();
#endif
            ssd_item(a, lds, item - 128, XC, GD, YS);
#if defined(DBG_DUP_SSD)
            __syncthreads(); ssd_item(a, lds, item - 128, XC, GD, YS);
#endif
        }
#endif
        __syncthreads();
    }
#endif
}

struct PmRow { u32x2 hm[4], o[4], ys[4], z[4]; };
DI void pm_load(PmRow& d, int row, int lane, const bf16_t* HM, const bf16_t* YS, const bf16_t* XC, const bf16_t* OZ) {
    ld_row_raw(HM + (size_t)row * 1024, lane, d.hm); ld_row_raw(OZ + (size_t)row * 2048, lane, d.o); ld_row_raw(YS + (size_t)row * 1024, lane, d.ys);
    ld_row_raw(OZ + (size_t)row * 2048 + 1024, lane, d.z);
}
DI void post_mix_phase(const Args& a, const bf16_t* HM, const bf16_t* YS, const bf16_t* XC, bf16_t* OZ, unsigned char* OZ8) {
    const int tid_ = tid_op(), lane = tid_ & 63, wid = tid_ >> 6;
    const float* pmlng = inp(I_MLNG); const float* pssng = inp(I_SSNG);
    const int stride = gridDim.x * 8;
    int row = blockIdx.x * 8 + wid;
    PmRow cur;
    if (row < NR) pm_load(cur, row, lane, HM, YS, XC, OZ);
    for (; row < NR; row += stride) {
        PmRow nxt = cur; const int nr = row + stride;
        if (nr < NR) pm_load(nxt, nr, lane, HM, YS, XC, OZ);
        f32x4 hm[4], o[4], r[4], ys[4], z[4], u[4]; float sq[4];
        cvt_row(cur.hm, hm); cvt_row(cur.o, o); cvt_row(cur.ys, ys); cvt_row(cur.z, z);
#pragma unroll
        for (int i = 0; i < 4; ++i) { const float ms = wave_sum(hm[i][0] * hm[i][0] + hm[i][1] * hm[i][1] + hm[i][2] * hm[i][2] + hm[i][3] * hm[i][3]) * (1.f / 256.f);
            const float rs = rsqrtf(ms + RMS_EPS); const f32x4 g = *(const f32x4*)(pmlng + i * 256 + lane * 4);
#pragma unroll
            for (int j = 0; j < 4; ++j) r[i][j] = hm[i][j] * rs * g[j] * sigmoidf_(o[i][j]); }
        if (MK_F8_OUT0) st_row_f8(OZ8 + (size_t)row * 2048, lane, r); else st_row_bf16(OZ + (size_t)row * 2048, lane, r);
#pragma unroll
        for (int i = 0; i < 4; ++i) {
#pragma unroll
            for (int j = 0; j < 4; ++j) u[i][j] = ys[i][j] * siluf_(z[i][j]);
            sq[i] = wave_sum(u[i][0] * u[i][0] + u[i][1] * u[i][1] + u[i][2] * u[i][2] + u[i][3] * u[i][3]); }
#pragma unroll
        for (int i = 0; i < 4; ++i) { const float rs = rsqrtf((sq[i & 2] + sq[(i & 2) + 1]) * (1.f / 512.f) + RMS_EPS); const f32x4 g = *(const f32x4*)(pssng + i * 256 + lane * 4);
            u[i] = u[i] * rs * g; }
        if (MK_F8_OUT0) st_row_f8(OZ8 + (size_t)row * 2048 + 1024, lane, u); else st_row_bf16(OZ + (size_t)row * 2048 + 1024, lane, u);
        cur = nxt;
    }
}

DI void post_attn_phase(const Args& a, LAS unsigned char* lds, int layer, int nrows, const bf16_t* OL, unsigned char* H2, const bf16_t* XBin, bf16_t* XBout) {
    LAS float* rw = (LAS float*)lds;
    const int tid = tid_op(), lane = tid & 63, wid = tid >> 6;
    { const float* pr = inp(I_ROUTER) + (size_t)layer * 1024 * 16; for (int i = tid; i < 1024 * 16; i += 512) rw[(i & 15) * 1024 + (i >> 4)] = pr[i]; }
    __syncthreads();
    const float* ng = inp(I_NORMG) + (size_t)layer * 4 * 1024; const float* px = inp(I_X); const float* pctx = inp(I_CTX);
    float* aff = (float*)(a.ws + WS_AFF); int* slot = (int*)(a.ws + WS_SLOT); float* ctxs = (float*)(a.ws + WS_CTXS);
    const int stride = gridDim.x * 8;
    int row = blockIdx.x * 8 + wid;
    f32x4 x[4]; u32x2 oraw[4];
    auto ldx = [&](int r, f32x4 (&d)[4]) { if (layer == 0) ld_row_f32(r < NL ? px + (size_t)r * 1024 : pctx + (size_t)(r - NL) * 1024, lane, d); else ld_row_bf16(XBin + (size_t)r * 1024, lane, d); };
    if (row < nrows) { ldx(row, x); ld_row_raw(OL + (size_t)row * 1024, lane, oraw); }
    for (; row < nrows; row += stride) {
        const int s = row_mod_s(row), nr = row + stride;
        f32x4 xn[4], o[4], h[4]; u32x2 on[4];
#pragma unroll
        for (int i = 0; i < 4; ++i) { xn[i] = x[i]; on[i] = oraw[i]; }
        if (nr < nrows) { ldx(nr, xn); ld_row_raw(OL + (size_t)nr * 1024, lane, on); }
        cvt_row(oraw, o);
        const float rs = rsqrtf(wave_sum(sumsq4(o)) * (1.f / 1024.f) + RMS_EPS);
        const float* gm = modp(a, layer, s, 2);
#pragma unroll
        for (int i = 0; i < 4; ++i) { const int c = i * 256 + lane * 4; const f32x4 g = *(const f32x4*)(ng + 1024 + c), gt = *(const f32x4*)(gm + c);
            x[i] = x[i] + gt * (o[i] * rs * g); }
        if (row < NL) st_row_bf16(XBout + (size_t)row * 1024, lane, x); else {
#pragma unroll
            for (int i = 0; i < 4; ++i) *(f32x4*)(ctxs + (size_t)(row - NL) * 1024 + i * 256 + lane * 4) = x[i]; }
        norm_mod(x, ng + 2048, modp(a, layer, s, 3), modp(a, layer, s, 4), lane, h);
        { unsigned char* hp = H2 + (size_t)row * 1024;
#pragma unroll
          for (int i = 0; i < 4; ++i) *(unsigned*)(hp + i * 256 + lane * 4) = pk_fp8x4(h[i][0] * F8_HID, h[i][1] * F8_HID, h[i][2] * F8_HID, h[i][3] * F8_HID); }
        float lg[16];
#pragma unroll
        for (int e = 0; e < 16; ++e) lg[e] = 0.f;
#pragma unroll
        for (int e = 0; e < 16; ++e) {
#pragma unroll
            for (int i = 0; i < 4; ++i) { const f32x4 w = *(const LAS f32x4*)(rw + e * 1024 + i * 256 + lane * 4); lg[e] += (h[i][0] * w[0] + h[i][1] * w[1]) + (h[i][2] * w[2] + h[i][3] * w[3]); }
            if ((e & 3) == 3) asm volatile("" ::: "memory"); }
        float l8[8], l4[4];
#pragma unroll
        for (int i = 0; i < 8; ++i) { const u32x2_t r = __builtin_amdgcn_permlane32_swap(__float_as_uint(lg[i]), __float_as_uint(lg[8 + i]), false, false); l8[i] = __uint_as_float(r[0]) + __uint_as_float(r[1]); }
#pragma unroll
        for (int i = 0; i < 4; ++i) { const u32x2_t r = __builtin_amdgcn_permlane16_swap(__float_as_uint(l8[i]), __float_as_uint(l8[4 + i]), false, false); l4[i] = row16_sum(__uint_as_float(r[0]) + __uint_as_float(r[1])); }
        const float mx = xrow_max(fmaxf(fmaxf(l4[0], l4[1]), fmaxf(l4[2], l4[3])));
        float pe4[4];
#pragma unroll
        for (int i = 0; i < 4; ++i) pe4[i] = __expf(l4[i] - mx);
        const float sum = xrow_sum((pe4[0] + pe4[1]) + (pe4[2] + pe4[3]));
        if ((lane & 15) < 4) { const int ex = ((lane >> 5) & 1) * 8 + ((lane >> 4) & 1) * 4 + (lane & 3);
            const float pe = (lane & 2) ? ((lane & 1) ? pe4[3] : pe4[2]) : ((lane & 1) ? pe4[1] : pe4[0]);
            aff[(size_t)row * 16 + ex] = pe / sum; slot[(size_t)row * 16 + ex] = -1; }
#pragma unroll
        for (int i = 0; i < 4; ++i) { x[i] = xn[i]; oraw[i] = on[i]; }
    }
    __syncthreads();
}

DI void topk_item(const Args& a, LAS unsigned char* lds, int item, int rpe, const unsigned char* H2, unsigned char* XG) {
    LAS unsigned* keys = (LAS unsigned*)lds;
    LAS unsigned* hist = keys + 8192;
    LAS unsigned* wsum = hist + 256;
    LAS unsigned* misc = wsum + 8;
    LAS int* sel = (LAS int*)(misc + 8);
    const int tid = tid_op(), lane = tid & 63, wid = tid >> 6;
    const bool lat = item < 128; const int it = lat ? item : item - 128, b = it >> 4, e = it & 15;
    const int n = lat ? T : TC, cap = lat ? 1024 : 32, rbase = lat ? b * T : NL + b * TC;
    const float* aff = (const float*)(a.ws + WS_AFF); int* slot = (int*)(a.ws + WS_SLOT); float* gate = (float*)(a.ws + WS_GATE);
    for (int i = tid; i < n; i += 512) keys[i] = __float_as_uint(aff[(size_t)(rbase + i) * 16 + e]);
    unsigned prefix = 0u, mask = 0u, need = (unsigned)cap;
    for (int pass = 0; pass < 4; ++pass) {
        const int shift = 24 - 8 * pass;
        if (tid < 256) hist[tid] = 0u;
        __syncthreads();
        for (int i = tid; i < n; i += 512) { const unsigned k = keys[i]; if ((k & mask) == prefix) __hip_atomic_fetch_add(hist + ((k >> shift) & 255u), 1u, __ATOMIC_RELAXED, __HIP_MEMORY_SCOPE_WORKGROUP); }
        __syncthreads();
        if (wid == 0) {
            const u32x4 hc = *(const LAS u32x4*)(hist + 4 * lane); const unsigned tot = hc.x + hc.y + hc.z + hc.w;
            unsigned suf = tot;
#pragma unroll
            for (int o = 1; o < 64; o <<= 1) { const unsigned t = __shfl_down(suf, o); if (lane + o < 64) suf += t; }
            const unsigned long long bal = __ballot(suf >= need); const int ls = 63 - __builtin_clzll(bal);
            if (lane == ls) { unsigned nd = need - (suf - tot); int bin;
                if (hc.w >= nd) bin = 3; else { nd -= hc.w; if (hc.z >= nd) bin = 2; else { nd -= hc.z; if (hc.y >= nd) bin = 1; else { nd -= hc.y; bin = 0; } } }
                misc[0] = (unsigned)(4 * lane + bin); misc[1] = nd; } }
        __syncthreads();
        prefix |= misc[0] << shift; mask |= 0xffu << shift; need = misc[1];
        __syncthreads();
    }
    const int per = lat ? 16 : 1, i0 = tid * per; const bool act = i0 < n;
    unsigned cnt = 0u;
    if (act) for (int j = 0; j < per; ++j) { const unsigned k = keys[i0 + j]; cnt += (k > prefix ? 1u : 0u) + (k == prefix ? 0x10000u : 0u); }
    unsigned inc = cnt;
#pragma unroll
    for (int o = 1; o < 64; o <<= 1) { const unsigned t = __shfl_up(inc, o); if (lane >= o) inc += t; }
    if (lane == 63) wsum[wid] = inc;
    __syncthreads();
    unsigned base = 0u;
    for (int w = 0; w < wid; ++w) base += wsum[w];
    unsigned ex = base + inc - cnt;
    if (act) for (int j = 0; j < per; ++j) { const unsigned k = keys[i0 + j]; const unsigned gtb = ex & 0xffffu, eqb = ex >> 16;
        const bool take = (k > prefix) || (k == prefix && eqb < need);
        if (take) { const int s = (int)(gtb + (eqb < need ? eqb : need)); const int tok = i0 + j, erow = lat ? b * 1024 + s : 8192 + b * 32 + s;
            sel[s] = tok; gate[(size_t)e * rpe + erow] = __uint_as_float(k); slot[(size_t)(rbase + tok) * 16 + e] = erow; }
        ex += (k > prefix ? 1u : 0u) + (k == prefix ? 0x10000u : 0u); }
    __syncthreads();
    const int sub = tid >> 6, c16 = tid & 63;
    for (int r0 = sub; r0 < cap; r0 += 32) {
        u32x4 v[4];
#pragma unroll
        for (int q = 0; q < 4; ++q) { const int r = r0 + 8 * q; if (r < cap) v[q] = *(const u32x4*)(H2 + (size_t)(rbase + sel[r]) * 1024 + c16 * 16); }
#pragma unroll
        for (int q = 0; q < 4; ++q) { const int r = r0 + 8 * q; if (r < cap) { const int erow = lat ? b * 1024 + r : 8192 + b * 32 + r; *(u32x4*)(XG + ((size_t)e * rpe + erow) * 1024 + c16 * 16) = v[q]; } }
    }
    __syncthreads();
}

DI void combine_phase(const Args& a, int layer, int nrows, int rpe, const bf16_t* Y, bf16_t* HS, bf16_t* XB) {
    const int tid_ = tid_op(), lane = tid_ & 63, wid = tid_ >> 6;
    const int* slot = (const int*)(a.ws + WS_SLOT); float* ctxs = (float*)(a.ws + WS_CTXS);
    const float* ng0 = inp(I_NORMG); const float* ng = ng0 + (size_t)layer * 4 * 1024;
    const int stride = gridDim.x * 8;
    int row = blockIdx.x * 8 + wid;
    auto ldx = [&](int r, f32x4 (&d)[4]) { if (r < NL) ld_row_bf16(XB + (size_t)r * 1024, lane, d); else ld_row_f32(ctxs + (size_t)(r - NL) * 1024, lane, d); };
    int sl = -1; f32x4 x[4];
    if (row < nrows) { sl = slot[(size_t)row * 16 + (lane & 15)]; ldx(row, x); }
    for (; row < nrows; row += stride) {
        const int s = row_mod_s(row), nr = row + stride;
        f32x4 m[4];
#pragma unroll
        for (int i = 0; i < 4; ++i) m[i] = (f32x4){0.f, 0.f, 0.f, 0.f};
#pragma unroll
        for (int e = 0; e < 16; ++e) { const int se = __builtin_amdgcn_readlane(sl, e);
            if (se >= 0) { f32x4 y[4]; ld_row_bf16(Y + ((size_t)e * rpe + se) * 1024, lane, y);
#pragma unroll
                for (int i = 0; i < 4; ++i) m[i] = m[i] + y[i]; } }
        int sln = sl; f32x4 xn[4];
#pragma unroll
        for (int i = 0; i < 4; ++i) xn[i] = x[i];
        if (nr < nrows) { sln = slot[(size_t)nr * 16 + (lane & 15)]; ldx(nr, xn); }
        const float rs = rsqrtf(wave_sum(sumsq4(m)) * (1.f / 1024.f) + RMS_EPS);
        const float* gm = modp(a, layer, s, 5);
#pragma unroll
        for (int i = 0; i < 4; ++i) { const int c = i * 256 + lane * 4; const f32x4 g = *(const f32x4*)(ng + 3072 + c), gt = *(const f32x4*)(gm + c);
            x[i] = x[i] + gt * (m[i] * rs * g); }
        if (layer == 1) {
#pragma unroll
            for (int i = 0; i < 4; ++i) *(f32x4*)(a.out + (size_t)row * 1024 + i * 256 + lane * 4) = x[i]; }
        else if (row < NL) st_row_bf16(XB + (size_t)row * 1024, lane, x);
        else {
#pragma unroll
            for (int i = 0; i < 4; ++i) *(f32x4*)(ctxs + (size_t)(row - NL) * 1024 + i * 256 + lane * 4) = x[i]; }
        if (layer == 0) { f32x4 h[4]; norm_mod(x, ng0 + 4096, modp(a, 1, s, 0), modp(a, 1, s, 1), lane, h);
#pragma unroll
            for (int i = 0; i < 4; ++i) { u32x2 w; w.x = pkbf(h[i][0], h[i][1]); w.y = pkbf(h[i][2], h[i][3]); *(u32x2*)(HS + (size_t)row * 2048 + i * 256 + lane * 4) = w; } }
        sl = sln;
#pragma unroll
        for (int i = 0; i < 4; ++i) x[i] = xn[i];
    }
}
DI void mix_phase(bf16_t* HS, bf16_t* XM) {
    const int tid_ = tid_op(), lane = tid_ & 63, wid = tid_ >> 6;
    const float* mu = inp(I_MU);
    f32x4 mr[4], mk[4], mv[4];
#pragma unroll
    for (int i = 0; i < 4; ++i) { const int c = i * 256 + lane * 4; mr[i] = *(const f32x4*)(mu + c); mk[i] = *(const f32x4*)(mu + 2 * 1024 + c); mv[i] = *(const f32x4*)(mu + 3 * 1024 + c); }
    for (int row = blockIdx.x * 8 + wid; row < NR; row += gridDim.x * 8) {
        const int t = row < NL ? (row & (T - 1)) : ((row - NL) & (TC - 1)), n = row < NL ? T : TC;
        const bool first = t == 0, last = t == n - 1;
        u32x2 p[4], q[4], hh[4];
#pragma unroll
        for (int i = 0; i < 4; ++i) { const int c = i * 256 + lane * 4; p[i] = (u32x2){0u, 0u}; q[i] = (u32x2){0u, 0u};
            if (!first) p[i] = *(const u32x2*)(HS + (size_t)(row - 1) * 2048 + c);
            if (!last) q[i] = *(const u32x2*)(HS + (size_t)(row + 1) * 2048 + c);
            hh[i] = *(const u32x2*)(HS + (size_t)row * 2048 + c); }
#pragma unroll
        for (int i = 0; i < 4; ++i) { const int c = i * 256 + lane * 4;
            const f32x4 h = (f32x4){bflo(hh[i].x), bfhi(hh[i].x), bflo(hh[i].y), bfhi(hh[i].y)};
            const f32x4 sh = (f32x4){0.5f * (bflo(p[i].x) + bflo(q[i].x)), 0.5f * (bfhi(p[i].x) + bfhi(q[i].x)), 0.5f * (bflo(p[i].y) + bflo(q[i].y)), 0.5f * (bfhi(p[i].y) + bfhi(q[i].y))};
            const f32x4 xx = sh - h, xr = h + xx * mr[i], xk = h + xx * mk[i], xv = h + xx * mv[i];
            u32x2 w; w.x = pkbf(sh[0], sh[1]); w.y = pkbf(sh[2], sh[3]); *(u32x2*)(HS + (size_t)row * 2048 + 1024 + c) = w;
            if (MK_F8_RKV) { unsigned char* xb = (unsigned char*)XM + (size_t)row * 1024 + c;
                *(unsigned*)xb = pk_fp8x4(xr[0] * F8_ACT, xr[1] * F8_ACT, xr[2] * F8_ACT, xr[3] * F8_ACT);
                *(unsigned*)(xb + USZ) = pk_fp8x4(xk[0] * F8_ACT, xk[1] * F8_ACT, xk[2] * F8_ACT, xk[3] * F8_ACT);
                *(unsigned*)(xb + 2 * USZ) = pk_fp8x4(xv[0] * F8_ACT, xv[1] * F8_ACT, xv[2] * F8_ACT, xv[3] * F8_ACT); }
            else {
            w.x = pkbf(xr[0], xr[1]); w.y = pkbf(xr[2], xr[3]); *(u32x2*)(XM + (size_t)row * 1024 + c) = w;
            w.x = pkbf(xk[0], xk[1]); w.y = pkbf(xk[2], xk[3]); *(u32x2*)(XM + (USZ / 2) + (size_t)row * 1024 + c) = w;
            w.x = pkbf(xv[0], xv[1]); w.y = pkbf(xv[2], xv[3]); *(u32x2*)(XM + 2 * (USZ / 2) + (size_t)row * 1024 + c) = w; } }
    }
}

struct EpiRw1 {
    static constexpr bool PERM = true; static constexpr bool SPLIT = MK_SPLIT; static constexpr int NST = 16; DI bool counted(const Unit& u) const { return true; }
    bf16_t *L1, *L2;
    DI void operator()(const f32x4 (&acc)[2][2][4][2], const Unit& u, int wr, int wc, int fr, int fq) const { half<0>(acc, u, wr, wc, fr, fq); half<1>(acc, u, wr, wc, fr, fq); }
    template <int ai> DI void half(const f32x4 (&acc)[2][2][4][2], const Unit& u, int wr, int wc, int fr, int fq) const {
        const int row0 = u.pm * 256 + wr * 64 + fr, pn = u.pn + 12, cl = wc * 32 + 8 * fq;
        {
#pragma unroll
            for (int m = 0; m < 4; ++m) { const size_t row = (size_t)(row0 + ai * 128 + m * 16);
#pragma unroll
                for (int bj = 0; bj < 2; ++bj) { f32x4 v0 = acc[ai][bj][m][0], v1 = acc[ai][bj][m][1]; bf16_t* dst;
                    if (pn == 12) { dst = L1 + row * 256 + bj * 128 + cl;
                        if (bj == 0) {
#pragma unroll
                            for (int j = 0; j < 4; ++j) { v0[j] = tanhf_(v0[j]); v1[j] = tanhf_(v1[j]); } } }
                    else { dst = L2 + row * 256 + bj * 128 + cl;
#pragma unroll
                        for (int j = 0; j < 4; ++j) { v0[j] = sigmoidf_(v0[j]); v1[j] = sigmoidf_(v1[j]); } }
                    *(u32x4*)dst = pack_acc(v0, v1); } }
        }
    }
};
struct EpiRw2 {
    static constexpr bool PERM = true; static constexpr bool SPLIT = false; static constexpr int NST = 16; DI bool counted(const Unit& u) const { return true; }
    bf16_t* LWA; const float* w0; const float* a0;
    DI void operator()(const f32x4 (&acc)[2][2][4][2], const Unit& u, int wr, int wc, int fr, int fq) const {
        const int row0 = u.pm * 256 + wr * 64 + fr, pn = u.pn;
        const float sc = pn < 8 ? -0.60653065971263342f : 1.f;
#pragma unroll
        for (int bj = 0; bj < 2; ++bj) { const int c = pn * 256 + bj * 128 + wc * 32 + 8 * fq;
            const float* bp = pn < 8 ? w0 + c : a0 + (c - 2048);
            const f32x4 b0 = *(const f32x4*)bp, b1 = *(const f32x4*)(bp + 4);
#pragma unroll
            for (int ai = 0; ai < 2; ++ai)
#pragma unroll
                for (int m = 0; m < 4; ++m) { f32x4 v0 = acc[ai][bj][m][0] + b0, v1 = acc[ai][bj][m][1] + b1;
#pragma unroll
                    for (int j = 0; j < 4; ++j) { v0[j] = sc * sigmoidf_(v0[j]); v1[j] = sc * sigmoidf_(v1[j]); }
                    *(u32x4*)(LWA + (size_t)(row0 + ai * 128 + m * 16) * 3072 + c) = pack_acc(v0, v1); } }
    }
};

DI float grp16_sum(float v) { return row16_sum(v); }

constexpr int RC_AT = 0, RC_RT = 2304, RC_NAK = 4608, RC_TIN = 5120, RC_MBR = 5632, RC_MKR = 6144, RC_BT = 6656, RC_KT = 9216, RC_VT = 11776, RC_GAM = 14336, RC_BN = 14592, RC_KN = 16896, RC_SLOT = 19200;
template <int N> DI float ror_add(float x) { const int y = __builtin_amdgcn_update_dpp(0, __float_as_int(x), 0x120 + N, 0xf, 0xf, false); return x + __int_as_float(y); }
DI float grp16_allsum(float x) { x = ror_add<8>(x); x = ror_add<4>(x); x = ror_add<2>(x); x = ror_add<1>(x); return x; }
DI bf16x8 mk_frag(const u32x2 lo, const u32x2 hi) { u32x4 w; w.x = lo.x; w.y = lo.y; w.z = hi.x; w.w = hi.y; return __builtin_bit_cast(bf16x8, w); }
DI float rdl(float x, int l) { return __int_as_float(__builtin_amdgcn_readlane(__float_as_int(x), l)); }
DI void rwkv_scan_item(LAS unsigned char* lds, int item, const bf16_t* Rm, const bf16_t* Km, const bf16_t* Vm, bf16_t* LWA, float* BON, int mode) {
    const bool dry = mode != 0;
    const int tid = tid_op(), lane = tid & 63, wid = __builtin_amdgcn_readfirstlane(tid >> 6), fr = lane & 15, fq = lane >> 4;
    const int b = item >> 5, h = (item >> 1) & 15, dir = item & 1;
    auto row_of = [&](int p) -> size_t { return p < TC ? (size_t)(NL + b * TC + (dir == 0 ? p : TC - 1 - p)) : (size_t)(b * T + (dir == 0 ? p - TC : T - 1 - (p - TC))); };
    constexpr int NGRP = (TC + T) / 64;
    const u32x2 z2 = (u32x2){0u, 0u};
    LAS unsigned* acnt = (LAS unsigned*)(lds + 8 * RC_SLOT);
    if (tid == 0) *acnt = 0u;
    if (wid >= 4) {
        const int j = wid - 4, pt = lane & 15, cq = lane >> 4;
        float kkw[16], kaw[16], rkw[16];
        { const float* pkk = inp(I_KK) + h * 64 + 16 * cq; const float* pka = inp(I_KA) + h * 64 + 16 * cq; const float* prk = inp(I_RK) + h * 64 + 16 * cq;
#pragma unroll
          for (int i = 0; i < 16; i += 4) { const f32x4 a4 = *(const f32x4*)(pkk + i), b4 = *(const f32x4*)(pka + i), c4 = *(const f32x4*)(prk + i);
#pragma unroll
              for (int q = 0; q < 4; ++q) { kkw[i + q] = a4[q]; kaw[i + q] = b4[q]; rkw[i + q] = c4[q]; } } }
        u32x4 raw[5][2];
        auto issue = [&](int g) { const size_t row = row_of(16 * (4 * g + j) + pt); const size_t ro = row * 1024 + h * 64 + 16 * cq; const bf16_t* pl = LWA + row * 3072 + h * 64 + 16 * cq;
#pragma unroll
            for (int q = 0; q < 2; ++q) { raw[0][q] = *(const u32x4*)(Rm + ro + 8 * q); raw[1][q] = *(const u32x4*)(Km + ro + 8 * q); raw[2][q] = *(const u32x4*)(Vm + ro + 8 * q);
                                          raw[3][q] = *(const u32x4*)(pl + dir * 1024 + 8 * q); raw[4][q] = *(const u32x4*)(pl + 2048 + 8 * q); } };
        auto prep = [&](int g) {
            LAS unsigned char* sl = lds + (((g & 1) * 4 + j) * RC_SLOT);
            LAS bf16_t* At = (LAS bf16_t*)(sl + RC_AT); LAS bf16_t* Rt = (LAS bf16_t*)(sl + RC_RT); LAS bf16_t* BT = (LAS bf16_t*)(sl + RC_BT); LAS bf16_t* KT = (LAS bf16_t*)(sl + RC_KT); LAS bf16_t* VT = (LAS bf16_t*)(sl + RC_VT);
            LAS bf16_t* Bn = (LAS bf16_t*)(sl + RC_BN); LAS bf16_t* Kn = (LAS bf16_t*)(sl + RC_KN);
            float fr_[16], fk[16], fl[16], fa[16]; u32x4 vraw[2] = {raw[2][0], raw[2][1]};
            unpack8(raw[0][0], *(float(*)[8])&fr_[0]); unpack8(raw[0][1], *(float(*)[8])&fr_[8]); unpack8(raw[1][0], *(float(*)[8])&fk[0]); unpack8(raw[1][1], *(float(*)[8])&fk[8]);
            unpack8(raw[3][0], *(float(*)[8])&fl[0]); unpack8(raw[3][1], *(float(*)[8])&fl[8]); unpack8(raw[4][0], *(float(*)[8])&fa[0]); unpack8(raw[4][1], *(float(*)[8])&fa[8]);
            const size_t rowb = row_of(16 * (4 * g + j) + pt); float bs = 0.f;
            if (g + 1 < NGRP) issue(g + 1);
            float kk[16], ss = 0.f;
#pragma unroll
            for (int i = 0; i < 16; ++i) { kk[i] = fk[i] * kkw[i]; ss += kk[i] * kk[i]; }
            ss = xrow_sum(ss);
            const float rn = rsqrtf(ss + 1e-12f);
            float at[16], rt[16], bt[16], kt[16], cc[16], ec[16];
#pragma unroll
            for (int i = 0; i < 16; ++i) cc[i] = fl[i] + __int_as_float(__builtin_amdgcn_update_dpp(0, __float_as_int(fl[i]), 0x111, 0xf, 0xf, true));
#pragma unroll
            for (int i = 0; i < 16; ++i) cc[i] += __int_as_float(__builtin_amdgcn_update_dpp(0, __float_as_int(cc[i]), 0x112, 0xf, 0xf, true));
#pragma unroll
            for (int i = 0; i < 16; ++i) cc[i] += __int_as_float(__builtin_amdgcn_update_dpp(0, __float_as_int(cc[i]), 0x114, 0xf, 0xf, true));
#pragma unroll
            for (int i = 0; i < 16; ++i) cc[i] += __int_as_float(__builtin_amdgcn_update_dpp(0, __float_as_int(cc[i]), 0x118, 0xf, 0xf, true));
#pragma unroll
            for (int i = 0; i < 16; ++i) ec[i] = __expf(cc[i]);
#pragma unroll
            for (int i = 0; i < 16; ++i) {
                const float einv = __expf(-cc[i]);
                float eprev = __int_as_float(__builtin_amdgcn_update_dpp(0, __float_as_int(ec[i]), 0x111, 0xf, 0xf, true)); eprev = pt == 0 ? 1.f : eprev;
                const float kn = kk[i] * rn, kp = fk[i] * ((fa[i] - 1.f) * kaw[i] + 1.f); bs += fr_[i] * kp * rkw[i];
                at[i] = -kn * eprev; rt[i] = fr_[i] * ec[i]; bt[i] = kn * fa[i] * einv; kt[i] = kp * einv; }
            bs = xrow_sum(bs);
            if (!dry && dir == 0 && cq == 0) BON[rowb * 16 + h] = bs;
            if (pt == 15) {
#pragma unroll
                for (int i = 0; i < 16; i += 4) *(LAS f32x4*)(sl + RC_GAM + (16 * cq + i) * 4) = (f32x4){ec[i], ec[i + 1], ec[i + 2], ec[i + 3]}; }
            { u32x4 w0, w1;
#define RC_PK16(src) w0.x = pkbf(src[0], src[1]); w0.y = pkbf(src[2], src[3]); w0.z = pkbf(src[4], src[5]); w0.w = pkbf(src[6], src[7]); w1.x = pkbf(src[8], src[9]); w1.y = pkbf(src[10], src[11]); w1.z = pkbf(src[12], src[13]); w1.w = pkbf(src[14], src[15]);
              RC_PK16(at) *(LAS u32x4*)(At + pt * 72 + 16 * cq) = w0; *(LAS u32x4*)(At + pt * 72 + 16 * cq + 8) = w1;
              RC_PK16(rt) *(LAS u32x4*)(Rt + pt * 72 + 16 * cq) = w0; *(LAS u32x4*)(Rt + pt * 72 + 16 * cq + 8) = w1;
              RC_PK16(bt) *(LAS u32x4*)(Bn + pt * 72 + 16 * cq) = w0; *(LAS u32x4*)(Bn + pt * 72 + 16 * cq + 8) = w1;
              RC_PK16(kt) *(LAS u32x4*)(Kn + pt * 72 + 16 * cq) = w0; *(LAS u32x4*)(Kn + pt * 72 + 16 * cq + 8) = w1;
              *(LAS u32x4*)(VT + pt * 72 + 16 * cq) = vraw[0]; *(LAS u32x4*)(VT + pt * 72 + 16 * cq + 8) = vraw[1];
#undef RC_PK16
            }
        };
        issue(0);
        prep(0);
        lds_barrier();
        for (int g = 0; g < NGRP; ++g) { if (g + 1 < NGRP && mode != 3) prep(g + 1); lds_barrier();   }
    } else {
        f32x4 st[4];
#pragma unroll
        for (int kt = 0; kt < 4; ++kt) st[kt] = (f32x4){0.f, 0.f, 0.f, 0.f};
        lds_barrier();
        for (int g = 0; g < NGRP; ++g) {
            if (mode != 2) {
                LAS unsigned char* sl = lds + (((g & 1) * 4 + wid) * RC_SLOT);
                const LAS bf16_t* At = (const LAS bf16_t*)(sl + RC_AT); const LAS bf16_t* Rt = (const LAS bf16_t*)(sl + RC_RT); LAS bf16_t* Bn = (LAS bf16_t*)(sl + RC_BN); const LAS bf16_t* Kn = (const LAS bf16_t*)(sl + RC_KN);
            f32x4 nab = (f32x4){0.f, 0.f, 0.f, 0.f}, nak = nab, mbr = nab, mkr = nab;
#pragma unroll
            for (int s2 = 0; s2 < 2; ++s2) { const bf16x8 fb_ = ld_frag(Bn + fr * 72 + 32 * s2 + 8 * fq), fk_ = ld_frag(Kn + fr * 72 + 32 * s2 + 8 * fq), fa_ = ld_frag(At + fr * 72 + 32 * s2 + 8 * fq), fr2 = ld_frag(Rt + fr * 72 + 32 * s2 + 8 * fq);
                nab = MFMA16(fb_, fa_, nab); nak = MFMA16(fk_, fa_, nak); mbr = MFMA16(fb_, fr2, mbr); mkr = MFMA16(fk_, fr2, mkr); }
#pragma unroll
            for (int jj = 0; jj < 4; ++jj) { const int i = 4 * fq + jj; if (!(i < fr)) { nab[jj] = 0.f; nak[jj] = 0.f; } if (!(i <= fr)) { mbr[jj] = 0.f; mkr[jj] = 0.f; } }
            { u32x2 w; w.x = pkbf(nak[0], nak[1]); w.y = pkbf(nak[2], nak[3]); *(LAS u32x2*)(sl + RC_NAK + fr * 32 + 8 * fq) = w;
              w.x = pkbf(mbr[0], mbr[1]); w.y = pkbf(mbr[2], mbr[3]); *(LAS u32x2*)(sl + RC_MBR + fr * 32 + 8 * fq) = w;
              w.x = pkbf(mkr[0], mkr[1]); w.y = pkbf(mkr[2], mkr[3]); *(LAS u32x2*)(sl + RC_MKR + fr * 32 + 8 * fq) = w; }
            LAS float* nf = (LAS float*)(sl + RC_BT);
            *(LAS f32x4*)(nf + fr * 16 + 4 * fq) = nab;
            float rw_[16];
#pragma unroll
            for (int t = 0; t < 16; ++t) { float acc0 = (fr == t) ? 1.f : 0.f, acc1 = 0.f;
#pragma unroll
                for (int i4 = 0; i4 < (t + 3) / 4; ++i4) { const f32x4 cf = *(const LAS f32x4*)(nf + t * 16 + 4 * i4);
#pragma unroll
                    for (int jj = 0; jj < 4; ++jj) { const int i = 4 * i4 + jj; if (i < t) { if (jj & 1) acc1 += cf[jj] * rw_[i]; else acc0 += cf[jj] * rw_[i]; } } }
                rw_[t] = acc0 + acc1; }
            if (lane < 16) {
#pragma unroll
                for (int t = 0; t < 16; t += 2) {   ((LAS bf16_t*)(sl + RC_TIN))[t * 16 + lane] = f2bf(rw_[t]); ((LAS bf16_t*)(sl + RC_TIN))[(t + 1) * 16 + lane] = f2bf(rw_[t + 1]); } }
            }
            asm volatile("s_waitcnt lgkmcnt(0)" ::: "memory");
            if (lane == 0) __hip_atomic_fetch_add(acnt, 1u, __ATOMIC_RELAXED, __HIP_MEMORY_SCOPE_WORKGROUP);
            while (__hip_atomic_load(acnt, __ATOMIC_RELAXED, __HIP_MEMORY_SCOPE_WORKGROUP) < 4u * (unsigned)(g + 1)) __builtin_amdgcn_s_sleep(1);
            asm volatile("" ::: "memory");
#pragma unroll 1
            for (int cc = 0; cc < (mode == 2 ? 0 : 4); ++cc) {
                const int c = 4 * g + cc; const LAS unsigned char* sl = lds + (((g & 1) * 4 + cc) * RC_SLOT);
                const LAS bf16_t* At = (const LAS bf16_t*)(sl + RC_AT); const LAS bf16_t* Rt = (const LAS bf16_t*)(sl + RC_RT);
                bf16x8 sb[2];
#pragma unroll
                for (int s2 = 0; s2 < 2; ++s2) { u32x4 w; w.x = pkbf(st[2 * s2][0], st[2 * s2][1]); w.y = pkbf(st[2 * s2][2], st[2 * s2][3]); w.z = pkbf(st[2 * s2 + 1][0], st[2 * s2 + 1][1]); w.w = pkbf(st[2 * s2 + 1][2], st[2 * s2 + 1][3]); sb[s2] = __builtin_bit_cast(bf16x8, w); }
                const LAS unsigned char* trb = sl + (4 * fq + (fr >> 2)) * 144 + 8 * (fr & 3);
                const u32x2 vv = __builtin_bit_cast(u32x2, ld_tr4(trb + RC_VT + 32 * wid));
                const bf16x8 fa0 = ld_frag2(At + fr * 72 + 4 * fq), fa1 = ld_frag2(At + fr * 72 + 32 + 4 * fq), fr0 = ld_frag2(Rt + fr * 72 + 4 * fq), fr1 = ld_frag2(Rt + fr * 72 + 32 + 4 * fq);
                const u32x2 qnak = *(const LAS u32x2*)(sl + RC_NAK + fr * 32 + 8 * fq), qtin = *(const LAS u32x2*)(sl + RC_TIN + fr * 32 + 8 * fq);
                const u32x2 qmbr = *(const LAS u32x2*)(sl + RC_MBR + fr * 32 + 8 * fq), qmkr = *(const LAS u32x2*)(sl + RC_MKR + fr * 32 + 8 * fq);
                u32x2 qbt[4], qkt[4]; f32x4 gm[4];
#pragma unroll
                for (int kt = 0; kt < 4; ++kt) { qbt[kt] = __builtin_bit_cast(u32x2, ld_tr4(trb + RC_BN + 32 * kt)); qkt[kt] = __builtin_bit_cast(u32x2, ld_tr4(trb + RC_KN + 32 * kt));
                    gm[kt] = *(const LAS f32x4*)(sl + RC_GAM + (16 * kt + 4 * fq) * 4); }
                __builtin_amdgcn_sched_barrier(0);
                const f32x4 zero4 = (f32x4){0.f, 0.f, 0.f, 0.f};
                f32x4 x = MFMA16(fa0, sb[0], zero4);
                x = MFMA16(fa1, sb[1], x);
                x = MFMA16(mk_frag(z2, qnak), mk_frag(z2, vv), x);
                f32x4 y = MFMA16(fr0, sb[0], zero4);
                y = MFMA16(fr1, sb[1], y);
                u32x2 xb; xb.x = pkbf(x[0], x[1]); xb.y = pkbf(x[2], x[3]);
                const f32x4 u = MFMA16(mk_frag(qtin, z2), mk_frag(xb, z2), zero4);
                u32x2 ub; ub.x = pkbf(u[0], u[1]); ub.y = pkbf(u[2], u[3]);
                const bf16x8 uv = mk_frag(ub, vv);
                y = MFMA16(mk_frag(qmbr, qmkr), uv, y);
#pragma unroll
                for (int kt = 0; kt < 4; ++kt) { st[kt] = MFMA16(mk_frag(qbt[kt], qkt[kt]), uv, st[kt]); st[kt] = st[kt] * gm[kt]; }
                if (!dry) {
                    bf16_t* yp = LWA + row_of(16 * c) * 3072 + dir * 1024 + h * 64 + 16 * wid + fr + (dir == 0 ? 1 : -1) * (4 * fq) * 3072;
#pragma unroll
                    for (int i = 0; i < 4; ++i) yp[(dir == 0 ? i : -i) * 3072] = f2bf(y[i]); }
            }
            lds_barrier();
        }
    }
}

struct RpRow { u32x2 yf[4], yb[4], v[4], g[4]; float bon[4]; };
DI void rp_load(RpRow& d, int row, int lane, const bf16_t* Vm, const bf16_t* LWA, const bf16_t* G, const float* BON) {
    ld_row_raw(LWA + (size_t)row * 3072, lane, d.yf); ld_row_raw(LWA + (size_t)row * 3072 + 1024, lane, d.yb);
    ld_row_raw(Vm + (size_t)row * 1024, lane, d.v); ld_row_raw(G + (size_t)row * 1024, lane, d.g);
#pragma unroll
    for (int i = 0; i < 4; ++i) d.bon[i] = BON[(size_t)row * 16 + i * 4 + (lane >> 4)];
}
DI void rw_post_phase(const Args& a, const bf16_t* Vm, bf16_t* LWA, const bf16_t* G, const float* BON) {
    const int tid_ = tid_op(), lane = tid_ & 63, wid = tid_ >> 6;
    const float* plg = inp(I_LNG); const float* plb = inp(I_LNB);
    const int stride = gridDim.x * 8;
    int row = blockIdx.x * 8 + wid;
    RpRow cur;
    if (row < NL) rp_load(cur, row, lane, Vm, LWA, G, BON);
    for (; row < NL; row += stride) {
        RpRow nxt = cur; const int nr = row + stride;
        if (nr < NL) rp_load(nxt, nr, lane, Vm, LWA, G, BON);
        f32x4 yf[4], yb[4], v[4], g[4], z[4];
        cvt_row(cur.yf, yf); cvt_row(cur.yb, yb); cvt_row(cur.v, v); cvt_row(cur.g, g);
#pragma unroll
        for (int i = 0; i < 4; ++i) { const int c = i * 256 + lane * 4; const f32x4 y = yf[i] + yb[i];
            const float mean = grp16_sum((y[0] + y[1]) + (y[2] + y[3])) * (1.f / 64.f); const f32x4 d = y - mean;
            const float var = grp16_sum((d[0] * d[0] + d[1] * d[1]) + (d[2] * d[2] + d[3] * d[3])) * (1.f / 64.f);
            const float rs = rsqrtf(var + 64e-5f);
            const f32x4 lg = *(const f32x4*)(plg + c), lb = *(const f32x4*)(plb + c);
            z[i] = (d * rs * lg + lb + v[i] * cur.bon[i]) * g[i]; }
        if (MK_F8_OUT1) st_row_f8((unsigned char*)(LWA + (size_t)row * 3072 + 2048), lane, z);
        else st_row_bf16(LWA + (size_t)row * 3072 + 2048, lane, z);
        cur = nxt;
    }
}
#ifndef MK_ONE_LAUNCH
#define MK_ONE_LAUNCH 1
#endif
#ifndef MK_NPH
#define MK_NPH 25
#endif
constexpr int NPH = 25;

__global__ void __launch_bounds__(512, 2) mk_fwd(Args a) {
    extern __shared__ __attribute__((aligned(16))) unsigned char lds_raw[];
    LAS unsigned char* lds = (LAS unsigned char*)lds_raw;
    const int lo = a.ph_lo, hi = a.ph_hi;
    if (threadIdx.x < 4) ((LAS unsigned*)(lds + LDS_BARW))[threadIdx.x] = 0u;
    __syncthreads();
    XcdBarrier bar; bar.bar = (unsigned*)(a.ws + WS_CTL); bar.x = 0; bar.st = nullptr;
    if (hi - lo > 1) bar = xcd_barrier_post((unsigned*)(a.ws + WS_CTL), (volatile LAS unsigned*)(lds + LDS_BARW));
#ifndef MK_PHMASK
#define MK_PHMASK 0xffffffffu
#endif
#ifndef MK_RWMODE
#define MK_RWMODE 1
#endif
#ifndef MK_DUPMASK
#define MK_DUPMASK 0u
#endif
#define PH(k) if (((MK_PHMASK >> (k)) & 1u) && lo <= (k) && (k) < hi) for (int _r = 0; _r < 1 + (int)((MK_DUPMASK >> (k)) & 1u); ++_r)
#ifndef MK_ALIGN_SWIGLU
#define MK_ALIGN_SWIGLU true
#endif
#ifndef MK_ALIGN_RW2
#define MK_ALIGN_RW2 true
#endif
#ifndef MK_GEMMDRY
#define MK_GEMMDRY 0
#endif
#define GDRY(k) (MK_GEMMDRY && ((MK_DUPMASK >> (k)) & 1u) && _r == 0 && lo == 0)
#define SEAM(k) do { if (lo <= (k) && (k) + 1 < hi) xcd_barrier(bar); } while (0)
    unsigned char* ws = a.ws;
    bf16_t* const S0 = (bf16_t*)(ws + slot_off(0)); bf16_t* const S1 = (bf16_t*)(ws + slot_off(1)); bf16_t* const S2 = (bf16_t*)(ws + slot_off(2));
    bf16_t* const S3 = (bf16_t*)(ws + slot_off(3)); bf16_t* const S4 = (bf16_t*)(ws + slot_off(4)); bf16_t* const S5 = (bf16_t*)(ws + slot_off(5)); bf16_t* const S6 = (bf16_t*)(ws + slot_off(6));
    float* const GD = (float*)(ws + WS_GD); bf16_t* const XC = (bf16_t*)a.out; bf16_t* const XB = (bf16_t*)a.out;
    unsigned char* const EW1 = (unsigned char*)a.out + ((size_t)128 << 20);
    const int G = gridDim.x, bx = blockIdx.x;
    unsigned char* const EW0U = (unsigned char*)a.out + ((size_t)198 << 20); unsigned char* const EW0D = (unsigned char*)S4;
#ifndef MK_CONVSPLIT
#define MK_CONVSPLIT 1
#endif
#ifndef MK_CVT4
#define MK_CVT4 (MK_CONVSPLIT ? 0 : 70)
#endif
#ifndef MK_CVT13
#define MK_CVT13 8
#endif
#ifndef MK_G6K
#define MK_G6K 128
#endif
#ifndef MK_LORA1_S6
#define MK_LORA1_S6 0
#endif
    bf16_t* const LORA1P = MK_LORA1_S6 ? S6 : (bf16_t*)(ws + WS_LORA1);

    PH(0) { p0a_phase(a, lds); } SEAM(0);
    PH(1) { p0b_phase(a, S0); } SEAM(1);
    PH(2) { pg8::Gemm g{S0, (const bf16_t*)(ws + WS_WIN), 1024, 1024}; pg8::StaticOrder S; S.init(NR, 5888, G, bx);
            EpiProj E{ws, GD}; pg8::gemm_phase(lds, g, S, E, GDRY(2)); } SEAM(2);
    const bool csplit = MK_CONVSPLIT && G == 256;
    PH(3) { if (!csplit) conv_phase(a, lds, S2, XC); }
    if (!csplit) SEAM(3);
    PH(4) { if (csplit && bx >= 128) { conv_phase(a, lds, S2, XC, 128); sub_barrier((unsigned*)(ws + WS_CTL + 49152), (unsigned)(G - 128)); }
            scan_phase(a, lds, S1, S4, XC, GD, S0, S2);
            if (bx >= 128) expert_cvt_items(a, lds, 0, EW0U, MK_CVT4, EW0D, 1); } SEAM(4);
    PH(5) { post_mix_phase(a, S0, S2, XC, S5, (unsigned char*)S3); } SEAM(5);
    PH(6) { pg8::StaticOrder S; S.init(NR, 1024, G, bx); EpiPlain E{S1, 1024};
            if (MK_F8_OUT0) { pg8::Gemm g{S3, (const bf16_t*)(ws + WS_WOUT), 1024, 1024, F8_ACT_SH}; pg8::gemm_phase<EpiPlain, pg8::StaticOrder, true, true, true>(lds, g, S, E); }
            else { pg8::Gemm g{S5, (const bf16_t*)(ws + WS_WOUT), 2048, 2048}; pg8::gemm_phase(lds, g, S, E); }
            if (bx >= (NR / 256 * 4) % G) expert_cvt_items(a, lds, 0, EW0U, 12, EW0D); } SEAM(6);
    PH(7) { post_attn_phase(a, lds, 0, NR, S1, (unsigned char*)S0, nullptr, XB); } SEAM(7);
    PH(8) { for (int item = bx; item < 256; item += G) topk_item(a, lds, item, 8448, (const unsigned char*)S0, (unsigned char*)S5);
            expert_cvt_items(a, lds, 0, EW0U, 1 << 30, EW0D); } SEAM(8);
    PH(9) { pg8::Gemm g{S5, (const bf16_t*)EW0U, 512, 512, F8_HID_SH}; pg8::GroupOrder S; S.init(33, 11, G, bx);
            EpiSwiglu E{(unsigned char*)S0}; pg8::gemm_phase<EpiSwiglu, pg8::GroupOrder, MK_ALIGN_SWIGLU, true, true>(lds, g, S, E); } SEAM(9);
    PH(10) { pg8::Gemm g{S0, (const bf16_t*)EW0D, FFP / 2, FFP / 2, F8_HID_SH}; pg8::GroupOrder S; S.init(33, 4, G, bx);
             EpiGate E{S5, (const float*)(ws + WS_GATE)}; pg8::gemm_phase<EpiGate, pg8::GroupOrder, true, true, true>(lds, g, S, E);
             if (bx >= (NE * 33 * 4) % G) expert_cvt_items(a, lds, 1, EW1, 10); } SEAM(10);
    PH(11) { combine_phase(a, 0, NR, 8448, S5, S0, XB); } SEAM(11);
    PH(12) { mix_phase(S0, S2); } SEAM(12);
    PH(13) { { pg8::Gemm g{S0, (const bf16_t*)(ws + WS_WRW) + (size_t)3072 * 2048, 2048, 2048}; pg8::StaticOrder S; S.init(NR, 512, G, bx);
               EpiRw1 E{LORA1P, (bf16_t*)(ws + WS_LORA2)}; pg8::gemm_phase(lds, g, S, E); }
             { pg8::SkipOrder S; S.init(NR, 1024, G, bx, 16); EpiPlainG E{S5};
               if (MK_F8_RKV) { pg8::Gemm g{S2, (const bf16_t*)(ws + WS_WRW), 512, 512, F8_ACT_SH, 2048, USZ}; pg8::gemm_phase<EpiPlainG, pg8::SkipOrder, true, true, true>(lds, g, S, E); }
               else { pg8::Gemm g{S2, (const bf16_t*)(ws + WS_WRW), 1024, 1024, 0, 2048, USZ}; pg8::gemm_phase(lds, g, S, E); } }
             if (bx >= 96) expert_cvt_items(a, lds, 1, EW1, MK_CVT13); } SEAM(13);
    PH(14) { pg8::StaticOrder S; S.init(NR, 2048, G, bx); EpiPlainG E{S0};
             if (MK_F8_RKV) { pg8::Gemm g{S3, (const bf16_t*)(ws + WS_WRW) + (size_t)1024 * 2048, 512, 512, F8_ACT_SH, 2048, USZ}; pg8::gemm_phase<EpiPlainG, pg8::StaticOrder, true, true, true>(lds, g, S, E); }
             else { pg8::Gemm g{S3, (const bf16_t*)(ws + WS_WRW) + (size_t)1024 * 2048, 1024, 1024, 0, 2048, USZ}; pg8::gemm_phase(lds, g, S, E); }
             if (bx >= (NR / 256 * 8) % G) expert_cvt_items(a, lds, 1, EW1, 7); } SEAM(14);
    PH(15) { pg8::Gemm g{LORA1P, (const bf16_t*)(ws + WS_W2A), 256, MK_G6K, 0, 256, MK_G6K == 128 ? 128 : 0, MK_G6K == 128 ? 128 : 0}; pg8::StaticOrder S; S.init(NR, 3072, G, bx);
             EpiRw2 E{S2, inp(I_W0), inp(I_A0)}; pg8::gemm_phase<EpiRw2, pg8::StaticOrder, MK_ALIGN_RW2>(lds, g, S, E);
             { pg8::Gemm g2{(const bf16_t*)(ws + WS_LORA2), (const bf16_t*)(ws + WS_G2), 256, 256}; pg8::StaticOrder S2_; S2_.init(NL, 1024, G, bx);
               EpiPlain E2{S6, 1024}; pg8::gemm_phase(lds, g2, S2_, E2); } } SEAM(15);
    PH(16) { for (int item = bx; item < 256; item += G) { rwkv_scan_item(lds, item, S5, S0, S1, S2, (float*)(ws + WS_BON), (((MK_DUPMASK >> 16) & 1u) && _r == 0) ? MK_RWMODE : 0); __syncthreads(); } } SEAM(16);
    PH(18) { rw_post_phase(a, S1, S2, S6, (const float*)(ws + WS_BON)); } SEAM(18);
    PH(19) { pg8::StaticOrder S; S.init(NL, 1024, G, bx); EpiPlain E{S6, 1024};
             if (MK_F8_OUT1) { pg8::Gemm g{S2 + 2048, (const bf16_t*)(ws + WS_WO), 3072, 512, F8_ACT_SH}; pg8::gemm_phase<EpiPlain, pg8::StaticOrder, true, true, true>(lds, g, S, E); }
             else { pg8::Gemm g{S2 + 2048, (const bf16_t*)(ws + WS_WO), 3072, 1024}; pg8::gemm_phase(lds, g, S, E); } } SEAM(19);
    PH(20) { post_attn_phase(a, lds, 1, NL, S6, (unsigned char*)S0, XB, S3); } SEAM(20);
    PH(21) { for (int item = bx; item < 128; item += G) topk_item(a, lds, item, 8192, (const unsigned char*)S0, (unsigned char*)S5);
             expert_cvt_items(a, lds, 1, EW1); } SEAM(21);
    PH(22) { pg8::Gemm g{S5, (const bf16_t*)EW1, 512, 512, F8_HID_SH}; pg8::GroupOrder S; S.init(32, 11, G, bx);
             EpiSwiglu E{(unsigned char*)S0}; pg8::gemm_phase<EpiSwiglu, pg8::GroupOrder, MK_ALIGN_SWIGLU, true, true>(lds, g, S, E); } SEAM(22);
    PH(23) { pg8::Gemm g{S0, (const bf16_t*)(EW1 + W13_BYTES), FFP / 2, FFP / 2, F8_HID_SH}; pg8::GroupOrder S; S.init(32, 4, G, bx);
             EpiGate E{S5, (const float*)(ws + WS_GATE)}; pg8::gemm_phase<EpiGate, pg8::GroupOrder, true, true, true>(lds, g, S, E); } SEAM(23);
    PH(24) { combine_phase(a, 1, NL, 8192, S5, S0, S3); }
#undef PH
#undef SEAM
}

extern "C" void kernel_launch(void* const* d_in, const int* in_sizes, int n_in, void* d_out, int out_size, void* d_ws, size_t ws_size, hipStream_t stream) {
    static int grid = 0;
    if (grid == 0) {
        if (n_in != N_IN || out_size != NL * D || ws_size < WS_NEED) { grid = -1; return; }
        int dev = 0, cus = 0;
        if (hipGetDevice(&dev) != hipSuccess || hipDeviceGetAttribute(&cus, hipDeviceAttributeMultiprocessorCount, dev) != hipSuccess) { grid = -1; return; }
        if (hipFuncSetAttribute((const void*)mk_fwd, hipFuncAttributeMaxDynamicSharedMemorySize, LDS_BYTES) != hipSuccess) { grid = -1; return; }
        int per_cu = 0;
        (void)hipOccupancyMaxActiveBlocksPerMultiprocessor(&per_cu, (const void*)mk_fwd, 512, LDS_BYTES);
        (void)hipGetLastError();
        grid = cus;
    }
    if (grid < 0) return;
    (void)hipMemsetAsync((char*)d_ws + WS_CTL, 0, 65536, stream);
    Args a{};
    for (int i = 0; i < N_IN; ++i) a.in[i] = (const float*)d_in[i];
    a.out = (float*)d_out; a.ws = (unsigned char*)d_ws;
#if MK_ONE_LAUNCH
    a.ph_lo = 0; a.ph_hi = MK_NPH;
    hipLaunchKernelGGL(mk_fwd, dim3(grid), dim3(512), LDS_BYTES, stream, a);
#else
    for (int p = 0; p < MK_NPH; ++p) { a.ph_lo = p; a.ph_hi = p + 1; hipLaunchKernelGGL(mk_fwd, dim3(grid), dim3(512), LDS_BYTES, stream, a); }
#endif
}
```
